# Optimizing an MI355X kernel written in HIP

```python
import math
import jax, jax.numpy as jnp
from jax import lax
import numpy as np

D_MODEL = 1024
BATCH = 8
SEQ = 2048
DEPTH = 2
DEC_BATCH = 128
DEC_SEQ = 4
PAST_LEN = 16384
PAGE_SIZE = 128

D_MIX = D_MODEL
D_RNN = D_MIX // 2
RNN_HEADS = 8
RNN_HEAD_DIM = D_RNN // RNN_HEADS
RG_CONV_W = 4
LRU_C = 8.0
D_CONF = D_MIX - D_RNN
CF_CONV_W = 31
D_IN = 2 * D_RNN + 2 * D_CONF
N_MEM = 256
MEM_HEADS = 4
MEM_HEAD_DIM = D_MODEL // MEM_HEADS
D_FF = ((8 * D_MODEL // 3 + 255) // 256) * 256
EPS = 1e-6

kernel_name = "hymba_rglru_conformer_memxattn_step"


def _rmsnorm(x, g):
    xf = x.astype(jnp.float32)
    y = xf * lax.rsqrt(jnp.mean(xf * xf, axis=-1, keepdims=True) + EPS)
    return (y * g.astype(jnp.float32)).astype(x.dtype)


def _layernorm(x, g, b):
    xf = x.astype(jnp.float32)
    mu = jnp.mean(xf, axis=-1, keepdims=True)
    xc = xf - mu
    var = jnp.mean(xc * xc, axis=-1, keepdims=True)
    return (xc * lax.rsqrt(var + EPS) * g.astype(jnp.float32) + b.astype(jnp.float32)).astype(x.dtype)


def _causal_dwconv(x, buf, w, b):
    k = w.shape[0]
    xp = jnp.concatenate([buf.astype(x.dtype), x], axis=1)
    y = lax.conv_general_dilated(
        xp, w[:, None, :].astype(x.dtype), window_strides=(1,), padding='VALID',
        dimension_numbers=('NWC', 'WIO', 'NWC'), feature_group_count=x.shape[-1])
    return y + b.astype(x.dtype), xp[:, -(k - 1):]


def _rglru(x, h0, wa, ba, wx, bx, lam):
    bsz, t = x.shape[0], x.shape[1]
    f32 = jnp.float32
    xf = x.astype(f32)
    xh = xf.reshape(bsz, t, RNN_HEADS, RNN_HEAD_DIM)
    r = jax.nn.sigmoid(jnp.einsum('bthi,hij->bthj', xh, wa.astype(f32)).reshape(bsz, t, D_RNN) + ba.astype(f32))
    i = jax.nn.sigmoid(jnp.einsum('bthi,hij->bthj', xh, wx.astype(f32)).reshape(bsz, t, D_RNN) + bx.astype(f32))
    log_a = -LRU_C * r * jax.nn.softplus(-lam.astype(f32))
    a = jnp.exp(log_a)
    mult = jnp.sqrt(-jnp.expm1(2.0 * log_a))
    bterm = mult * (i * xf)
    bterm = bterm.at[:, 0].add(a[:, 0] * h0.astype(f32))

    def combine(left, right):
        a_l, b_l = left
        a_r, b_r = right
        return a_l * a_r, a_r * b_l + b_r

    _, h = lax.associative_scan(combine, (a, bterm), axis=1)
    return h.astype(x.dtype), h[:, -1].astype(h0.dtype)


def _mem_kv(mem, g, wk, wv):
    bsz = mem.shape[0]
    m = _rmsnorm(mem, g)
    k = (m @ wk).reshape(bsz, N_MEM, MEM_HEADS, MEM_HEAD_DIM)
    v = (m @ wv).reshape(bsz, N_MEM, MEM_HEADS, MEM_HEAD_DIM)
    return k, v


def _cross_attn(x, k, v, wq, wo):
    bsz, t = x.shape[0], x.shape[1]
    q = (x @ wq).reshape(bsz, t, MEM_HEADS, MEM_HEAD_DIM).astype(jnp.float32)
    s = jnp.einsum('bthd,bmhd->bhtm', q, k.astype(jnp.float32)) * (MEM_HEAD_DIM ** -0.5)
    p = jax.nn.softmax(s, axis=-1)
    o = jnp.einsum('bhtm,bmhd->bthd', p, v.astype(jnp.float32)).astype(x.dtype)
    return o.reshape(bsz, t, MEM_HEADS * MEM_HEAD_DIM) @ wo


def _layer(x, mem_k, mem_v, h0, rg_buf, cf_buf, lw):
    u = _rmsnorm(x, lw['norm_mix_g']) @ lw['w_in']
    xr = u[..., :D_RNN]
    gr = u[..., D_RNN:2 * D_RNN]
    cv = u[..., 2 * D_RNN:2 * D_RNN + D_CONF]
    cg = u[..., 2 * D_RNN + D_CONF:]
    xr_c, rg_buf_new = _causal_dwconv(xr, rg_buf, lw['rg_conv_w'], lw['rg_conv_b'])
    h, h_last = _rglru(xr_c, h0, lw['rg_wa'], lw['rg_ba'], lw['rg_wx'], lw['rg_bx'], lw['rg_lambda'])
    y_r = h * jax.nn.gelu(gr)
    c = cv * jax.nn.sigmoid(cg)
    c_c, cf_buf_new = _causal_dwconv(c, cf_buf, lw['cf_conv_w'], lw['cf_conv_b'])
    y_c = jax.nn.silu(_layernorm(c_c, lw['cf_ln_g'], lw['cf_ln_b']))
    x = x + jnp.concatenate([y_r, y_c], axis=-1) @ lw['w_out']
    x = x + _cross_attn(_rmsnorm(x, lw['norm_attn_g']), mem_k, mem_v, lw['w_q'], lw['w_o'])
    z = _rmsnorm(x, lw['norm_ffn_g'])
    x = x + (jax.nn.silu(z @ lw['w_gate']) * (z @ lw['w_up'])) @ lw['w_down']
    return x, h_last, rg_buf_new, cf_buf_new


def setup_inputs(seed: int = 0) -> dict:
    key = jax.random.key(seed)
    ks = iter(jax.random.split(key, 40))
    f32 = jnp.float32

    def nrm(shape, scale):
        return jax.random.normal(next(ks), shape, f32) * scale

    def gain(shape):
        return 1.0 + nrm(shape, 0.02)

    u = jax.random.uniform(next(ks), (DEPTH, D_RNN), f32, 0.9, 0.999)
    s = u ** (1.0 / LRU_C)
    rg_lambda = jnp.log(s) - jnp.log1p(-s)
    return {
        'x_prompt': nrm((BATCH, SEQ, D_MODEL), 1.0),
        'x_sample': nrm((DEC_BATCH, DEC_SEQ, D_MODEL), 1.0),
        'state_rglru_h': nrm((DEPTH, DEC_BATCH, D_RNN), 0.5),
        'state_rglru_conv': nrm((DEPTH, DEC_BATCH, RG_CONV_W - 1, D_RNN), 1.0),
        'state_conf_conv': nrm((DEPTH, DEC_BATCH, CF_CONV_W - 1, D_CONF), 1.0),
        'cache_mem_k': nrm((DEPTH, DEC_BATCH, N_MEM, MEM_HEADS, MEM_HEAD_DIM), 1.0),
        'cache_mem_v': nrm((DEPTH, DEC_BATCH, N_MEM, MEM_HEADS, MEM_HEAD_DIM), 1.0),
        'mem_prompt': nrm((BATCH, N_MEM, D_MODEL), 1.0),
        'norm_mix_g': gain((DEPTH, D_MODEL)),
        'w_in': nrm((DEPTH, D_MODEL, D_IN), D_MODEL ** -0.5),
        'rg_conv_w': nrm((DEPTH, RG_CONV_W, D_RNN), RG_CONV_W ** -0.5),
        'rg_conv_b': nrm((DEPTH, D_RNN), 0.02),
        'rg_wa': nrm((DEPTH, RNN_HEADS, RNN_HEAD_DIM, RNN_HEAD_DIM), RNN_HEAD_DIM ** -0.5),
        'rg_ba': nrm((DEPTH, D_RNN), 0.02),
        'rg_wx': nrm((DEPTH, RNN_HEADS, RNN_HEAD_DIM, RNN_HEAD_DIM), RNN_HEAD_DIM ** -0.5),
        'rg_bx': nrm((DEPTH, D_RNN), 0.02),
        'rg_lambda': rg_lambda,
        'cf_conv_w': nrm((DEPTH, CF_CONV_W, D_CONF), CF_CONV_W ** -0.5),
        'cf_conv_b': nrm((DEPTH, D_CONF), 0.02),
        'cf_ln_g': gain((DEPTH, D_CONF)),
        'cf_ln_b': nrm((DEPTH, D_CONF), 0.02),
        'w_out': nrm((DEPTH, D_MIX, D_MODEL), D_MIX ** -0.5),
        'norm_attn_g': gain((DEPTH, D_MODEL)),
        'norm_mem_g': gain((DEPTH, D_MODEL)),
        'w_q': nrm((DEPTH, D_MODEL, MEM_HEADS * MEM_HEAD_DIM), D_MODEL ** -0.5),
        'w_k': nrm((DEPTH, D_MODEL, MEM_HEADS * MEM_HEAD_DIM), D_MODEL ** -0.5),
        'w_v': nrm((DEPTH, D_MODEL, MEM_HEADS * MEM_HEAD_DIM), D_MODEL ** -0.5),
        'w_o': nrm((DEPTH, MEM_HEADS * MEM_HEAD_DIM, D_MODEL), (MEM_HEADS * MEM_HEAD_DIM) ** -0.5),
        'norm_ffn_g': gain((DEPTH, D_MODEL)),
        'w_gate': nrm((DEPTH, D_MODEL, D_FF), D_MODEL ** -0.5),
        'w_up': nrm((DEPTH, D_MODEL, D_FF), D_MODEL ** -0.5),
        'w_down': nrm((DEPTH, D_FF, D_MODEL), D_FF ** -0.5),
        'norm_final_g': gain((D_MODEL,)),
    }


def reference(x_prompt, x_sample, state_rglru_h, state_rglru_conv, state_conf_conv,
              cache_mem_k, cache_mem_v, mem_prompt,
              norm_mix_g, w_in, rg_conv_w, rg_conv_b, rg_wa, rg_ba, rg_wx, rg_bx, rg_lambda,
              cf_conv_w, cf_conv_b, cf_ln_g, cf_ln_b, w_out,
              norm_attn_g, norm_mem_g, w_q, w_k, w_v, w_o,
              norm_ffn_g, w_gate, w_up, w_down, norm_final_g):
    bp = x_prompt.shape[0]
    xp = x_prompt
    xs = x_sample
    p_h, p_rg, p_cf, p_mk, p_mv = [], [], [], [], []
    s_h, s_rg, s_cf = [], [], []
    for l in range(DEPTH):
        lw = {
            'norm_mix_g': norm_mix_g[l], 'w_in': w_in[l],
            'rg_conv_w': rg_conv_w[l], 'rg_conv_b': rg_conv_b[l],
            'rg_wa': rg_wa[l], 'rg_ba': rg_ba[l], 'rg_wx': rg_wx[l], 'rg_bx': rg_bx[l],
            'rg_lambda': rg_lambda[l],
            'cf_conv_w': cf_conv_w[l], 'cf_conv_b': cf_conv_b[l],
            'cf_ln_g': cf_ln_g[l], 'cf_ln_b': cf_ln_b[l], 'w_out': w_out[l],
            'norm_attn_g': norm_attn_g[l], 'w_q': w_q[l], 'w_o': w_o[l],
            'norm_ffn_g': norm_ffn_g[l], 'w_gate': w_gate[l], 'w_up': w_up[l], 'w_down': w_down[l],
        }
        mk, mv = _mem_kv(mem_prompt, norm_mem_g[l], w_k[l], w_v[l])
        h0 = jnp.zeros((bp, D_RNN), state_rglru_h.dtype)
        rb0 = jnp.zeros((bp, RG_CONV_W - 1, D_RNN), state_rglru_conv.dtype)
        cb0 = jnp.zeros((bp, CF_CONV_W - 1, D_CONF), state_conf_conv.dtype)
        xp, hp, rbp, cbp = _layer(xp, mk, mv, h0, rb0, cb0, lw)
        p_h.append(hp); p_rg.append(rbp); p_cf.append(cbp); p_mk.append(mk); p_mv.append(mv)
        xs, hs, rbs, cbs = _layer(xs, cache_mem_k[l], cache_mem_v[l], state_rglru_h[l],
                                  state_rglru_conv[l], state_conf_conv[l], lw)
        s_h.append(hs); s_rg.append(rbs); s_cf.append(cbs)
    y_prompt = _rmsnorm(xp, norm_final_g)
    y_sample = _rmsnorm(xs, norm_final_g)
    return (y_prompt, y_sample,
            jnp.stack(p_h), jnp.stack(p_rg), jnp.stack(p_cf), jnp.stack(p_mk), jnp.stack(p_mv),
            jnp.stack(s_h), jnp.stack(s_rg), jnp.stack(s_cf))
```

```cpp
#include <hip/hip_runtime.h>
#include <hip/hip_cooperative_groups.h>
#include <cstdio>
#include <cstdint>
namespace cg = cooperative_groups;

namespace pg8 {
#define PG8_LAS __attribute__((address_space(3)))
typedef unsigned short bf16_t;
typedef short bf16x8 __attribute__((ext_vector_type(8)));
typedef float f32x4 __attribute__((ext_vector_type(4)));
typedef unsigned u32x4 __attribute__((ext_vector_type(4)));
constexpr int BM = 256, BK = 64, HALF = 128, HTB = HALF * BK * 2  , STAGE_BYTES = 8 * HTB, NXCD = 8, WGM = 8;

__host__ __device__ __forceinline__ int lds_byte(int r, int c) { const int st = (r >> 4) * 2 + (c >> 5), rr = r & 15, cc = c & 31, ob = rr * 64 + cc * 2; return st * 1024 + (ob ^ (((ob >> 9) & 1) << 5)); }
__host__ __device__ __forceinline__ void stage_rc(int b, int& R, int& C) { const int st = b / 1024, sb = b % 1024, swz = sb ^ (((sb >> 9) & 1) << 5); R = (st >> 1) * 16 + swz / 64; C = (st & 1) * 32 + (swz % 64) / 2; }
__host__ __device__ __forceinline__ int perm32(int rho) { const int n = rho >> 4, i = rho & 15; return 8 * (i >> 2) + 4 * n + (i & 3); }

struct Unit { int pm, pn; };
struct Gemm { const bf16_t* A; const bf16_t* Bt; int M, N, K; };

struct StaticOrder {
    int nM, nN, nwg, G, c;
    __host__ __device__ void init(int M, int N, int G_, int c_) { nM = M / BM; nN = N / BM; nwg = nM * nN; G = G_; c = c_; }
    __host__ __device__ bool next(int i, Unit& u) const {
        const long L = (long)i * G + c; if (L >= nwg) return false;
        int wgid = (int)L; { const int q = nwg / NXCD, r = nwg % NXCD, xcd = wgid % NXCD, off = wgid / NXCD; wgid = (xcd < r ? xcd * (q + 1) : r * (q + 1) + (xcd - r) * q) + off; }
        const int nig = WGM * nN, gid = wgid / nig, fm = gid * WGM, gsz = (nM - fm) < WGM ? (nM - fm) : WGM;
        u.pm = fm + ((wgid % nig) % gsz); u.pn = (wgid % nig) / gsz; return true;
    }
    __device__ __forceinline__ void a_ready(const Unit&) const {}
    __device__ __forceinline__ void done(const Unit&) const {}
};

__device__ __forceinline__ unsigned cvt_pk_bf16(float lo, float hi) { unsigned r; asm volatile("v_cvt_pk_bf16_f32 %0, %1, %2" : "=v"(r) : "v"(lo), "v"(hi)); return r; }
typedef unsigned u32x2 __attribute__((ext_vector_type(2)));
constexpr float RMS_EPS = 1e-6f;

struct EpiScaleBf16 {
    static constexpr bool PERM = true, AFTER_DRAIN = false;
    bf16_t* O; int ldc; const float* ssq; float scale;
    __device__ __forceinline__ void operator()(const f32x4 (&acc)[2][2][4][2], const Unit& u, int wr, int wc, int fr, int fq) const {
        const int row0 = u.pm * BM + wr * 64 + fr, col0 = u.pn * BM + wc * 32 + 8 * fq;
#pragma unroll
        for (int ai = 0; ai < 2; ++ai)
#pragma unroll
            for (int m = 0; m < 4; ++m) { const int row = row0 + ai * HALF + m * 16; const float r = rsqrtf(ssq[row] * (1.0f / 1024.0f) + RMS_EPS) * scale;
                bf16_t* rowp = O + (size_t)row * ldc + col0;
#pragma unroll
                for (int bj = 0; bj < 2; ++bj) { const f32x4 v0 = acc[ai][bj][m][0] * r, v1 = acc[ai][bj][m][1] * r;
                    u32x4 w; w.x = cvt_pk_bf16(v0[0], v0[1]); w.y = cvt_pk_bf16(v0[2], v0[3]); w.z = cvt_pk_bf16(v1[0], v1[1]); w.w = cvt_pk_bf16(v1[2], v1[3]);
                    *(u32x4*)(rowp + bj * HALF) = w; } }
    }
};
struct EpiGateUp {
    static constexpr bool PERM = true, AFTER_DRAIN = false;
    bf16_t* O; int ldc; const float* ssq;
    __device__ __forceinline__ void operator()(const f32x4 (&acc)[2][2][4][2], const Unit& u, int wr, int wc, int fr, int fq) const {
        const int row0 = u.pm * BM + wr * 64 + fr, col0 = u.pn * HALF + wc * 32 + 8 * fq;
#pragma unroll
        for (int ai = 0; ai < 2; ++ai)
#pragma unroll
            for (int m = 0; m < 4; ++m) { const int row = row0 + ai * HALF + m * 16; const float r = rsqrtf(ssq[row] * (1.0f / 1024.0f) + RMS_EPS);
                float o[8];
#pragma unroll
                for (int n = 0; n < 2; ++n)
#pragma unroll
                    for (int j = 0; j < 4; ++j) { const float g = acc[ai][0][m][n][j] * r, up = acc[ai][1][m][n][j] * r;
                        o[n * 4 + j] = g * __builtin_amdgcn_rcpf(1.0f + __expf(-g)) * up; }
                u32x4 w; w.x = cvt_pk_bf16(o[0], o[1]); w.y = cvt_pk_bf16(o[2], o[3]); w.z = cvt_pk_bf16(o[4], o[5]); w.w = cvt_pk_bf16(o[6], o[7]);
                *(u32x4*)(O + (size_t)row * ldc + col0) = w; }
    }
};
struct EpiRes {
    static constexpr bool PERM = false, AFTER_DRAIN = false;
    float* X; bf16_t* XB; float* ssq_out;
    __device__ __forceinline__ void operator()(const f32x4 (&acc)[2][2][4][2], const Unit& u, int wr, int wc, int fr, int fq) const {
        const int row0 = u.pm * BM + wr * 64 + fr, col0 = u.pn * BM + wc * 32 + 4 * fq;
#pragma unroll
        for (int ai = 0; ai < 2; ++ai)
#pragma unroll
            for (int m = 0; m < 4; ++m) { const int row = row0 + ai * HALF + m * 16; const size_t off = (size_t)row * 1024 + col0; float s = 0.f;
#pragma unroll
                for (int bj = 0; bj < 2; ++bj)
#pragma unroll
                    for (int n = 0; n < 2; ++n) { const f32x4 xo = *(const f32x4*)(X + off + bj * HALF + n * 16); const f32x4 xn = xo + acc[ai][bj][m][n];
                        *(f32x4*)(X + off + bj * HALF + n * 16) = xn;
                        u32x2 w; w.x = cvt_pk_bf16(xn[0], xn[1]); w.y = cvt_pk_bf16(xn[2], xn[3]); *(u32x2*)(XB + off + bj * HALF + n * 16) = w;
                        s += (xn[0] * xn[0] + xn[1] * xn[1]) + (xn[2] * xn[2] + xn[3] * xn[3]); }
                s += __shfl_xor(s, 16); s += __shfl_xor(s, 32);
                if (fq == 0) atomicAdd(ssq_out + row, s);
                asm volatile("" ::: "memory"); }
    }
};
struct EpiKV {
    static constexpr bool PERM = false, AFTER_DRAIN = false;
    float* outK; float* outV; bf16_t* KB; bf16_t* VT; const float* ssq;
    __device__ __forceinline__ void operator()(const f32x4 (&acc)[2][2][4][2], const Unit& u, int wr, int wc, int fr, int fq) const {
        const int row0 = u.pm * BM + wr * 64 + fr; const bool isV = u.pn >= 4; const int col0 = (u.pn & 3) * BM + wc * 32 + 4 * fq;
        float* outp = isV ? outV : outK;
#pragma unroll
        for (int ai = 0; ai < 2; ++ai)
#pragma unroll
            for (int m = 0; m < 4; ++m) { const int row = row0 + ai * HALF + m * 16; const float r = rsqrtf(ssq[row] * (1.0f / 1024.0f) + RMS_EPS);
#pragma unroll
                for (int bj = 0; bj < 2; ++bj)
#pragma unroll
                    for (int n = 0; n < 2; ++n) { const int c = col0 + bj * HALF + n * 16; const f32x4 v = acc[ai][bj][m][n] * r;
                        *(f32x4*)(outp + (size_t)row * 1024 + c) = v;
                        if (!isV) { u32x2 w; w.x = cvt_pk_bf16(v[0], v[1]); w.y = cvt_pk_bf16(v[2], v[3]); *(u32x2*)(KB + (size_t)row * 1024 + c) = w; }
                        else { const int b = row >> 8, mm = row & 255, h = c >> 8, d = c & 255; bf16_t* vp = VT + ((size_t)((b * 4 + h) * 256 + d)) * 256 + mm;
                            const unsigned w0 = cvt_pk_bf16(v[0], v[1]), w1 = cvt_pk_bf16(v[2], v[3]);
                            vp[0] = (bf16_t)(w0 & 0xffffu); vp[256] = (bf16_t)(w0 >> 16); vp[512] = (bf16_t)(w1 & 0xffffu); vp[768] = (bf16_t)(w1 >> 16); } } }
    }
};

template <class Epi, class Sched, bool ALIGN_EPI = false, bool SP2 = false>
__device__ __forceinline__ void gemm_phase(PG8_LAS unsigned char* lds, const Gemm g, const Sched& S, const Epi& E) {
    int tid = threadIdx.x; asm volatile("" : "+v"(tid));
    const int wid = __builtin_amdgcn_readfirstlane(tid >> 6), lane = tid & 63, wr = wid >> 2, wc = wid & 3, fr = lane & 15, fq = lane >> 4;
    const int K = g.K, nt = K / BK;
    unsigned voffA[2], voffB[2];
#pragma unroll
    for (int i = 0; i < 2; ++i) { int R, C; stage_rc(tid * 16 + i * 8192, R, C); const int Rb = Epi::PERM ? ((R & ~31) + perm32(R & 31)) : R;
        voffA[i] = (unsigned)(R * K + C) * 2u; voffB[i] = (unsigned)(Rb * K + C) * 2u; }
    const size_t kstep = (size_t)(BK * 2);
    const size_t hstep = (size_t)HALF * K * 2;
    const size_t tstep = 2 * hstep;
    const unsigned ldsw = (unsigned)wid * 1024u;
    const int aoff = lds_byte(wr * 64 + fr, fq * 8), boff = lds_byte(wc * 32 + fr, fq * 8);
#define PG8_SA(b, h) (((b) * 2 + (h)) * HTB)
#define PG8_SB(b, h) ((4 + (b) * 2 + (h)) * HTB)
#define PG8_STAGE(bufoff, gbase, voff) do { _Pragma("unroll") for (int _i = 0; _i < 2; ++_i) \
        __builtin_amdgcn_global_load_lds((const unsigned*)((const char*)(gbase) + (voff)[_i]), (PG8_LAS unsigned*)(lds + (bufoff) + ldsw + _i * 8192), 16, 0, 0); } while (0)
#define PG8_LDA(dst, b, h) do { _Pragma("unroll") for (int m = 0; m < 4; ++m) _Pragma("unroll") for (int k = 0; k < 2; ++k) dst[m][k] = *(const PG8_LAS bf16x8*)(lds + PG8_SA(b, h) + aoff + m * 2048 + k * 1024); } while (0)
#define PG8_LDB(dst, b, h) do { _Pragma("unroll") for (int n = 0; n < 2; ++n) _Pragma("unroll") for (int k = 0; k < 2; ++k) dst[n][k] = *(const PG8_LAS bf16x8*)(lds + PG8_SB(b, h) + boff + n * 2048 + k * 1024); } while (0)
#define PG8_MMA(ai, bj, At, Bt) do { __builtin_amdgcn_s_setprio(1); _Pragma("unroll") for (int m = 0; m < 4; ++m) _Pragma("unroll") for (int n = 0; n < 2; ++n) _Pragma("unroll") for (int k = 0; k < 2; ++k) \
        acc[ai][bj][m][n] = __builtin_amdgcn_mfma_f32_16x16x32_bf16(Bt[n][k], At[m][k], acc[ai][bj][m][n], 0, 0, 0); __builtin_amdgcn_s_setprio(0); } while (0)
#define PG8_WAIT_V(n) asm volatile("s_waitcnt vmcnt(" #n ")" ::: "memory")
#define PG8_WAIT_L(n) asm volatile("s_waitcnt lgkmcnt(" #n ")" ::: "memory")
#define PG8_BAR __builtin_amdgcn_s_barrier()
#define PG8_SCHED __builtin_amdgcn_sched_barrier(0)
    Unit cur, nxt; int ui = 0;
    if (!S.next(0, cur)) return;
    f32x4 acc[2][2][4][2];
#pragma unroll
    for (int a = 0; a < 2; ++a)
#pragma unroll
        for (int b = 0; b < 2; ++b)
#pragma unroll
            for (int m = 0; m < 4; ++m)
#pragma unroll
                for (int n = 0; n < 2; ++n) acc[a][b][m][n] = (f32x4){0.f, 0.f, 0.f, 0.f};
    bf16x8 At[4][2], B0[2][2], B1[2][2];
    const char* cA = (const char*)g.A + (size_t)cur.pm * tstep; const char* cB = (const char*)g.Bt + (size_t)cur.pn * tstep;
    S.a_ready(cur);
    if constexpr (SP2) {
        PG8_STAGE(PG8_SB(0, 0), cB, voffB); PG8_STAGE(PG8_SB(0, 1), cB + hstep, voffB); PG8_STAGE(PG8_SA(0, 0), cA, voffA); PG8_STAGE(PG8_SA(0, 1), cA + hstep, voffA);
        if (wr == 1) PG8_BAR;
        PG8_WAIT_V(2); PG8_BAR;
        PG8_STAGE(PG8_SB(1, 0), cB + kstep, voffB); PG8_STAGE(PG8_SA(1, 0), cA + kstep, voffA); PG8_STAGE(PG8_SB(1, 1), cB + hstep + kstep, voffB);
        PG8_WAIT_V(6); PG8_BAR;
    } else {
        PG8_STAGE(PG8_SB(0, 0), cB, voffB); PG8_STAGE(PG8_SA(0, 0), cA, voffA); PG8_STAGE(PG8_SB(0, 1), cB + hstep, voffB); PG8_STAGE(PG8_SA(0, 1), cA + hstep, voffA);
        if (wr == 1) PG8_BAR;
        PG8_WAIT_V(4); PG8_BAR;
        PG8_STAGE(PG8_SB(1, 0), cB + kstep, voffB); PG8_STAGE(PG8_SA(1, 0), cA + kstep, voffA); PG8_STAGE(PG8_SB(1, 1), cB + hstep + kstep, voffB);
        PG8_WAIT_V(6); PG8_BAR;
    }
    for (;;) {
        const bool has_next = S.next(ui + 1, nxt);
        const char* nA = has_next ? (const char*)g.A + (size_t)nxt.pm * tstep : cA; const char* nB = has_next ? (const char*)g.Bt + (size_t)nxt.pn * tstep : cB;
        for (int t = 0; t < nt; t += 2) {
            const bool last = (t == nt - 2);
            const char* a1 = cA + (size_t)(t + 1) * kstep;
            const char* a2 = last ? nA : cA + (size_t)(t + 2) * kstep; const char* b2 = last ? nB : cB + (size_t)(t + 2) * kstep;
            const char* a3 = a2 + kstep; const char* b3 = b2 + kstep;
            if (last && has_next) S.a_ready(nxt);
            if constexpr (SP2) {
            PG8_LDB(B0, 0, 0); PG8_LDB(B1, 0, 1); PG8_SCHED; PG8_LDA(At, 0, 0); PG8_STAGE(PG8_SA(1, 1), a1 + hstep, voffA);
            PG8_WAIT_V(8); PG8_WAIT_L(0); PG8_BAR; PG8_MMA(0, 0, At, B0); PG8_MMA(0, 1, At, B1); PG8_BAR; PG8_SCHED;
            PG8_LDA(At, 0, 1); PG8_STAGE(PG8_SB(0, 0), b2, voffB); PG8_STAGE(PG8_SB(0, 1), b2 + hstep, voffB); PG8_STAGE(PG8_SA(0, 0), a2, voffA);
            PG8_WAIT_V(8); PG8_WAIT_L(0); PG8_BAR; PG8_MMA(1, 0, At, B0); PG8_MMA(1, 1, At, B1); PG8_BAR; PG8_SCHED;
            PG8_LDB(B0, 1, 0); PG8_LDB(B1, 1, 1); PG8_SCHED; PG8_LDA(At, 1, 0); PG8_STAGE(PG8_SA(0, 1), a2 + hstep, voffA);
            PG8_WAIT_V(8); PG8_WAIT_L(0); PG8_BAR; PG8_MMA(0, 0, At, B0); PG8_MMA(0, 1, At, B1); PG8_BAR; PG8_SCHED;
            PG8_LDA(At, 1, 1); PG8_STAGE(PG8_SB(1, 0), b3, voffB); PG8_STAGE(PG8_SB(1, 1), b3 + hstep, voffB); PG8_STAGE(PG8_SA(1, 0), a3, voffA);
            PG8_WAIT_V(8); PG8_WAIT_L(0); PG8_BAR; PG8_MMA(1, 0, At, B0); PG8_MMA(1, 1, At, B1); PG8_BAR; PG8_SCHED;
            } else {
            PG8_LDB(B0, 0, 0); PG8_SCHED; PG8_LDA(At, 0, 0); PG8_STAGE(PG8_SA(1, 1), a1 + hstep, voffA);
            PG8_WAIT_L(8); PG8_BAR; PG8_WAIT_L(0); PG8_MMA(0, 0, At, B0); PG8_BAR; PG8_SCHED;
            PG8_LDB(B1, 0, 1); PG8_STAGE(PG8_SB(0, 0), b2, voffB);
            PG8_BAR; PG8_WAIT_L(0); PG8_MMA(0, 1, At, B1); PG8_BAR;
            PG8_LDA(At, 0, 1); PG8_STAGE(PG8_SA(0, 0), a2, voffA);
            PG8_BAR; PG8_WAIT_L(0); PG8_MMA(1, 0, At, B0); PG8_BAR; PG8_SCHED;
            PG8_STAGE(PG8_SB(0, 1), b2 + hstep, voffB);
            PG8_WAIT_V(6); PG8_BAR; PG8_MMA(1, 1, At, B1); PG8_BAR;
            PG8_LDB(B0, 1, 0); PG8_SCHED; PG8_LDA(At, 1, 0); PG8_STAGE(PG8_SA(0, 1), a2 + hstep, voffA);
            PG8_WAIT_L(8); PG8_BAR; PG8_WAIT_L(0); PG8_MMA(0, 0, At, B0); PG8_BAR; PG8_SCHED;
            PG8_LDB(B1, 1, 1); PG8_STAGE(PG8_SB(1, 0), b3, voffB);
            PG8_BAR; PG8_WAIT_L(0); PG8_MMA(0, 1, At, B1); PG8_BAR;
            PG8_LDA(At, 1, 1); PG8_STAGE(PG8_SA(1, 0), a3, voffA);
            PG8_BAR; PG8_WAIT_L(0); PG8_MMA(1, 0, At, B0); PG8_BAR; PG8_SCHED;
            PG8_STAGE(PG8_SB(1, 1), b3 + hstep, voffB);
            PG8_WAIT_V(6); PG8_BAR; PG8_MMA(1, 1, At, B1); PG8_BAR;
            }
        }
        if constexpr (ALIGN_EPI) { if (wr == 0) PG8_BAR; }
        if constexpr (!Epi::AFTER_DRAIN) { E(acc, cur, wr, wc, fr, fq); S.done(cur); }
        if (!has_next) break;
#pragma unroll
        for (int a = 0; a < 2; ++a)
#pragma unroll
            for (int b = 0; b < 2; ++b)
#pragma unroll
                for (int m = 0; m < 4; ++m)
#pragma unroll
                    for (int n = 0; n < 2; ++n) acc[a][b][m][n] = (f32x4){0.f, 0.f, 0.f, 0.f};
        cur = nxt; cA = nA; cB = nB; ++ui;
        if constexpr (ALIGN_EPI) { if (wr == 1) PG8_BAR; }
    }
    PG8_WAIT_V(0);
    if constexpr (!ALIGN_EPI) { if (wr == 0) PG8_BAR; }
    PG8_BAR;
    if constexpr (Epi::AFTER_DRAIN) { E.fused(acc, cur, wr, wc, fr, fq, lds, wid, lane); S.done(cur); }
#undef PG8_SA
#undef PG8_SB
#undef PG8_STAGE
#undef PG8_LDA
#undef PG8_LDB
#undef PG8_MMA
#undef PG8_WAIT_V
#undef PG8_WAIT_L
#undef PG8_BAR
#undef PG8_SCHED
}
}

#define LAS __attribute__((address_space(3)))
typedef unsigned short bf16;
typedef short bf16x8 __attribute__((ext_vector_type(8)));
typedef short bf16x4 __attribute__((ext_vector_type(4)));
typedef float f32x4 __attribute__((ext_vector_type(4)));
typedef float f32x2 __attribute__((ext_vector_type(2)));
typedef float f32x16 __attribute__((ext_vector_type(16)));
typedef unsigned u32x4 __attribute__((ext_vector_type(4)));
typedef unsigned u32x2 __attribute__((ext_vector_type(2)));

constexpr int D = 1024, NB = 8, SEQ = 2048, TP = NB * SEQ, SB = 128, SS = 4, TS = SB * SS, T = TP + TS;
constexpr int DR = 512, DC = 512, DIN = 2048, NMEM = 256, NH = 4, HD = 256, DFF = 2816, MROWS = NB * NMEM;
constexpr int NTHREADS = 512, NWAVES = 8, GRID = 256;
constexpr float EPS = 1e-6f;
constexpr float QSCALE = 0.0625f * 1.4426950408889634f;

enum { I_XP = 0, I_XS, I_SH, I_SRG, I_SCF, I_CK, I_CV, I_MEM, I_GMIX, I_WIN, I_RGCW, I_RGCB, I_WA, I_BA, I_WX, I_BX, I_LAM, I_CFW, I_CFB, I_LNG, I_LNB, I_WOUT,
       I_GATTN, I_GMEM, I_WQ, I_WK, I_WV, I_WO, I_GFFN, I_WG, I_WU, I_WD, I_GFIN, N_IN };
constexpr size_t O_YP = 0, O_YS = (size_t)TP * D, O_PH = O_YS + (size_t)TS * D, O_PRG = O_PH + 2 * NB * DR, O_PCF = O_PRG + 2 * NB * 3 * DR, O_PMK = O_PCF + 2 * NB * 30 * DC,
                 O_PMV = O_PMK + (size_t)2 * MROWS * D, O_SH = O_PMV + (size_t)2 * MROWS * D, O_SRG = O_SH + 2 * SB * DR, O_SCF = O_SRG + 2 * SB * 3 * DR, O_END = O_SCF + (size_t)2 * SB * 30 * DC;
constexpr size_t MiB = 1u << 20;
constexpr size_t WS_SSQ = 0, WS_SSQM = 512 * 1024, WS_SP8 = 640 * 1024, WS_AGG = 1 * MiB, WS_RGW = 2 * MiB, WS_W = 4 * MiB, W_LAYER = 31 * MiB;
constexpr size_t WO_IN = 0, WO_OUT = 4 * MiB, WO_Q = 6 * MiB, WO_KV = 8 * MiB, WO_O = 12 * MiB, WO_GU = 14 * MiB, WO_D = 25 * MiB;
constexpr size_t WS_X = 68 * MiB, WS_XB = 134 * MiB, WS_U = 167 * MiB, WS_YM = 233 * MiB, WS_QB = 266 * MiB, WS_H = 299 * MiB, WS_MEMB = 390 * MiB, WS_KB = 394 * MiB, WS_VT = 402 * MiB, WS_END = 410 * MiB;
constexpr int LDS_BYTES = 147456;

struct Params { const float* in[N_IN]; float* out; unsigned char* ws; int ph_lo, ph_hi; };
typedef const __attribute__((address_space(4))) Params CParams;
__device__ __forceinline__ int otid() { int t = threadIdx.x; asm volatile("" : "+v"(t)); return t; }

__device__ __forceinline__ unsigned f2bf(float f) { unsigned u = __builtin_bit_cast(unsigned, f); return (u + 0x7fffu + ((u >> 16) & 1u)) >> 16; }
__device__ __forceinline__ unsigned pk2(float lo, float hi) { return f2bf(lo) | (f2bf(hi) << 16); }
__device__ __forceinline__ float bf2f(unsigned short b) { return __builtin_bit_cast(float, ((unsigned)b) << 16); }
__device__ __forceinline__ float bflo(unsigned w) { return __builtin_bit_cast(float, w << 16); }
__device__ __forceinline__ float bfhi(unsigned w) { return __builtin_bit_cast(float, w & 0xffff0000u); }
__device__ __forceinline__ float wave_sum(float v) {
#pragma unroll
    for (int o = 1; o < 64; o <<= 1) v += __shfl_xor(v, o);
    return v;
}
__device__ __forceinline__ float sigmoidf_(float x) { return __builtin_amdgcn_rcpf(1.0f + __expf(-x)); }
__device__ __forceinline__ float gelu_tanh(float x) {
    const float u = 0.7978845608028654f * (x + 0.044715f * x * x * x);
    const float t = 1.0f - 2.0f * __builtin_amdgcn_rcpf(1.0f + __expf(2.0f * u));
    return 0.5f * x * (1.0f + t);
}
__device__ __forceinline__ float softplusf_(float x) { return x > 15.f ? x : log1pf(__expf(x)); }
__device__ __forceinline__ void lru_coef(float la, float& a, float& mult) {
    a = __expf(la); const float x = 2.0f * la;
    const float ser = -x * (1.0f + x * (0.5f + x * (0.16666667f + x * (0.041666667f + x * (0.0083333333f + x * 0.0013888889f)))));
    const float om = (x > -0.25f) ? ser : (1.0f - a * a);
    mult = sqrtf(om);
}

__device__ __forceinline__ void transpose_item(const float* W, int K, int N, const float* gain, bf16* WT, int dst_row0, LAS float* scr, int k0, int n0, int lane) {
#pragma unroll 8
    for (int i = 0; i < 32; ++i) { const int kk = 2 * i + (lane >> 5); float v = W[(size_t)(k0 + kk) * N + n0 + (lane & 31)]; if (gain) v *= gain[k0 + kk]; scr[kk * 33 + (lane & 31)] = v; }
    asm volatile("s_waitcnt lgkmcnt(0)" ::: "memory");
    const int c = lane & 7;
#pragma unroll
    for (int j = 0; j < 4; ++j) { const int n = (lane >> 3) + 8 * j; const LAS float* s = scr + (8 * c) * 33 + n;
        u32x4 o; o.x = pk2(s[0 * 33], s[1 * 33]); o.y = pk2(s[2 * 33], s[3 * 33]); o.z = pk2(s[4 * 33], s[5 * 33]); o.w = pk2(s[6 * 33], s[7 * 33]);
        *(u32x4*)(WT + (size_t)(dst_row0 + n) * K + k0 + 8 * c) = o; }
    asm volatile("s_waitcnt lgkmcnt(0)" ::: "memory");
}
__device__ __forceinline__ void prologue(CParams& p, LAS unsigned char* lds) {
    const int tid = otid(), lane = tid & 63, wave = tid >> 6;
    const int gw = blockIdx.x * NWAVES + wave, NGW = gridDim.x * NWAVES;
    LAS float* scr = (LAS float*)(lds + wave * 16384);
    unsigned char* ws = p.ws;
    constexpr int I_SQ = 512, I_INN = 1024, I_GU = 1408, PER_LAYER = I_INN + 5 * I_SQ + 3 * I_GU;
    for (int it = gw; it < 2 * PER_LAYER; it += NGW) {
        const int l = it / PER_LAYER; int r = it % PER_LAYER;
        unsigned char* wl = ws + WS_W + (size_t)l * W_LAYER;
        const float* W; const float* gain = nullptr; bf16* WT; int K = D, N = D, mode = 0;
        int off = 0;
        if (r < I_INN) { W = p.in[I_WIN] + (size_t)l * D * DIN; gain = p.in[I_GMIX] + l * D; WT = (bf16*)(wl + WO_IN); N = DIN; }
        else if ((r -= I_INN) < I_SQ) { W = p.in[I_WOUT] + (size_t)l * D * D; WT = (bf16*)(wl + WO_OUT); }
        else if ((r -= I_SQ) < I_SQ) { W = p.in[I_WQ] + (size_t)l * D * D; gain = p.in[I_GATTN] + l * D; WT = (bf16*)(wl + WO_Q); }
        else if ((r -= I_SQ) < I_SQ) { W = p.in[I_WK] + (size_t)l * D * D; gain = p.in[I_GMEM] + l * D; WT = (bf16*)(wl + WO_KV); }
        else if ((r -= I_SQ) < I_SQ) { W = p.in[I_WV] + (size_t)l * D * D; gain = p.in[I_GMEM] + l * D; WT = (bf16*)(wl + WO_KV); off = 1024; }
        else if ((r -= I_SQ) < I_SQ) { W = p.in[I_WO] + (size_t)l * D * D; WT = (bf16*)(wl + WO_O); }
        else if ((r -= I_SQ) < I_GU) { W = p.in[I_WG] + (size_t)l * D * DFF; gain = p.in[I_GFFN] + l * D; WT = (bf16*)(wl + WO_GU); N = DFF; mode = 1; }
        else if ((r -= I_GU) < I_GU) { W = p.in[I_WU] + (size_t)l * D * DFF; gain = p.in[I_GFFN] + l * D; WT = (bf16*)(wl + WO_GU); N = DFF; mode = 2; }
        else { r -= I_GU; W = p.in[I_WD] + (size_t)l * DFF * D; WT = (bf16*)(wl + WO_D); K = DFF; }
        const int nblk = N / 32, kb = r / nblk, nb = r % nblk, k0 = 64 * kb, n0 = 32 * nb;
        int dst0 = n0 + off;
        if (mode) dst0 = (n0 >> 7) * 256 + (n0 & 127) + (mode == 2 ? 128 : 0);
        transpose_item(W, K, N, gain, WT, dst0, scr, k0, n0, lane);
    }
    float* X = (float*)(ws + WS_X); bf16* XB = (bf16*)(ws + WS_XB); float* SSQ = (float*)(ws + WS_SSQ); float* SSQM = (float*)(ws + WS_SSQM); bf16* MEMB = (bf16*)(ws + WS_MEMB);
    for (int m = gw; m < T + MROWS; m += NGW) {
        const bool ismem = m >= T; const int mr = ismem ? m - T : m;
        const float* src = ismem ? p.in[I_MEM] + (size_t)mr * D : (m < TP ? p.in[I_XP] + (size_t)m * D : p.in[I_XS] + (size_t)(m - TP) * D);
        const f32x4* xr = (const f32x4*)src + lane; f32x4 v[4]; float s = 0.f;
#pragma unroll
        for (int j = 0; j < 4; ++j) { v[j] = xr[64 * j]; s += (v[j].x * v[j].x + v[j].y * v[j].y) + (v[j].z * v[j].z + v[j].w * v[j].w); }
        s = wave_sum(s);
        bf16* ob = ismem ? MEMB + (size_t)mr * D : XB + (size_t)m * D;
        unsigned long long* o8 = (unsigned long long*)ob + lane;
#pragma unroll
        for (int j = 0; j < 4; ++j) o8[64 * j] = (unsigned long long)pk2(v[j].x, v[j].y) | ((unsigned long long)pk2(v[j].z, v[j].w) << 32);
        if (!ismem) { f32x4* xo = (f32x4*)(X + (size_t)m * D) + lane;
#pragma unroll
            for (int j = 0; j < 4; ++j) xo[64 * j] = v[j];
            if (lane == 0) SSQ[m] = s; }
        else if (lane == 0) SSQM[mr] = s;
    }
    for (int i = blockIdx.x * NTHREADS + tid; i < 6 * T; i += gridDim.x * NTHREADS) SSQ[T + i] = 0.f;
    bf16* RGW = (bf16*)(ws + WS_RGW);
    for (int i = blockIdx.x * NTHREADS + tid; i < 2 * 2 * 8 * 64 * 64; i += gridDim.x * NTHREADS) {
        const int l = i >> 16, g = (i >> 15) & 1, h = (i >> 12) & 7, j = (i >> 6) & 63, ii = i & 63;
        const float* src = (g ? p.in[I_WX] : p.in[I_WA]) + (size_t)((l * 8 + h) * 64 + ii) * 64 + j;
        RGW[i] = (bf16)f2bf(*src);
    }
    float* SP8 = (float*)(ws + WS_SP8);
    for (int i = blockIdx.x * NTHREADS + tid; i < 2 * DR; i += gridDim.x * NTHREADS) SP8[i] = -8.0f * softplusf_(-p.in[I_LAM][i]);
}

__device__ __forceinline__ void conf_prompt_item(CParams& p, int l, int b, int ck, LAS unsigned char* lds) {
    const int tid = otid(), lane = tid & 63, wave = tid >> 6, c = tid;
    const bf16* U = (const bf16*)(p.ws + WS_U); bf16* YM = (bf16*)(p.ws + WS_YM);
    LAS float* cO = (LAS float*)lds;
    const int t0 = ck * 32; const size_t rowb = (size_t)b * SEQ;
    LAS float* cL = (LAS float*)lds;
#pragma unroll 2
    for (int r = 0; r < 62; ++r) { const int t = t0 - 30 + r; float val = 0.f;
        if (t >= 0) { const bf16* up = U + (rowb + t) * DIN; const float a = bf2f(up[1024 + c]), g = bf2f(up[1536 + c]); val = a * sigmoidf_(g); }
        cL[r * 512 + c] = val;
        if (ck == 63 && r >= 32) p.out[O_PCF + ((size_t)(l * NB + b) * 30 + (r - 32)) * DC + c] = val; }
    const float* wp = p.in[I_CFW] + (size_t)l * 31 * DC + c; const float bias = p.in[I_CFB][l * DC + c];
    float w[31];
#pragma unroll
    for (int j = 0; j < 31; ++j) w[j] = wp[j * DC];
#pragma unroll 1
    for (int t4 = 0; t4 < 32; t4 += 4) { float a0 = bias, a1 = bias, a2 = bias, a3 = bias; const LAS float* cp = cL + t4 * 512 + c;
#pragma unroll
        for (int j = 0; j < 34; ++j) { const float v = cp[j * 512];
            if (j < 31) a0 += w[j] * v;
            if (j >= 1 && j < 32) a1 += w[j - 1] * v;
            if (j >= 2 && j < 33) a2 += w[j - 2] * v;
            if (j >= 3) a3 += w[j - 3] * v; }
        cO[(t4 + 0) * 512 + c] = a0; cO[(t4 + 1) * 512 + c] = a1; cO[(t4 + 2) * 512 + c] = a2; cO[(t4 + 3) * 512 + c] = a3; }
    __syncthreads();
    const f32x4* gp = (const f32x4*)(p.in[I_LNG] + l * DC + lane * 8); const f32x4* bp = (const f32x4*)(p.in[I_LNB] + l * DC + lane * 8);
    const f32x4 g0 = gp[0], g1 = gp[1], b0 = bp[0], b1 = bp[1];
#pragma unroll
    for (int i = 0; i < 4; ++i) { const int t = wave + 8 * i;
        const f32x4 x0 = *(const LAS f32x4*)(cO + t * 512 + lane * 8), x1 = *(const LAS f32x4*)(cO + t * 512 + lane * 8 + 4);
        const float mean = wave_sum((x0.x + x0.y) + (x0.z + x0.w) + (x1.x + x1.y) + (x1.z + x1.w)) * (1.0f / 512.0f);
        const f32x4 d0 = x0 - mean, d1 = x1 - mean;
        const float var = wave_sum((d0.x * d0.x + d0.y * d0.y) + (d0.z * d0.z + d0.w * d0.w) + (d1.x * d1.x + d1.y * d1.y) + (d1.z * d1.z + d1.w * d1.w)) * (1.0f / 512.0f);
        const float rs = rsqrtf(var + EPS);
        f32x4 y0 = d0 * rs * g0 + b0, y1 = d1 * rs * g1 + b1;
#pragma unroll
        for (int j = 0; j < 4; ++j) { y0[j] = y0[j] * sigmoidf_(y0[j]); y1[j] = y1[j] * sigmoidf_(y1[j]); }
        u32x4 o; o.x = pk2(y0.x, y0.y); o.y = pk2(y0.z, y0.w); o.z = pk2(y1.x, y1.y); o.w = pk2(y1.z, y1.w);
        *(u32x4*)(YM + (rowb + t0 + t) * D + 512 + lane * 8) = o; }
    __syncthreads();
}

__device__ __forceinline__ void sample_mixer_item(CParams& p, int l, int sb, LAS unsigned char* lds) {
    const int tid = otid(), lane = tid & 63, wave = tid >> 6, c = tid;
    const bf16* U = (const bf16*)(p.ws + WS_U); bf16* YM = (bf16*)(p.ws + WS_YM);
    LAS float* xcS = (LAS float*)lds;
    LAS float* cS = (LAS float*)(lds + 8192);
    const size_t row0 = (size_t)TP + sb * SS;
    float xp[7];
    { const float* st = p.in[I_SRG] + ((size_t)(l * SB + sb) * 3) * DR + c; xp[0] = st[0]; xp[1] = st[DR]; xp[2] = st[2 * DR]; }
    float gr[4];
#pragma unroll
    for (int t = 0; t < 4; ++t) { const bf16* up = U + (row0 + t) * DIN; xp[3 + t] = bf2f(up[c]); gr[t] = bf2f(up[512 + c]); }
#pragma unroll
    for (int j = 0; j < 3; ++j) p.out[O_SRG + ((size_t)(l * SB + sb) * 3 + j) * DR + c] = xp[4 + j];
    float xc[4];
    { const float* cw = p.in[I_RGCW] + (size_t)l * 4 * DR + c; const float w0 = cw[0], w1 = cw[DR], w2 = cw[2 * DR], w3 = cw[3 * DR], bc = p.in[I_RGCB][l * DR + c];
#pragma unroll
      for (int t = 0; t < 4; ++t) { xc[t] = bc + w0 * xp[t] + w1 * xp[t + 1] + w2 * xp[t + 2] + w3 * xp[t + 3]; xcS[t * 512 + c] = xc[t]; } }
    __syncthreads();
    float ra[4], ia[4];
    { const float ba = p.in[I_BA][l * DR + c], bx = p.in[I_BX][l * DR + c];
#pragma unroll
      for (int t = 0; t < 4; ++t) { ra[t] = ba; ia[t] = bx; }
      const int h = c >> 6, jj = c & 63;
      const float* wa = p.in[I_WA] + (size_t)((l * 8 + h) * 64) * 64 + jj; const float* wx = p.in[I_WX] + (size_t)((l * 8 + h) * 64) * 64 + jj;
#pragma unroll 8
      for (int i = 0; i < 64; ++i) { const float a = wa[i * 64], x = wx[i * 64];
#pragma unroll
          for (int t = 0; t < 4; ++t) { const float xv = xcS[t * 512 + h * 64 + i]; ra[t] += xv * a; ia[t] += xv * x; } } }
    { const float sp8 = ((const float*)(p.ws + WS_SP8))[l * DR + c];
      float hs = p.in[I_SH][(size_t)(l * SB + sb) * DR + c];
#pragma unroll
      for (int t = 0; t < 4; ++t) { const float r = sigmoidf_(ra[t]), ig = sigmoidf_(ia[t]); float a, mult; lru_coef(sp8 * r, a, mult);
          hs = a * hs + mult * (ig * xc[t]);
          YM[(row0 + t) * D + c] = (bf16)f2bf(hs * gelu_tanh(gr[t])); }
      p.out[O_SH + (size_t)(l * SB + sb) * DR + c] = hs; }
    { float cp[34];
      const float* st = p.in[I_SCF] + ((size_t)(l * SB + sb) * 30) * DC + c;
#pragma unroll
      for (int j = 0; j < 30; ++j) cp[j] = st[j * DC];
#pragma unroll
      for (int t = 0; t < 4; ++t) { const bf16* up = U + (row0 + t) * DIN; cp[30 + t] = bf2f(up[1024 + c]) * sigmoidf_(bf2f(up[1536 + c])); }
#pragma unroll
      for (int j = 0; j < 30; ++j) p.out[O_SCF + ((size_t)(l * SB + sb) * 30 + j) * DC + c] = cp[4 + j];
      const float* wp = p.in[I_CFW] + (size_t)l * 31 * DC + c; const float bias = p.in[I_CFB][l * DC + c];
      float a4[4] = {bias, bias, bias, bias};
#pragma unroll
      for (int j = 0; j < 31; ++j) { const float w = wp[j * DC];
#pragma unroll
          for (int t = 0; t < 4; ++t) a4[t] += w * cp[t + j]; }
#pragma unroll
      for (int t = 0; t < 4; ++t) cS[t * 512 + c] = a4[t]; }
    __syncthreads();
    if (wave < 4) { const int t = wave;
        const f32x4* gp = (const f32x4*)(p.in[I_LNG] + l * DC + lane * 8); const f32x4* bp = (const f32x4*)(p.in[I_LNB] + l * DC + lane * 8);
        const f32x4 g0 = gp[0], g1 = gp[1], b0 = bp[0], b1 = bp[1];
        const f32x4 x0 = *(const LAS f32x4*)(cS + t * 512 + lane * 8), x1 = *(const LAS f32x4*)(cS + t * 512 + lane * 8 + 4);
        const float mean = wave_sum((x0.x + x0.y) + (x0.z + x0.w) + (x1.x + x1.y) + (x1.z + x1.w)) * (1.0f / 512.0f);
        const f32x4 d0 = x0 - mean, d1 = x1 - mean;
        const float var = wave_sum((d0.x * d0.x + d0.y * d0.y) + (d0.z * d0.z + d0.w * d0.w) + (d1.x * d1.x + d1.y * d1.y) + (d1.z * d1.z + d1.w * d1.w)) * (1.0f / 512.0f);
        const float rs = rsqrtf(var + EPS);
        f32x4 y0 = d0 * rs * g0 + b0, y1 = d1 * rs * g1 + b1;
#pragma unroll
        for (int j = 0; j < 4; ++j) { y0[j] = y0[j] * sigmoidf_(y0[j]); y1[j] = y1[j] * sigmoidf_(y1[j]); }
        u32x4 o; o.x = pk2(y0.x, y0.y); o.y = pk2(y0.z, y0.w); o.z = pk2(y1.x, y1.y); o.w = pk2(y1.z, y1.w);
        *(u32x4*)(YM + (row0 + t) * D + 512 + lane * 8) = o; }
    __syncthreads();
}

constexpr int XC_PITCH = 1040;
struct RgState { float Hl[4][4][4]; float Pl[4][4][4]; };

__device__ __forceinline__ void rglru_part1(CParams& p, int l, int b, int k, LAS unsigned char* lds, RgState& S) {
    const int tid = otid(), lane = tid & 63, h = tid >> 6, fr = lane & 15, fq = lane >> 4;
    const bf16* U = (const bf16*)(p.ws + WS_U);
    {
        const int c = tid; const float* cw = p.in[I_RGCW] + (size_t)l * 4 * DR + c; const float w0 = cw[0], w1 = cw[DR], w2 = cw[2 * DR], w3 = cw[3 * DR], bc = p.in[I_RGCB][l * DR + c];
        const size_t row = (size_t)b * SEQ + k * 64; float x0 = 0.f, x1 = 0.f, x2 = 0.f;
        if (k > 0) { x0 = bf2f(U[(row - 3) * DIN + c]); x1 = bf2f(U[(row - 2) * DIN + c]); x2 = bf2f(U[(row - 1) * DIN + c]); }
#pragma unroll 8
        for (int t = 0; t < 64; ++t) { const float x3 = bf2f(U[(row + t) * DIN + c]); const float xc = bc + w0 * x0 + w1 * x1 + w2 * x2 + w3 * x3;
            *(LAS bf16*)(lds + t * XC_PITCH + c * 2) = (bf16)f2bf(xc);
            if (k == 31 && t >= 61) p.out[O_PRG + ((size_t)(l * NB + b) * 3 + (t - 61)) * DR + c] = x3;
            x0 = x1; x1 = x2; x2 = x3; }
    }
    __syncthreads();
    const bf16* RGW = (const bf16*)(p.ws + WS_RGW) + (size_t)(l * 2) * 8 * 4096;
    float2* AGG = (float2*)(p.ws + WS_AGG);
#pragma unroll
    for (int ct = 0; ct < 4; ++ct) {
        const int c = h * 64 + 16 * ct + fr;
        bf16x8 wf[2][2];
#pragma unroll
        for (int g = 0; g < 2; ++g)
#pragma unroll
            for (int ks = 0; ks < 2; ++ks) wf[g][ks] = *(const bf16x8*)(RGW + (size_t)((g * 8 + h) * 64 + 16 * ct + fr) * 64 + 32 * ks + 8 * fq);
        const float ba = p.in[I_BA][l * DR + c], bx = p.in[I_BX][l * DR + c], sp8 = ((const float*)(p.ws + WS_SP8))[l * DR + c];
        float Ac = 1.f, Bc = 0.f;
#pragma unroll
        for (int tt = 0; tt < 4; ++tt) {
            const bf16x8 xf0 = *(const LAS bf16x8*)(lds + (16 * tt + fr) * XC_PITCH + (h * 64 + 8 * fq) * 2);
            const bf16x8 xf1 = *(const LAS bf16x8*)(lds + (16 * tt + fr) * XC_PITCH + (h * 64 + 32 + 8 * fq) * 2);
            f32x4 racc = {0.f, 0.f, 0.f, 0.f}, iacc = {0.f, 0.f, 0.f, 0.f};
            racc = __builtin_amdgcn_mfma_f32_16x16x32_bf16(xf0, wf[0][0], racc, 0, 0, 0); racc = __builtin_amdgcn_mfma_f32_16x16x32_bf16(xf1, wf[0][1], racc, 0, 0, 0);
            iacc = __builtin_amdgcn_mfma_f32_16x16x32_bf16(xf0, wf[1][0], iacc, 0, 0, 0); iacc = __builtin_amdgcn_mfma_f32_16x16x32_bf16(xf1, wf[1][1], iacc, 0, 0, 0);
            float hq = 0.f, pq = 1.f;
#pragma unroll
            for (int e = 0; e < 4; ++e) { const float xcv = bf2f(*(const LAS bf16*)(lds + (16 * tt + 4 * fq + e) * XC_PITCH + c * 2));
                const float r = sigmoidf_(racc[e] + ba), ig = sigmoidf_(iacc[e] + bx); float a, mult; lru_coef(sp8 * r, a, mult);
                hq = a * hq + mult * (ig * xcv); pq *= a; S.Hl[ct][tt][e] = hq; S.Pl[ct][tt][e] = pq; }
            float Ai = pq, Bi = hq;
            { const float A1 = __shfl_up(Ai, 16), B1 = __shfl_up(Bi, 16); if (fq >= 1) { Bi = Ai * B1 + Bi; Ai = A1 * Ai; } }
            { const float A2 = __shfl_up(Ai, 32), B2 = __shfl_up(Bi, 32); if (fq >= 2) { Bi = Ai * B2 + Bi; Ai = A2 * Ai; } }
            float Ae = __shfl_up(Ai, 16), Be = __shfl_up(Bi, 16); if (fq == 0) { Ae = 1.f; Be = 0.f; }
            const float Ap = Ac * Ae, Bp = Ae * Bc + Be;
#pragma unroll
            for (int e = 0; e < 4; ++e) { S.Hl[ct][tt][e] += S.Pl[ct][tt][e] * Bp; S.Pl[ct][tt][e] *= Ap; }
            const float At = __shfl(Ai, 48 + fr), Bt = __shfl(Bi, 48 + fr);
            Bc = At * Bc + Bt; Ac = Ac * At;
            asm volatile("" ::: "memory");
        }
        if (fq == 0) AGG[(size_t)(b * 32 + k) * DR + c] = make_float2(Ac, Bc);
    }
}
__device__ __forceinline__ void rglru_part2(CParams& p, int l, int b, int k, const RgState& S) {
    const int tid = otid(), lane = tid & 63, h = tid >> 6, fr = lane & 15, fq = lane >> 4;
    const bf16* U = (const bf16*)(p.ws + WS_U); bf16* YM = (bf16*)(p.ws + WS_YM);
    const float2* AGG = (const float2*)(p.ws + WS_AGG);
#pragma unroll
    for (int ct = 0; ct < 4; ++ct) {
        const int c = h * 64 + 16 * ct + fr; float carry = 0.f;
        for (int kk = 0; kk < k; ++kk) { const float2 ab = AGG[(size_t)(b * 32 + kk) * DR + c]; carry = ab.x * carry + ab.y; }
#pragma unroll
        for (int tt = 0; tt < 4; ++tt)
#pragma unroll
            for (int e = 0; e < 4; ++e) { const float hv = S.Hl[ct][tt][e] + S.Pl[ct][tt][e] * carry;
                const size_t row = (size_t)b * SEQ + k * 64 + 16 * tt + 4 * fq + e;
                const float g = bf2f(U[row * DIN + 512 + c]);
                YM[row * D + c] = (bf16)f2bf(hv * gelu_tanh(g));
                if (k == 31 && tt == 3 && e == 3 && fq == 3) p.out[O_PH + (size_t)(l * NB + b) * DR + c] = hv;
                if (e == 3) asm volatile("" ::: "memory"); }
    }
}

__device__ __forceinline__ void attn_prompt_unit(CParams& p, int l, int b, int h, int qb, LAS unsigned char* lds) {
    const int tid = otid(), lane = tid & 63, wave = tid >> 6, r32 = lane & 31, half = lane >> 5;
    const bf16* QB = (const bf16*)(p.ws + WS_QB); bf16* OB = (bf16*)(p.ws + WS_YM);
    const bf16* KB = (const bf16*)(p.ws + WS_KB) + (size_t)l * MROWS * D; const bf16* VT = (const bf16*)(p.ws + WS_VT) + (size_t)l * MROWS * D;
#pragma unroll 4
    for (int i = 0; i < 16; ++i) { const int idx = tid + 512 * i, key = idx >> 5, ch = idx & 31;
        const u32x4 v = *(const u32x4*)(KB + (size_t)(b * NMEM + key) * D + h * HD + ch * 8);
        *(LAS u32x4*)(lds + key * 512 + ((ch ^ (key & 31)) << 4)) = v; }
    const size_t qrow = (size_t)b * SEQ + qb * 256 + wave * 32 + r32;
    const bf16* qp = QB + qrow * D + h * HD + 8 * half;
    __syncthreads();
    f32x16 acc[8];
#pragma unroll
    for (int kb = 0; kb < 8; ++kb)
#pragma unroll
        for (int j = 0; j < 16; ++j) acc[kb][j] = 0.f;
    bf16x8 qn = *(const bf16x8*)qp;
#pragma unroll 2
    for (int ks = 0; ks < 16; ++ks) { const bf16x8 qf = qn; if (ks < 15) qn = *(const bf16x8*)(qp + (ks + 1) * 16);
#pragma unroll
        for (int kb = 0; kb < 8; ++kb) { const int key = 32 * kb + r32;
            const bf16x8 a = *(const LAS bf16x8*)(lds + key * 512 + (((2 * ks + half) ^ r32) << 4));
            acc[kb] = __builtin_amdgcn_mfma_f32_32x32x16_bf16(a, qf, acc[kb], 0, 0, 0); } }
    float mx = -3.0e38f;
#pragma unroll
    for (int kb = 0; kb < 8; ++kb)
#pragma unroll
        for (int j = 0; j < 16; ++j) mx = fmaxf(mx, acc[kb][j]);
    mx = fmaxf(mx, __shfl_xor(mx, 32));
    float sum = 0.f;
#pragma unroll
    for (int kb = 0; kb < 8; ++kb)
#pragma unroll
        for (int j = 0; j < 16; ++j) { const float e = __builtin_amdgcn_exp2f(acc[kb][j] - mx); acc[kb][j] = e; sum += e; }
    sum += __shfl_xor(sum, 32);
    const float inv = 1.0f / sum;
    bf16x8 pf[8][2];
#pragma unroll
    for (int kb = 0; kb < 8; ++kb)
#pragma unroll
        for (int jj = 0; jj < 2; ++jj) { u32x4 w; w.x = pk2(acc[kb][8 * jj + 0], acc[kb][8 * jj + 1]); w.y = pk2(acc[kb][8 * jj + 2], acc[kb][8 * jj + 3]);
            w.z = pk2(acc[kb][8 * jj + 4], acc[kb][8 * jj + 5]); w.w = pk2(acc[kb][8 * jj + 6], acc[kb][8 * jj + 7]); pf[kb][jj] = __builtin_bit_cast(bf16x8, w); }
    __syncthreads();
#pragma unroll 4
    for (int i = 0; i < 16; ++i) { const int idx = tid + 512 * i, d = idx >> 5, ch = idx & 31;
        const u32x4 v = *(const u32x4*)(VT + ((size_t)((b * NH + h) * HD + d)) * NMEM + ch * 8);
        const int c8 = 2 * ch; u32x2 lo; lo.x = v.x; lo.y = v.y; u32x2 hi; hi.x = v.z; hi.y = v.w;
        *(LAS u32x2*)(lds + d * 512 + ((c8 ^ (d & 63)) << 3)) = lo; *(LAS u32x2*)(lds + d * 512 + (((c8 + 1) ^ (d & 63)) << 3)) = hi; }
    __syncthreads();
#pragma unroll
    for (int db = 0; db < 8; ++db) {
        f32x16 o;
#pragma unroll
        for (int j = 0; j < 16; ++j) o[j] = 0.f;
        const int dim = 32 * db + r32;
#pragma unroll
        for (int kb = 0; kb < 8; ++kb)
#pragma unroll
            for (int jj = 0; jj < 2; ++jj) { const int c8 = 8 * kb + 4 * jj + half;
                const u32x2 lo = *(const LAS u32x2*)(lds + dim * 512 + ((c8 ^ (dim & 63)) << 3)), hi = *(const LAS u32x2*)(lds + dim * 512 + (((c8 + 2) ^ (dim & 63)) << 3));
                u32x4 w; w.x = lo.x; w.y = lo.y; w.z = hi.x; w.w = hi.y;
                o = __builtin_amdgcn_mfma_f32_32x32x16_bf16(__builtin_bit_cast(bf16x8, w), pf[kb][jj], o, 0, 0, 0); }
#pragma unroll
        for (int g = 0; g < 4; ++g) { u32x2 w; w.x = pk2(o[4 * g] * inv, o[4 * g + 1] * inv); w.y = pk2(o[4 * g + 2] * inv, o[4 * g + 3] * inv);
            *(u32x2*)(OB + qrow * D + h * HD + 32 * db + 8 * g + 4 * half) = w; }
    }
    __syncthreads();
}

__device__ __forceinline__ void attn_sample_unit(CParams& p, int l, int sb, int h, LAS unsigned char* lds) {
    const int tid = otid(), lane = tid & 63, wave = tid >> 6;
    const bf16* QB = (const bf16*)(p.ws + WS_QB); bf16* OB = (bf16*)(p.ws + WS_YM);
    const float* CK = p.in[I_CK] + ((size_t)(l * SB + sb) * NMEM) * D + h * HD; const float* CV = p.in[I_CV] + ((size_t)(l * SB + sb) * NMEM) * D + h * HD;
    LAS f32x4* sc = (LAS f32x4*)lds;
    LAS float* oS = (LAS float*)(lds + 4096);
    const size_t row0 = (size_t)TP + sb * SS;
    {
        const int ksub = lane >> 4, dseg = lane & 15;
        f32x4 q[4][4];
#pragma unroll
        for (int t = 0; t < 4; ++t)
#pragma unroll
            for (int jj = 0; jj < 4; ++jj) { const u32x2 w = *(const u32x2*)(QB + (row0 + t) * D + h * HD + jj * 64 + dseg * 4);
                q[t][jj] = (f32x4){bflo(w.x), bfhi(w.x), bflo(w.y), bfhi(w.y)}; }
#pragma unroll 2
        for (int it = 0; it < 8; ++it) { const int key = wave * 32 + it * 4 + ksub;
            f32x4 kv[4];
#pragma unroll
            for (int jj = 0; jj < 4; ++jj) kv[jj] = *(const f32x4*)(CK + (size_t)key * D + jj * 64 + dseg * 4);
            float s[4];
#pragma unroll
            for (int t = 0; t < 4; ++t) { float a = 0.f;
#pragma unroll
                for (int jj = 0; jj < 4; ++jj) a += (kv[jj].x * q[t][jj].x + kv[jj].y * q[t][jj].y) + (kv[jj].z * q[t][jj].z + kv[jj].w * q[t][jj].w);
                a += __shfl_xor(a, 1); a += __shfl_xor(a, 2); a += __shfl_xor(a, 4); a += __shfl_xor(a, 8); s[t] = a; }
            if (dseg == 0) sc[key] = (f32x4){s[0], s[1], s[2], s[3]}; }
    }
    __syncthreads();
    if (wave < 4) { const int t = wave; float v[4]; float mx = -3.0e38f;
#pragma unroll
        for (int j = 0; j < 4; ++j) { v[j] = ((const LAS float*)lds)[(lane * 4 + j) * 4 + t]; mx = fmaxf(mx, v[j]); }
#pragma unroll
        for (int o = 1; o < 64; o <<= 1) mx = fmaxf(mx, __shfl_xor(mx, o));
        float sum = 0.f;
#pragma unroll
        for (int j = 0; j < 4; ++j) { v[j] = __builtin_amdgcn_exp2f(v[j] - mx); sum += v[j]; }
        sum = wave_sum(sum); const float inv = 1.0f / sum;
#pragma unroll
        for (int j = 0; j < 4; ++j) ((LAS float*)lds)[(lane * 4 + j) * 4 + t] = v[j] * inv; }
    __syncthreads();
    { const int d = tid & 255, hf = tid >> 8; f32x4 o = {0.f, 0.f, 0.f, 0.f};
#pragma unroll 8
        for (int m = 0; m < 128; ++m) { const int key = hf * 128 + m; const float v = CV[(size_t)key * D + d]; const f32x4 pr = sc[key]; o += pr * v; }
        if (hf == 1) { oS[d] = o.x; oS[256 + d] = o.y; oS[512 + d] = o.z; oS[768 + d] = o.w; }
        __syncthreads();
        if (hf == 0) { o.x += oS[d]; o.y += oS[256 + d]; o.z += oS[512 + d]; o.w += oS[768 + d];
#pragma unroll
            for (int t = 0; t < 4; ++t) OB[(row0 + t) * D + h * HD + d] = (bf16)f2bf(o[t]); }
    }
    __syncthreads();
}

constexpr int N_PHASES = 18;
__device__ __forceinline__ void phase_body(const int ph, CParams* p0, LAS unsigned char* lds, cg::grid_group& grid) {
        CParams* pq = p0; asm volatile("" : "+s"(pq));
        CParams& p = *pq;
        unsigned char* ws = p.ws;
        float* X = (float*)(ws + WS_X); bf16* XB = (bf16*)(ws + WS_XB); bf16* U = (bf16*)(ws + WS_U); bf16* YM = (bf16*)(ws + WS_YM); bf16* QB = (bf16*)(ws + WS_QB); bf16* HB = (bf16*)(ws + WS_H);
        float* SSQ = (float*)(ws + WS_SSQ); const int bx = blockIdx.x;
        if (ph == 0) { prologue(p, lds); return; }
        if (ph == N_PHASES - 1) {
            const int tdx = otid(), lane = tdx & 63, wave = tdx >> 6; const float* g = p.in[I_GFIN];
            for (int m = bx * NWAVES + wave; m < T; m += GRID * NWAVES) { const float rs = rsqrtf(SSQ[6 * T + m] * (1.0f / 1024.0f) + EPS);
                const f32x4* xr = (const f32x4*)(X + (size_t)m * D) + lane; f32x4* yo = (f32x4*)(p.out + (size_t)m * D) + lane; const f32x4* gp = (const f32x4*)g + lane;
#pragma unroll
                for (int j = 0; j < 4; ++j) yo[64 * j] = xr[64 * j] * rs * gp[64 * j]; }
            return;
        }
        const int l = (ph - 1) >> 3, sub = (ph - 1) & 7;
        unsigned char* wl = ws + WS_W + (size_t)l * W_LAYER;
        if (sub == 0) {
            { pg8::Gemm g{XB, (const bf16*)(wl + WO_IN), T, DIN, D}; pg8::StaticOrder S; S.init(T, DIN, GRID, bx);
              pg8::EpiScaleBf16 E{U, DIN, SSQ + (size_t)(3 * l) * T, 1.0f};
              pg8::gemm_phase<pg8::EpiScaleBf16, pg8::StaticOrder, true, true>(lds, g, S, E); }
            if (l == 0) {
                for (int ll = 0; ll < 2; ++ll) { pg8::Gemm g{(const bf16*)(ws + WS_MEMB), (const bf16*)(ws + WS_W + (size_t)ll * W_LAYER + WO_KV), MROWS, 2048, D};
                    pg8::StaticOrder S; S.init(MROWS, 2048, GRID, (bx + 128 + 64 * ll) & 255);
                    pg8::EpiKV E{p.out + O_PMK + (size_t)ll * MROWS * D, p.out + O_PMV + (size_t)ll * MROWS * D, (bf16*)(ws + WS_KB) + (size_t)ll * MROWS * D, (bf16*)(ws + WS_VT) + (size_t)ll * MROWS * D, (const float*)(ws + WS_SSQM)};
                    pg8::gemm_phase<pg8::EpiKV, pg8::StaticOrder, true, true>(lds, g, S, E); }
            }
        } else if (sub == 1) {
            const int b = bx >> 5, k = bx & 31;
            conf_prompt_item(p, l, b, 2 * k, lds); conf_prompt_item(p, l, b, 2 * k + 1, lds);
            if (bx < SB) sample_mixer_item(p, l, bx, lds);
            RgState S; rglru_part1(p, l, b, k, lds, S);
            grid.sync();
            rglru_part2(p, l, b, k, S);
        } else if (sub == 2) {
            pg8::Gemm g{YM, (const bf16*)(wl + WO_OUT), T, D, D}; pg8::StaticOrder S; S.init(T, D, GRID, bx);
            pg8::EpiRes E{X, XB, SSQ + (size_t)(3 * l + 1) * T};
            pg8::gemm_phase<pg8::EpiRes, pg8::StaticOrder, true, true>(lds, g, S, E);
        } else if (sub == 3) {
            pg8::Gemm g{XB, (const bf16*)(wl + WO_Q), T, D, D}; pg8::StaticOrder S; S.init(T, D, GRID, bx);
            pg8::EpiScaleBf16 E{QB, D, SSQ + (size_t)(3 * l + 1) * T, QSCALE};
            pg8::gemm_phase<pg8::EpiScaleBf16, pg8::StaticOrder, true, true>(lds, g, S, E);
        } else if (sub == 4) {
            for (int u = bx; u < NB * NH * 8; u += GRID) attn_prompt_unit(p, l, u >> 5, (u >> 3) & 3, u & 7, lds);
            for (int u = bx; u < SB * NH; u += GRID) attn_sample_unit(p, l, u >> 2, u & 3, lds);
        } else if (sub == 5) {
            pg8::Gemm g{YM, (const bf16*)(wl + WO_O), T, D, D}; pg8::StaticOrder S; S.init(T, D, GRID, bx);
            pg8::EpiRes E{X, XB, SSQ + (size_t)(3 * l + 2) * T};
            pg8::gemm_phase<pg8::EpiRes, pg8::StaticOrder, true, true>(lds, g, S, E);
        } else if (sub == 6) {
            pg8::Gemm g{XB, (const bf16*)(wl + WO_GU), T, 2 * DFF, D}; pg8::StaticOrder S; S.init(T, 2 * DFF, GRID, bx);
            pg8::EpiGateUp E{HB, DFF, SSQ + (size_t)(3 * l + 2) * T};
            pg8::gemm_phase<pg8::EpiGateUp, pg8::StaticOrder, true, true>(lds, g, S, E);
        } else {
            pg8::Gemm g{HB, (const bf16*)(wl + WO_D), T, D, DFF}; pg8::StaticOrder S; S.init(T, D, GRID, bx);
            pg8::EpiRes E{X, XB, SSQ + (size_t)(3 * l + 3) * T};
            pg8::gemm_phase<pg8::EpiRes, pg8::StaticOrder, true, true>(lds, g, S, E);
        }
}
__global__ void __launch_bounds__(NTHREADS, 2) hymba_fwd(Params p_formal) {
    extern __shared__ __attribute__((aligned(16))) unsigned char lds_raw[];
    LAS unsigned char* lds = (LAS unsigned char*)lds_raw;
    cg::grid_group grid = cg::this_grid();
    if (gridDim.x != GRID) return;
    CParams* p0 = (CParams*)__builtin_amdgcn_kernarg_segment_ptr();
    const int ph_lo = p0->ph_lo, ph_hi = p0->ph_hi;
#define RUN(PH) if (ph_lo <= (PH) && (PH) < ph_hi) { if ((PH) > ph_lo) grid.sync(); phase_body((PH), p0, lds, grid); }
    RUN(0) RUN(1) RUN(2) RUN(3) RUN(4) RUN(5) RUN(6) RUN(7) RUN(8) RUN(9) RUN(10) RUN(11) RUN(12) RUN(13) RUN(14) RUN(15) RUN(16) RUN(17)
#undef RUN
}

#ifndef N_LAUNCH_SPLIT
#define N_LAUNCH_SPLIT 0
#endif
extern "C" void kernel_launch(void* const* d_in, const int* in_sizes, int n_in, void* d_out, int out_size, void* d_ws, size_t ws_size, hipStream_t stream) {
    static int ready = 0;
    if (ready == 0) {
        if (n_in != N_IN || (size_t)out_size != O_END || ws_size < WS_END) { fprintf(stderr, "kernel_launch: unexpected shapes: n_in %d out %d ws %zu\n", n_in, out_size, ws_size); ready = -1; return; }
        if (hipFuncSetAttribute((const void*)hymba_fwd, hipFuncAttributeMaxDynamicSharedMemorySize, LDS_BYTES) != hipSuccess) { fprintf(stderr, "kernel_launch: hipFuncSetAttribute failed\n"); ready = -1; return; }
        int dev = 0, cus = 0, per_cu = 0;
        hipGetDevice(&dev); hipDeviceGetAttribute(&cus, hipDeviceAttributeMultiprocessorCount, dev);
        hipOccupancyMaxActiveBlocksPerMultiprocessor(&per_cu, (const void*)hymba_fwd, NTHREADS, LDS_BYTES);
        if (cus * per_cu < GRID) { fprintf(stderr, "kernel_launch: device holds %d x %d workgroups, need %d resident\n", cus, per_cu, GRID); ready = -1; return; }
        ready = 1;
    }
    if (ready < 0) return;
    Params p{};
    for (int i = 0; i < N_IN; ++i) p.in[i] = (const float*)d_in[i];
    p.out = (float*)d_out; p.ws = (unsigned char*)d_ws;
#if N_LAUNCH_SPLIT
    for (int ph = 0; ph < N_PHASES; ++ph) { p.ph_lo = ph; p.ph_hi = ph + 1; void* args[] = {&p};
        hipError_t e = hipLaunchCooperativeKernel((const void*)hymba_fwd, dim3(GRID), dim3(NTHREADS), args, LDS_BYTES, stream);
        if (e != hipSuccess) { fprintf(stderr, "cooperative launch failed: %s\n", hipGetErrorString(e)); return; } }
#else
    p.ph_lo = 0; p.ph_hi = N_PHASES; void* args[] = {&p};
    hipError_t e = hipLaunchCooperativeKernel((const void*)hymba_fwd, dim3(GRID), dim3(NTHREADS), args, LDS_BYTES, stream);
    if (e != hipSuccess) fprintf(stderr, "cooperative launch failed: %s\n", hipGetErrorString(e));
#endif
}
```

```cpp
#include <hip/hip_runtime.h>
#include <hip/hip_cooperative_groups.h>
#include <cstdio>
#include <cstdint>
namespace cg = cooperative_groups;

namespace pg8 {
#define PG8_LAS __attribute__((address_space(3)))
typedef unsigned short bf16_t;
typedef short bf16x8 __attribute__((ext_vector_type(8)));
typedef float f32x4 __attribute__((ext_vector_type(4)));
typedef unsigned u32x4 __attribute__((ext_vector_type(4)));
constexpr int BM = 256, BK = 64, HALF = 128, HTB = HALF * BK * 2  , STAGE_BYTES = 8 * HTB, NXCD = 8, WGM = 8;

__host__ __device__ __forceinline__ int lds_byte(int r, int c) { const int st = (r >> 4) * 2 + (c >> 5), rr = r & 15, cc = c & 31, ob = rr * 64 + cc * 2; return st * 1024 + (ob ^ (((ob >> 9) & 1) << 5)); }
__host__ __device__ __forceinline__ void stage_rc(int b, int& R, int& C) { const int st = b / 1024, sb = b % 1024, swz = sb ^ (((sb >> 9) & 1) << 5); R = (st >> 1) * 16 + swz / 64; C = (st & 1) * 32 + (swz % 64) / 2; }
__host__ __device__ __forceinline__ int perm32(int rho) { const int n = rho >> 4, i = rho & 15; return 8 * (i >> 2) + 4 * n + (i & 3); }

struct Unit { int pm, pn; };
struct Gemm { const bf16_t* A; const bf16_t* Bt; int M, N, K; };

struct StaticOrder {
    int nM, nN, nwg, G, c;
    __host__ __device__ void init(int M, int N, int G_, int c_) { nM = M / BM; nN = N / BM; nwg = nM * nN; G = G_; c = c_; }
    __host__ __device__ bool next(int i, Unit& u) const {
        const long L = (long)i * G + c; if (L >= nwg) return false;
        int wgid = (int)L; { const int q = nwg / NXCD, r = nwg % NXCD, xcd = wgid % NXCD, off = wgid / NXCD; wgid = (xcd < r ? xcd * (q + 1) : r * (q + 1) + (xcd - r) * q) + off; }
        const int nig = WGM * nN, gid = wgid / nig, fm = gid * WGM, gsz = (nM - fm) < WGM ? (nM - fm) : WGM;
        u.pm = fm + ((wgid % nig) % gsz); u.pn = (wgid % nig) / gsz; return true;
    }
    __device__ __forceinline__ void a_ready(const Unit&) const {}
    __device__ __forceinline__ void done(const Unit&) const {}
};

__device__ __forceinline__ unsigned cvt_pk_bf16(float lo, float hi) { unsigned r; asm volatile("v_cvt_pk_bf16_f32 %0, %1, %2" : "=v"(r) : "v"(lo), "v"(hi)); return r; }
typedef unsigned u32x2 __attribute__((ext_vector_type(2)));
constexpr float RMS_EPS = 1e-6f;

struct EpiScaleBf16 {
    static constexpr bool PERM = true, AFTER_DRAIN = false;
    bf16_t* O; int ldc; const float* ssq; float scale;
    __device__ __forceinline__ void operator()(const f32x4 (&acc)[2][2][4][2], const Unit& u, int wr, int wc, int fr, int fq) const {
        const int row0 = u.pm * BM + wr * 64 + fr, col0 = u.pn * BM + wc * 32 + 8 * fq;
#pragma unroll
        for (int ai = 0; ai < 2; ++ai)
#pragma unroll
            for (int m = 0; m < 4; ++m) { const int row = row0 + ai * HALF + m * 16; const float r = rsqrtf(ssq[row] * (1.0f / 1024.0f) + RMS_EPS) * scale;
                bf16_t* rowp = O + (size_t)row * ldc + col0;
#pragma unroll
                for (int bj = 0; bj < 2; ++bj) { const f32x4 v0 = acc[ai][bj][m][0] * r, v1 = acc[ai][bj][m][1] * r;
                    u32x4 w; w.x = cvt_pk_bf16(v0[0], v0[1]); w.y = cvt_pk_bf16(v0[2], v0[3]); w.z = cvt_pk_bf16(v1[0], v1[1]); w.w = cvt_pk_bf16(v1[2], v1[3]);
                    *(u32x4*)(rowp + bj * HALF) = w; } }
    }
};
struct EpiGateUp {
    static constexpr bool PERM = true, AFTER_DRAIN = false;
    bf16_t* O; int ldc; const float* ssq;
    __device__ __forceinline__ void operator()(const f32x4 (&acc)[2][2][4][2], const Unit& u, int wr, int wc, int fr, int fq) const {
        const int row0 = u.pm * BM + wr * 64 + fr, col0 = u.pn * HALF + wc * 32 + 8 * fq;
#pragma unroll
        for (int ai = 0; ai < 2; ++ai)
#pragma unroll
            for (int m = 0; m < 4; ++m) { const int row = row0 + ai * HALF + m * 16; const float r = rsqrtf(ssq[row] * (1.0f / 1024.0f) + RMS_EPS);
                float o[8];
#pragma unroll
                for (int n = 0; n < 2; ++n)
#pragma unroll
                    for (int j = 0; j < 4; ++j) { const float g = acc[ai][0][m][n][j] * r, up = acc[ai][1][m][n][j] * r;
                        o[n * 4 + j] = g * __builtin_amdgcn_rcpf(1.0f + __expf(-g)) * up; }
                u32x4 w; w.x = cvt_pk_bf16(o[0], o[1]); w.y = cvt_pk_bf16(o[2], o[3]); w.z = cvt_pk_bf16(o[4], o[5]); w.w = cvt_pk_bf16(o[6], o[7]);
                *(u32x4*)(O + (size_t)row * ldc + col0) = w; }
    }
};
struct EpiRes {
    static constexpr bool PERM = false, AFTER_DRAIN = false;
    float* X; bf16_t* XB; float* ssq_out;
    __device__ __forceinline__ void operator()(const f32x4 (&acc)[2][2][4][2], const Unit& u, int wr, int wc, int fr, int fq) const {
        const int row0 = u.pm * BM + wr * 64 + fr, col0 = u.pn * BM + wc * 32 + 4 * fq;
#pragma unroll
        for (int ai = 0; ai < 2; ++ai)
#pragma unroll
            for (int m = 0; m < 4; ++m) { const int row = row0 + ai * HALF + m * 16; const size_t off = (size_t)row * 1024 + col0; float s = 0.f;
#pragma unroll
                for (int bj = 0; bj < 2; ++bj)
#pragma unroll
                    for (int n = 0; n < 2; ++n) { const f32x4 xo = *(const f32x4*)(X + off + bj * HALF + n * 16); const f32x4 xn = xo + acc[ai][bj][m][n];
                        *(f32x4*)(X + off + bj * HALF + n * 16) = xn;
                        u32x2 w; w.x = cvt_pk_bf16(xn[0], xn[1]); w.y = cvt_pk_bf16(xn[2], xn[3]); *(u32x2*)(XB + off + bj * HALF + n * 16) = w;
                        s += (xn[0] * xn[0] + xn[1] * xn[1]) + (xn[2] * xn[2] + xn[3] * xn[3]); }
                s += __shfl_xor(s, 16); s += __shfl_xor(s, 32);
                if (fq == 0) atomicAdd(ssq_out + row, s);
                asm volatile("" ::: "memory"); }
    }
};
struct EpiKV {
    static constexpr bool PERM = false, AFTER_DRAIN = false;
    float* outK; float* outV; bf16_t* KB; bf16_t* VT; const float* ssq;
    __device__ __forceinline__ void operator()(const f32x4 (&acc)[2][2][4][2], const Unit& u, int wr, int wc, int fr, int fq) const {
        const int row0 = u.pm * BM + wr * 64 + fr; const bool isV = u.pn >= 4; const int col0 = (u.pn & 3) * BM + wc * 32 + 4 * fq;
        float* outp = isV ? outV : outK;
#pragma unroll
        for (int ai = 0; ai < 2; ++ai)
#pragma unroll
            for (int m = 0; m < 4; ++m) { const int row = row0 + ai * HALF + m * 16; const float r = rsqrtf(ssq[row] * (1.0f / 1024.0f) + RMS_EPS);
#pragma unroll
                for (int bj = 0; bj < 2; ++bj)
#pragma unroll
                    for (int n = 0; n < 2; ++n) { const int c = col0 + bj * HALF + n * 16; const f32x4 v = acc[ai][bj][m][n] * r;
                        *(f32x4*)(outp + (size_t)row * 1024 + c) = v;
                        if (!isV) { u32x2 w; w.x = cvt_pk_bf16(v[0], v[1]); w.y = cvt_pk_bf16(v[2], v[3]); *(u32x2*)(KB + (size_t)row * 1024 + c) = w; }
                        else { const int b = row >> 8, mm = row & 255, h = c >> 8, d = c & 255; bf16_t* vp = VT + ((size_t)((b * 4 + h) * 256 + d)) * 256 + mm;
                            const unsigned w0 = cvt_pk_bf16(v[0], v[1]), w1 = cvt_pk_bf16(v[2], v[3]);
                            vp[0] = (bf16_t)(w0 & 0xffffu); vp[256] = (bf16_t)(w0 >> 16); vp[512] = (bf16_t)(w1 & 0xffffu); vp[768] = (bf16_t)(w1 >> 16); } } }
    }
};

template <class Epi, class Sched, bool ALIGN_EPI = false, bool SP2 = false>
__device__ __forceinline__ void gemm_phase(PG8_LAS unsigned char* lds, const Gemm g, const Sched& S, const Epi& E) {
    int tid = threadIdx.x; asm volatile("" : "+v"(tid));
    const int wid = __builtin_amdgcn_readfirstlane(tid >> 6), lane = tid & 63, wr = wid >> 2, wc = wid & 3, fr = lane & 15, fq = lane >> 4;
    const int K = g.K, nt = K / BK;
    unsigned voffA[2], voffB[2];
#pragma unroll
    for (int i = 0; i < 2; ++i) { int R, C; stage_rc(tid * 16 + i * 8192, R, C); const int Rb = Epi::PERM ? ((R & ~31) + perm32(R & 31)) : R;
        voffA[i] = (unsigned)(R * K + C) * 2u; voffB[i] = (unsigned)(Rb * K + C) * 2u; }
    const size_t kstep = (size_t)(BK * 2);
    const size_t hstep = (size_t)HALF * K * 2;
    const size_t tstep = 2 * hstep;
    const unsigned ldsw = (unsigned)wid * 1024u;
    const int aoff = lds_byte(wr * 64 + fr, fq * 8), boff = lds_byte(wc * 32 + fr, fq * 8);
#define PG8_SA(b, h) (((b) * 2 + (h)) * HTB)
#define PG8_SB(b, h) ((4 + (b) * 2 + (h)) * HTB)
#define PG8_STAGE(bufoff, gbase, voff) do { _Pragma("unroll") for (int _i = 0; _i < 2; ++_i) \
        __builtin_amdgcn_global_load_lds((const unsigned*)((const char*)(gbase) + (voff)[_i]), (PG8_LAS unsigned*)(lds + (bufoff) + ldsw + _i * 8192), 16, 0, 0); } while (0)
#define PG8_LDA(dst, b, h) do { _Pragma("unroll") for (int m = 0; m < 4; ++m) _Pragma("unroll") for (int k = 0; k < 2; ++k) dst[m][k] = *(const PG8_LAS bf16x8*)(lds + PG8_SA(b, h) + aoff + m * 2048 + k * 1024); } while (0)
#define PG8_LDB(dst, b, h) do { _Pragma("unroll") for (int n = 0; n < 2; ++n) _Pragma("unroll") for (int k = 0; k < 2; ++k) dst[n][k] = *(const PG8_LAS bf16x8*)(lds + PG8_SB(b, h) + boff + n * 2048 + k * 1024); } while (0)
#define PG8_MMA(ai, bj, At, Bt) do { __builtin_amdgcn_s_setprio(1); _Pragma("unroll") for (int m = 0; m < 4; ++m) _Pragma("unroll") for (int n = 0; n < 2; ++n) _Pragma("unroll") for (int k = 0; k < 2; ++k) \
        acc[ai][bj][m][n] = __builtin_amdgcn_mfma_f32_16x16x32_bf16(Bt[n][k], At[m][k], acc[ai][bj][m][n], 0, 0, 0); __builtin_amdgcn_s_setprio(0); } while (0)
#define PG8_WAIT_V(n) asm volatile("s_waitcnt vmcnt(" #n ")" ::: "memory")
#define PG8_WAIT_L(n) asm volatile("s_waitcnt lgkmcnt(" #n ")" ::: "memory")
#define PG8_BAR __builtin_amdgcn_s_barrier()
#define PG8_SCHED __builtin_amdgcn_sched_barrier(0)
    Unit cur, nxt; int ui = 0;
    if (!S.next(0, cur)) return;
    f32x4 acc[2][2][4][2];
#pragma unroll
    for (int a = 0; a < 2; ++a)
#pragma unroll
        for (int b = 0; b < 2; ++b)
#pragma unroll
            for (int m = 0; m < 4; ++m)
#pragma unroll
                for (int n = 0; n < 2; ++n) acc[a][b][m][n] = (f32x4){0.f, 0.f, 0.f, 0.f};
    bf16x8 At[4][2], B0[2][2], B1[2][2];
    const char* cA = (const char*)g.A + (size_t)cur.pm * tstep; const char* cB = (const char*)g.Bt + (size_t)cur.pn * tstep;
    S.a_ready(cur);
    if constexpr (SP2) {
        PG8_STAGE(PG8_SB(0, 0), cB, voffB); PG8_STAGE(PG8_SB(0, 1), cB + hstep, voffB); PG8_STAGE(PG8_SA(0, 0), cA, voffA); PG8_STAGE(PG8_SA(0, 1), cA + hstep, voffA);
        if (wr == 1) PG8_BAR;
        PG8_WAIT_V(2); PG8_BAR;
        PG8_STAGE(PG8_SB(1, 0), cB + kstep, voffB); PG8_STAGE(PG8_SA(1, 0), cA + kstep, voffA); PG8_STAGE(PG8_SB(1, 1), cB + hstep + kstep, voffB);
        PG8_WAIT_V(6); PG8_BAR;
    } else {
        PG8_STAGE(PG8_SB(0, 0), cB, voffB); PG8_STAGE(PG8_SA(0, 0), cA, voffA); PG8_STAGE(PG8_SB(0, 1), cB + hstep, voffB); PG8_STAGE(PG8_SA(0, 1), cA + hstep, voffA);
        if (wr == 1) PG8_BAR;
        PG8_WAIT_V(4); PG8_BAR;
        PG8_STAGE(PG8_SB(1, 0), cB + kstep, voffB); PG8_STAGE(PG8_SA(1, 0), cA + kstep, voffA); PG8_STAGE(PG8_SB(1, 1), cB + hstep + kstep, voffB);
        PG8_WAIT_V(6); PG8_BAR;
    }
    for (;;) {
        const bool has_next = S.next(ui + 1, nxt);
        const char* nA = has_next ? (const char*)g.A + (size_t)nxt.pm * tstep : cA; const char* nB = has_next ? (const char*)g.Bt + (size_t)nxt.pn * tstep : cB;
        for (int t = 0; t < nt; t += 2) {
            const bool last = (t == nt - 2);
            const char* a1 = cA + (size_t)(t + 1) * kstep;
            const char* a2 = last ? nA : cA + (size_t)(t + 2) * kstep; const char* b2 = last ? nB : cB + (size_t)(t + 2) * kstep;
            const char* a3 = a2 + kstep; const char* b3 = b2 + kstep;
            if (last && has_next) S.a_ready(nxt);
            if constexpr (SP2) {
            PG8_LDB(B0, 0, 0); PG8_LDB(B1, 0, 1); PG8_SCHED; PG8_LDA(At, 0, 0); PG8_STAGE(PG8_SA(1, 1), a1 + hstep, voffA);
            PG8_WAIT_V(8); PG8_WAIT_L(0); PG8_BAR; PG8_MMA(0, 0, At, B0); PG8_MMA(0, 1, At, B1); PG8_BAR; PG8_SCHED;
            PG8_LDA(At, 0, 1); PG8_STAGE(PG8_SB(0, 0), b2, voffB); PG8_STAGE(PG8_SB(0, 1), b2 + hstep, voffB); PG8_STAGE(PG8_SA(0, 0), a2, voffA);
            PG8_WAIT_V(8); PG8_WAIT_L(0); PG8_BAR; PG8_MMA(1, 0, At, B0); PG8_MMA(1, 1, At, B1); PG8_BAR; PG8_SCHED;
            PG8_LDB(B0, 1, 0); PG8_LDB(B1, 1, 1); PG8_SCHED; PG8_LDA(At, 1, 0); PG8_STAGE(PG8_SA(0, 1), a2 + hstep, voffA);
            PG8_WAIT_V(8); PG8_WAIT_L(0); PG8_BAR; PG8_MMA(0, 0, At, B0); PG8_MMA(0, 1, At, B1); PG8_BAR; PG8_SCHED;
            PG8_LDA(At, 1, 1); PG8_STAGE(PG8_SB(1, 0), b3, voffB); PG8_STAGE(PG8_SB(1, 1), b3 + hstep, voffB); PG8_STAGE(PG8_SA(1, 0), a3, voffA);
            PG8_WAIT_V(8); PG8_WAIT_L(0); PG8_BAR; PG8_MMA(1, 0, At, B0); PG8_MMA(1, 1, At, B1); PG8_BAR; PG8_SCHED;
            } else {
            PG8_LDB(B0, 0, 0); PG8_SCHED; PG8_LDA(At, 0, 0); PG8_STAGE(PG8_SA(1, 1), a1 + hstep, voffA);
            PG8_WAIT_L(8); PG8_BAR; PG8_WAIT_L(0); PG8_MMA(0, 0, At, B0); PG8_BAR; PG8_SCHED;
            PG8_LDB(B1, 0, 1); PG8_STAGE(PG8_SB(0, 0), b2, voffB);
            PG8_BAR; PG8_WAIT_L(0); PG8_MMA(0, 1, At, B1); PG8_BAR;
            PG8_LDA(At, 0, 1); PG8_STAGE(PG8_SA(0, 0), a2, voffA);
            PG8_BAR; PG8_WAIT_L(0); PG8_MMA(1, 0, At, B0); PG8_BAR; PG8_SCHED;
            PG8_STAGE(PG8_SB(0, 1), b2 + hstep, voffB);
            PG8_WAIT_V(6); PG8_BAR; PG8_MMA(1, 1, At, B1); PG8_BAR;
            PG8_LDB(B0, 1, 0); PG8_SCHED; PG8_LDA(At, 1, 0); PG8_STAGE(PG8_SA(0, 1), a2 + hstep, voffA);
            PG8_WAIT_L(8); PG8_BAR; PG8_WAIT_L(0); PG8_MMA(0, 0, At, B0); PG8_BAR; PG8_SCHED;
            PG8_LDB(B1, 1, 1); PG8_STAGE(PG8_SB(1, 0), b3, voffB);
            PG8_BAR; PG8_WAIT_L(0); PG8_MMA(0, 1, At, B1); PG8_BAR;
            PG8_LDA(At, 1, 1); PG8_STAGE(PG8_SA(1, 0), a3, voffA);
            PG8_BAR; PG8_WAIT_L(0); PG8_MMA(1, 0, At, B0); PG8_BAR; PG8_SCHED;
            PG8_STAGE(PG8_SB(1, 1), b3 + hstep, voffB);
            PG8_WAIT_V(6); PG8_BAR; PG8_MMA(1, 1, At, B1); PG8_BAR;
            }
        }
        if constexpr (ALIGN_EPI) { if (wr == 0) PG8_BAR; }
        if constexpr (!Epi::AFTER_DRAIN) { E(acc, cur, wr, wc, fr, fq); S.done(cur); }
        if (!has_next) break;
#pragma unroll
        for (int a = 0; a < 2; ++a)
#pragma unroll
            for (int b = 0; b < 2; ++b)
#pragma unroll
                for (int m = 0; m < 4; ++m)
#pragma unroll
                    for (int n = 0; n < 2; ++n) acc[a][b][m][n] = (f32x4){0.f, 0.f, 0.f, 0.f};
        cur = nxt; cA = nA; cB = nB; ++ui;
        if constexpr (ALIGN_EPI) { if (wr == 1) PG8_BAR; }
    }
    PG8_WAIT_V(0);
    if constexpr (!ALIGN_EPI) { if (wr == 0) PG8_BAR; }
    PG8_BAR;
    if constexpr (Epi::AFTER_DRAIN) { E.fused(acc, cur, wr, wc, fr, fq, lds, wid, lane); S.done(cur); }
#undef PG8_SA
#undef PG8_SB
#undef PG8_STAGE
#undef PG8_LDA
#undef PG8_LDB
#undef PG8_MMA
#undef PG8_WAIT_V
#undef PG8_WAIT_L
#undef PG8_BAR
#undef PG8_SCHED
}
}

#define LAS __attribute__((address_space(3)))
typedef unsigned short bf16;
typedef short bf16x8 __attribute__((ext_vector_type(8)));
typedef short bf16x4 __attribute__((ext_vector_type(4)));
typedef float f32x4 __attribute__((ext_vector_type(4)));
typedef float f32x2 __attribute__((ext_vector_type(2)));
typedef float f32x16 __attribute__((ext_vector_type(16)));
typedef unsigned u32x4 __attribute__((ext_vector_type(4)));
typedef unsigned u32x2 __attribute__((ext_vector_type(2)));

constexpr int D = 1024, NB = 8, SEQ = 2048, TP = NB * SEQ, SB = 128, SS = 4, TS = SB * SS, T = TP + TS;
constexpr int DR = 512, DC = 512, DIN = 2048, NMEM = 256, NH = 4, HD = 256, DFF = 2816, MROWS = NB * NMEM;
constexpr int NTHREADS = 512, NWAVES = 8, GRID = 256;
constexpr float EPS = 1e-6f;
constexpr float QSCALE = 0.0625f * 1.4426950408889634f;

enum { I_XP = 0, I_XS, I_SH, I_SRG, I_SCF, I_CK, I_CV, I_MEM, I_GMIX, I_WIN, I_RGCW, I_RGCB, I_WA, I_BA, I_WX, I_BX, I_LAM, I_CFW, I_CFB, I_LNG, I_LNB, I_WOUT,
       I_GATTN, I_GMEM, I_WQ, I_WK, I_WV, I_WO, I_GFFN, I_WG, I_WU, I_WD, I_GFIN, N_IN };
constexpr size_t O_YP = 0, O_YS = (size_t)TP * D, O_PH = O_YS + (size_t)TS * D, O_PRG = O_PH + 2 * NB * DR, O_PCF = O_PRG + 2 * NB * 3 * DR, O_PMK = O_PCF + 2 * NB * 30 * DC,
                 O_PMV = O_PMK + (size_t)2 * MROWS * D, O_SH = O_PMV + (size_t)2 * MROWS * D, O_SRG = O_SH + 2 * SB * DR, O_SCF = O_SRG + 2 * SB * 3 * DR, O_END = O_SCF + (size_t)2 * SB * 30 * DC;
constexpr size_t MiB = 1u << 20;
constexpr size_t WS_SSQ = 0, WS_SSQM = 512 * 1024, WS_SP8 = 640 * 1024, WS_BAR = 768 * 1024, BAR_BYTES = 16384, WS_AGG = 1 * MiB, WS_RGW = 2 * MiB, WS_W = 4 * MiB, W_LAYER = 31 * MiB;
constexpr size_t WO_IN = 0, WO_OUT = 4 * MiB, WO_Q = 6 * MiB, WO_KV = 8 * MiB, WO_O = 12 * MiB, WO_GU = 14 * MiB, WO_D = 25 * MiB;
constexpr size_t WS_X = 68 * MiB, WS_XB = 134 * MiB, WS_U = 167 * MiB, WS_YM = 233 * MiB, WS_QB = 266 * MiB, WS_H = 299 * MiB, WS_MEMB = 390 * MiB, WS_KB = 394 * MiB, WS_VT = 402 * MiB, WS_END = 410 * MiB;
constexpr int LDS_BYTES = 147456, LDS_BARW = LDS_BYTES - 64;

struct Params { const float* in[N_IN]; float* out; unsigned char* ws; int ph_lo, ph_hi; };
typedef const __attribute__((address_space(4))) Params CParams;
__device__ __forceinline__ int otid() { int t = threadIdx.x; asm volatile("" : "+v"(t)); return t; }

__device__ __forceinline__ unsigned f2bf(float f) { unsigned u = __builtin_bit_cast(unsigned, f); return (u + 0x7fffu + ((u >> 16) & 1u)) >> 16; }
__device__ __forceinline__ unsigned pk2(float lo, float hi) { return f2bf(lo) | (f2bf(hi) << 16); }
__device__ __forceinline__ float bf2f(unsigned short b) { return __builtin_bit_cast(float, ((unsigned)b) << 16); }
__device__ __forceinline__ float bflo(unsigned w) { return __builtin_bit_cast(float, w << 16); }
__device__ __forceinline__ float bfhi(unsigned w) { return __builtin_bit_cast(float, w & 0xffff0000u); }
__device__ __forceinline__ float wave_sum(float v) {
#pragma unroll
    for (int o = 1; o < 64; o <<= 1) v += __shfl_xor(v, o);
    return v;
}
__device__ __forceinline__ float sigmoidf_(float x) { return __builtin_amdgcn_rcpf(1.0f + __expf(-x)); }
__device__ __forceinline__ float gelu_tanh(float x) {
    const float u = 0.7978845608028654f * (x + 0.044715f * x * x * x);
    const float t = 1.0f - 2.0f * __builtin_amdgcn_rcpf(1.0f + __expf(2.0f * u));
    return 0.5f * x * (1.0f + t);
}
__device__ __forceinline__ float softplusf_(float x) { return x > 15.f ? x : log1pf(__expf(x)); }
__device__ __forceinline__ void lru_coef(float la, float& a, float& mult) {
    a = __expf(la); const float x = 2.0f * la;
    const float ser = -x * (1.0f + x * (0.5f + x * (0.16666667f + x * (0.041666667f + x * (0.0083333333f + x * 0.0013888889f)))));
    const float om = (x > -0.25f) ? ser : (1.0f - a * a);
    mult = sqrtf(om);
}

#define XB_TMO      128
#define XB_XCNT(j)  (256  + 64 * (j))
#define XB_XSUB(j)  (1280 + 64 * (j))
#define XB_XGEN(j)  (2304 + 64 * (j))
#define XB_TOP      3328
#define XB_TOPGEN   3392
#define XCD_BAR_WORDS 3456
#define XB_SPIN_CAP (1u << 18)

__device__ __forceinline__ unsigned xb_ld(unsigned* p)              { return __hip_atomic_load(p, __ATOMIC_RELAXED, __HIP_MEMORY_SCOPE_AGENT); }
__device__ __forceinline__ unsigned xb_add(unsigned* p, unsigned v) { return __hip_atomic_fetch_add(p, v, __ATOMIC_RELAXED, __HIP_MEMORY_SCOPE_AGENT); }
__device__ __forceinline__ unsigned xb_xcc_id() { return (unsigned)__builtin_amdgcn_s_getreg((3 << 11) | 20) & 0xFu; }
#define XB_SPIN(cond, bar) do { unsigned _sp = 0; while (cond) { __builtin_amdgcn_s_sleep(1); \
    if ((++_sp & 255u) == 0u) { if (xb_ld(&(bar)[XB_TMO])) break; if (_sp > XB_SPIN_CAP) { atomicAdd(&(bar)[XB_TMO], 1u); break; } } } } while (0)

struct XcdBarrier {
    unsigned* bar; unsigned x;
    volatile LAS unsigned* st;
};

__device__ __forceinline__ XcdBarrier xcd_barrier_post(unsigned* bar, volatile LAS unsigned* st) {
    XcdBarrier b; b.bar = bar; b.x = xb_xcc_id(); b.st = st;
    if (threadIdx.x == 0) (void)xb_add(&bar[XB_XCNT(b.x)], 1u);
    return b;
}
__device__ __forceinline__ void xcd_barrier_complete(unsigned* bar, unsigned x, unsigned& nloc, unsigned& nx) {
    const unsigned G = gridDim.x * gridDim.y * gridDim.z;
    unsigned sum, cnt, mine, sp = 0u;
    for (;;) {
        sum = 0u; cnt = 0u; mine = 0u;
#pragma unroll
        for (unsigned j = 0; j < 16; ++j) { const unsigned c = xb_ld(&bar[XB_XCNT(j)]); sum += c; cnt += (c > 0u) ? 1u : 0u; mine = (j == x) ? c : mine; }
        if (sum == G) break;
        __builtin_amdgcn_s_sleep(1);
        if ((++sp & 255u) == 0u) { if (xb_ld(&bar[XB_TMO])) break; if (sp > XB_SPIN_CAP) { atomicAdd(&bar[XB_TMO], 1u); break; } }
    }
    nloc = mine > 0u ? mine : 1u; nx = cnt > 0u ? cnt : 1u;
}

__device__ __forceinline__ void xcd_barrier(const XcdBarrier& b) {
    asm volatile("s_waitcnt vmcnt(0)" ::: "memory");
    __syncthreads();
    if (threadIdx.x == 0) {
        unsigned* bar = b.bar;
        __builtin_amdgcn_s_waitcnt(0);
        unsigned nloc = b.st[0], nx = b.st[1];
        if (nloc == 0u) { xcd_barrier_complete(bar, b.x, nloc, nx); b.st[0] = nloc; b.st[1] = nx; }
        const unsigned old = xb_add(&bar[XB_XSUB(b.x)], 1u);
        const unsigned gen = old / nloc;
        if (old + 1u == (gen + 1u) * nloc) {
            __builtin_amdgcn_fence(__ATOMIC_RELEASE, "agent");
            asm volatile("s_waitcnt vmcnt(0)" ::: "memory");
            const unsigned og = xb_add(&bar[XB_TOP], 1u);
            const unsigned tg = og / nx;
            if (og + 1u == (tg + 1u) * nx) xb_add(&bar[XB_TOPGEN], 1u);
            else XB_SPIN(xb_ld(&bar[XB_TOPGEN]) == tg, bar);
            __builtin_amdgcn_fence(__ATOMIC_ACQUIRE, "agent");
            xb_add(&bar[XB_XGEN(b.x)], 1u);
            asm volatile("s_waitcnt vmcnt(0)" ::: "memory");
        } else {
            XB_SPIN(xb_ld(&bar[XB_XGEN(b.x)]) == gen, bar);
            __builtin_amdgcn_fence(__ATOMIC_ACQUIRE, "agent");
            asm volatile("s_waitcnt vmcnt(0)" ::: "memory");
        }
    }
    __syncthreads();
}

__device__ __forceinline__ void transpose_item(const float* W, int K, int N, const float* gain, bf16* WT, int dst_row0, LAS float* scr, int k0, int n0, int lane) {
    const int kr = lane >> 4, nq = lane & 15;
    f32x4 v[16];
#pragma unroll
    for (int i = 0; i < 16; ++i) v[i] = *(const f32x4*)(W + (size_t)(k0 + 4 * i + kr) * N + n0 + 4 * nq);
#pragma unroll
    for (int i = 0; i < 16; ++i) { const int kk = 4 * i + kr; const float g = gain ? gain[k0 + kk] : 1.0f; LAS float* d = scr + kk * 65 + 4 * nq;
        d[0] = v[i].x * g; d[1] = v[i].y * g; d[2] = v[i].z * g; d[3] = v[i].w * g; }
    asm volatile("s_waitcnt lgkmcnt(0)" ::: "memory");
    const int c = lane & 7;
#pragma unroll
    for (int j = 0; j < 8; ++j) { const int n = (lane >> 3) + 8 * j; const LAS float* s = scr + (8 * c) * 65 + n;
        u32x4 o; o.x = pk2(s[0 * 65], s[1 * 65]); o.y = pk2(s[2 * 65], s[3 * 65]); o.z = pk2(s[4 * 65], s[5 * 65]); o.w = pk2(s[6 * 65], s[7 * 65]);
        *(u32x4*)(WT + (size_t)(dst_row0 + n) * K + k0 + 8 * c) = o; }
    asm volatile("s_waitcnt lgkmcnt(0)" ::: "memory");
}
__device__ __forceinline__ void prologue(CParams& p, LAS unsigned char* lds) {
    const int tid = otid(), lane = tid & 63, wave = tid >> 6;
    const int gw = blockIdx.x * NWAVES + wave, NGW = gridDim.x * NWAVES;
    LAS float* scr = (LAS float*)(lds + wave * 18432);
    unsigned char* ws = p.ws;
    constexpr int I_SQ = 256, I_INN = 512, I_GU = 704, PER_LAYER = I_INN + 5 * I_SQ + 3 * I_GU;
    for (int it = gw; it < 2 * PER_LAYER; it += NGW) {
        const int l = it / PER_LAYER; int r = it % PER_LAYER;
        unsigned char* wl = ws + WS_W + (size_t)l * W_LAYER;
        const float* W; const float* gain = nullptr; bf16* WT; int K = D, N = D, mode = 0;
        int off = 0;
        if (r < I_INN) { W = p.in[I_WIN] + (size_t)l * D * DIN; gain = p.in[I_GMIX] + l * D; WT = (bf16*)(wl + WO_IN); N = DIN; }
        else if ((r -= I_INN) < I_SQ) { W = p.in[I_WOUT] + (size_t)l * D * D; WT = (bf16*)(wl + WO_OUT); }
        else if ((r -= I_SQ) < I_SQ) { W = p.in[I_WQ] + (size_t)l * D * D; gain = p.in[I_GATTN] + l * D; WT = (bf16*)(wl + WO_Q); }
        else if ((r -= I_SQ) < I_SQ) { W = p.in[I_WK] + (size_t)l * D * D; gain = p.in[I_GMEM] + l * D; WT = (bf16*)(wl + WO_KV); }
        else if ((r -= I_SQ) < I_SQ) { W = p.in[I_WV] + (size_t)l * D * D; gain = p.in[I_GMEM] + l * D; WT = (bf16*)(wl + WO_KV); off = 1024; }
        else if ((r -= I_SQ) < I_SQ) { W = p.in[I_WO] + (size_t)l * D * D; WT = (bf16*)(wl + WO_O); }
        else if ((r -= I_SQ) < I_GU) { W = p.in[I_WG] + (size_t)l * D * DFF; gain = p.in[I_GFFN] + l * D; WT = (bf16*)(wl + WO_GU); N = DFF; mode = 1; }
        else if ((r -= I_GU) < I_GU) { W = p.in[I_WU] + (size_t)l * D * DFF; gain = p.in[I_GFFN] + l * D; WT = (bf16*)(wl + WO_GU); N = DFF; mode = 2; }
        else { r -= I_GU; W = p.in[I_WD] + (size_t)l * DFF * D; WT = (bf16*)(wl + WO_D); K = DFF; }
        const int nblk = N / 64, kb = r / nblk, nb = r % nblk, k0 = 64 * kb, n0 = 64 * nb;
        int dst0 = n0 + off;
        if (mode) dst0 = (n0 >> 7) * 256 + (n0 & 127) + (mode == 2 ? 128 : 0);
        transpose_item(W, K, N, gain, WT, dst0, scr, k0, n0, lane);
    }
    float* X = (float*)(ws + WS_X); bf16* XB = (bf16*)(ws + WS_XB); float* SSQ = (float*)(ws + WS_SSQ); float* SSQM = (float*)(ws + WS_SSQM); bf16* MEMB = (bf16*)(ws + WS_MEMB);
    for (int m = gw; m < T + MROWS; m += NGW) {
        const bool ismem = m >= T; const int mr = ismem ? m - T : m;
        const float* src = ismem ? p.in[I_MEM] + (size_t)mr * D : (m < TP ? p.in[I_XP] + (size_t)m * D : p.in[I_XS] + (size_t)(m - TP) * D);
        const f32x4* xr = (const f32x4*)src + lane; f32x4 v[4]; float s = 0.f;
#pragma unroll
        for (int j = 0; j < 4; ++j) { v[j] = xr[64 * j]; s += (v[j].x * v[j].x + v[j].y * v[j].y) + (v[j].z * v[j].z + v[j].w * v[j].w); }
        s = wave_sum(s);
        bf16* ob = ismem ? MEMB + (size_t)mr * D : XB + (size_t)m * D;
        unsigned long long* o8 = (unsigned long long*)ob + lane;
#pragma unroll
        for (int j = 0; j < 4; ++j) o8[64 * j] = (unsigned long long)pk2(v[j].x, v[j].y) | ((unsigned long long)pk2(v[j].z, v[j].w) << 32);
        if (!ismem) { f32x4* xo = (f32x4*)(X + (size_t)m * D) + lane;
#pragma unroll
            for (int j = 0; j < 4; ++j) xo[64 * j] = v[j];
            if (lane == 0) SSQ[m] = s; }
        else if (lane == 0) SSQM[mr] = s;
    }
    for (int i = blockIdx.x * NTHREADS + tid; i < 6 * T; i += gridDim.x * NTHREADS) SSQ[T + i] = 0.f;
    bf16* RGW = (bf16*)(ws + WS_RGW);
    for (int i = blockIdx.x * NTHREADS + tid; i < 2 * 2 * 8 * 64 * 64; i += gridDim.x * NTHREADS) {
        const int l = i >> 16, g = (i >> 15) & 1, h = (i >> 12) & 7, j = (i >> 6) & 63, ii = i & 63;
        const float* src = (g ? p.in[I_WX] : p.in[I_WA]) + (size_t)((l * 8 + h) * 64 + ii) * 64 + j;
        RGW[i] = (bf16)f2bf(*src);
    }
    float* SP8 = (float*)(ws + WS_SP8);
    for (int i = blockIdx.x * NTHREADS + tid; i < 2 * DR; i += gridDim.x * NTHREADS) SP8[i] = -8.0f * softplusf_(-p.in[I_LAM][i]);
}

__device__ __forceinline__ void conf_prompt_item(CParams& p, int l, int b, int ck, LAS unsigned char* lds) {
    const int tid = otid(), lane = tid & 63, wave = tid >> 6, c = tid;
    const bf16* U = (const bf16*)(p.ws + WS_U); bf16* YM = (bf16*)(p.ws + WS_YM);
    LAS float* cO = (LAS float*)lds;
    const int t0 = ck * 32; const size_t rowb = (size_t)b * SEQ;
    LAS float* cL = (LAS float*)lds;
#pragma unroll 1
    for (int i0 = 0; i0 < 8; i0 += 4) {
        u32x4 va[4], vg[4];
#pragma unroll
        for (int i = 0; i < 4; ++i) { const int r = wave + 8 * (i0 + i), t = t0 - 30 + r; va[i] = (u32x4){0u, 0u, 0u, 0u}; vg[i] = va[i];
            if (r < 62 && t >= 0) { const bf16* up = U + (rowb + t) * DIN + lane * 8; va[i] = *(const u32x4*)(up + 1024); vg[i] = *(const u32x4*)(up + 1536); } }
#pragma unroll
        for (int i = 0; i < 4; ++i) { const int r = wave + 8 * (i0 + i);
            if (r < 62) { f32x4 c0, c1;
                c0.x = bflo(va[i].x) * sigmoidf_(bflo(vg[i].x)); c0.y = bfhi(va[i].x) * sigmoidf_(bfhi(vg[i].x)); c0.z = bflo(va[i].y) * sigmoidf_(bflo(vg[i].y)); c0.w = bfhi(va[i].y) * sigmoidf_(bfhi(vg[i].y));
                c1.x = bflo(va[i].z) * sigmoidf_(bflo(vg[i].z)); c1.y = bfhi(va[i].z) * sigmoidf_(bfhi(vg[i].z)); c1.z = bflo(va[i].w) * sigmoidf_(bflo(vg[i].w)); c1.w = bfhi(va[i].w) * sigmoidf_(bfhi(vg[i].w));
                *(LAS f32x4*)(cL + r * 512 + lane * 8) = c0; *(LAS f32x4*)(cL + r * 512 + lane * 8 + 4) = c1;
                if (ck == 63 && r >= 32) { float* op = p.out + O_PCF + ((size_t)(l * NB + b) * 30 + (r - 32)) * DC + lane * 8; *(f32x4*)op = c0; *(f32x4*)(op + 4) = c1; } } }
    }
    __syncthreads();
    const float* wp = p.in[I_CFW] + (size_t)l * 31 * DC + c; const float bias = p.in[I_CFB][l * DC + c];
    float w[31];
#pragma unroll
    for (int j = 0; j < 31; ++j) w[j] = wp[j * DC];
#pragma unroll 1
    for (int t4 = 0; t4 < 32; t4 += 4) { float a0 = bias, a1 = bias, a2 = bias, a3 = bias; const LAS float* cp = cL + t4 * 512 + c;
#pragma unroll
        for (int j = 0; j < 34; ++j) { const float v = cp[j * 512];
            if (j < 31) a0 += w[j] * v;
            if (j >= 1 && j < 32) a1 += w[j - 1] * v;
            if (j >= 2 && j < 33) a2 += w[j - 2] * v;
            if (j >= 3) a3 += w[j - 3] * v; }
        cO[(t4 + 0) * 512 + c] = a0; cO[(t4 + 1) * 512 + c] = a1; cO[(t4 + 2) * 512 + c] = a2; cO[(t4 + 3) * 512 + c] = a3; }
    __syncthreads();
    const f32x4* gp = (const f32x4*)(p.in[I_LNG] + l * DC + lane * 8); const f32x4* bp = (const f32x4*)(p.in[I_LNB] + l * DC + lane * 8);
    const f32x4 g0 = gp[0], g1 = gp[1], b0 = bp[0], b1 = bp[1];
#pragma unroll
    for (int i = 0; i < 4; ++i) { const int t = wave + 8 * i;
        const f32x4 x0 = *(const LAS f32x4*)(cO + t * 512 + lane * 8), x1 = *(const LAS f32x4*)(cO + t * 512 + lane * 8 + 4);
        const float mean = wave_sum((x0.x + x0.y) + (x0.z + x0.w) + (x1.x + x1.y) + (x1.z + x1.w)) * (1.0f / 512.0f);
        const f32x4 d0 = x0 - mean, d1 = x1 - mean;
        const float var = wave_sum((d0.x * d0.x + d0.y * d0.y) + (d0.z * d0.z + d0.w * d0.w) + (d1.x * d1.x + d1.y * d1.y) + (d1.z * d1.z + d1.w * d1.w)) * (1.0f / 512.0f);
        const float rs = rsqrtf(var + EPS);
        f32x4 y0 = d0 * rs * g0 + b0, y1 = d1 * rs * g1 + b1;
#pragma unroll
        for (int j = 0; j < 4; ++j) { y0[j] = y0[j] * sigmoidf_(y0[j]); y1[j] = y1[j] * sigmoidf_(y1[j]); }
        u32x4 o; o.x = pk2(y0.x, y0.y); o.y = pk2(y0.z, y0.w); o.z = pk2(y1.x, y1.y); o.w = pk2(y1.z, y1.w);
        *(u32x4*)(YM + (rowb + t0 + t) * D + 512 + lane * 8) = o; }
    __syncthreads();
}

__device__ __forceinline__ void sample_mixer_item(CParams& p, int l, int sb, LAS unsigned char* lds) {
    const int tid = otid(), lane = tid & 63, wave = tid >> 6, c = tid;
    const bf16* U = (const bf16*)(p.ws + WS_U); bf16* YM = (bf16*)(p.ws + WS_YM);
    LAS float* xcS = (LAS float*)lds;
    LAS float* cS = (LAS float*)(lds + 8192);
    const size_t row0 = (size_t)TP + sb * SS;
    float xp[7];
    { const float* st = p.in[I_SRG] + ((size_t)(l * SB + sb) * 3) * DR + c; xp[0] = st[0]; xp[1] = st[DR]; xp[2] = st[2 * DR]; }
    float gr[4];
#pragma unroll
    for (int t = 0; t < 4; ++t) { const bf16* up = U + (row0 + t) * DIN; xp[3 + t] = bf2f(up[c]); gr[t] = bf2f(up[512 + c]); }
#pragma unroll
    for (int j = 0; j < 3; ++j) p.out[O_SRG + ((size_t)(l * SB + sb) * 3 + j) * DR + c] = xp[4 + j];
    float xc[4];
    { const float* cw = p.in[I_RGCW] + (size_t)l * 4 * DR + c; const float w0 = cw[0], w1 = cw[DR], w2 = cw[2 * DR], w3 = cw[3 * DR], bc = p.in[I_RGCB][l * DR + c];
#pragma unroll
      for (int t = 0; t < 4; ++t) { xc[t] = bc + w0 * xp[t] + w1 * xp[t + 1] + w2 * xp[t + 2] + w3 * xp[t + 3]; xcS[t * 512 + c] = xc[t]; } }
    __syncthreads();
    float ra[4], ia[4];
    { const float ba = p.in[I_BA][l * DR + c], bx = p.in[I_BX][l * DR + c];
#pragma unroll
      for (int t = 0; t < 4; ++t) { ra[t] = ba; ia[t] = bx; }
      const int h = c >> 6, jj = c & 63;
      const float* wa = p.in[I_WA] + (size_t)((l * 8 + h) * 64) * 64 + jj; const float* wx = p.in[I_WX] + (size_t)((l * 8 + h) * 64) * 64 + jj;
#pragma unroll 16
      for (int i = 0; i < 64; ++i) { const float a = wa[i * 64], x = wx[i * 64];
#pragma unroll
          for (int t = 0; t < 4; ++t) { const float xv = xcS[t * 512 + h * 64 + i]; ra[t] += xv * a; ia[t] += xv * x; } } }
    { const float sp8 = ((const float*)(p.ws + WS_SP8))[l * DR + c];
      float hs = p.in[I_SH][(size_t)(l * SB + sb) * DR + c];
#pragma unroll
      for (int t = 0; t < 4; ++t) { const float r = sigmoidf_(ra[t]), ig = sigmoidf_(ia[t]); float a, mult; lru_coef(sp8 * r, a, mult);
          hs = a * hs + mult * (ig * xc[t]);
          YM[(row0 + t) * D + c] = (bf16)f2bf(hs * gelu_tanh(gr[t])); }
      p.out[O_SH + (size_t)(l * SB + sb) * DR + c] = hs; }
    { float cp[34];
      const float* st = p.in[I_SCF] + ((size_t)(l * SB + sb) * 30) * DC + c;
#pragma unroll
      for (int j = 0; j < 30; ++j) cp[j] = st[j * DC];
#pragma unroll
      for (int t = 0; t < 4; ++t) { const bf16* up = U + (row0 + t) * DIN; cp[30 + t] = bf2f(up[1024 + c]) * sigmoidf_(bf2f(up[1536 + c])); }
#pragma unroll
      for (int j = 0; j < 30; ++j) p.out[O_SCF + ((size_t)(l * SB + sb) * 30 + j) * DC + c] = cp[4 + j];
      const float* wp = p.in[I_CFW] + (size_t)l * 31 * DC + c; const float bias = p.in[I_CFB][l * DC + c];
      float a4[4] = {bias, bias, bias, bias};
#pragma unroll
      for (int j = 0; j < 31; ++j) { const float w = wp[j * DC];
#pragma unroll
          for (int t = 0; t < 4; ++t) a4[t] += w * cp[t + j]; }
#pragma unroll
      for (int t = 0; t < 4; ++t) cS[t * 512 + c] = a4[t]; }
    __syncthreads();
    if (wave < 4) { const int t = wave;
        const f32x4* gp = (const f32x4*)(p.in[I_LNG] + l * DC + lane * 8); const f32x4* bp = (const f32x4*)(p.in[I_LNB] + l * DC + lane * 8);
        const f32x4 g0 = gp[0], g1 = gp[1], b0 = bp[0], b1 = bp[1];
        const f32x4 x0 = *(const LAS f32x4*)(cS + t * 512 + lane * 8), x1 = *(const LAS f32x4*)(cS + t * 512 + lane * 8 + 4);
        const float mean = wave_sum((x0.x + x0.y) + (x0.z + x0.w) + (x1.x + x1.y) + (x1.z + x1.w)) * (1.0f / 512.0f);
        const f32x4 d0 = x0 - mean, d1 = x1 - mean;
        const float var = wave_sum((d0.x * d0.x + d0.y * d0.y) + (d0.z * d0.z + d0.w * d0.w) + (d1.x * d1.x + d1.y * d1.y) + (d1.z * d1.z + d1.w * d1.w)) * (1.0f / 512.0f);
        const float rs = rsqrtf(var + EPS);
        f32x4 y0 = d0 * rs * g0 + b0, y1 = d1 * rs * g1 + b1;
#pragma unroll
        for (int j = 0; j < 4; ++j) { y0[j] = y0[j] * sigmoidf_(y0[j]); y1[j] = y1[j] * sigmoidf_(y1[j]); }
        u32x4 o; o.x = pk2(y0.x, y0.y); o.y = pk2(y0.z, y0.w); o.z = pk2(y1.x, y1.y); o.w = pk2(y1.z, y1.w);
        *(u32x4*)(YM + (row0 + t) * D + 512 + lane * 8) = o; }
    __syncthreads();
}

constexpr int GR_OFF = 69632, CARRY_OFF = 137216;
constexpr int XC_PITCH = 1040;
struct RgState { float Hl[4][4][4]; float Pl[4][4][4]; };

__device__ __forceinline__ void rglru_part1(CParams& p, int l, int b, int k, LAS unsigned char* lds, RgState& S) {
    const int tid = otid(), lane = tid & 63, h = tid >> 6, fr = lane & 15, fq = lane >> 4;
    const bf16* U = (const bf16*)(p.ws + WS_U);
    {
        const int wave = h; const size_t row = (size_t)b * SEQ + k * 64;
        u32x4 xr[11];
#pragma unroll
        for (int i = 0; i < 11; ++i) { const int t = 8 * wave - 3 + i; xr[i] = (u32x4){0u, 0u, 0u, 0u};
            if (k > 0 || t >= 0) xr[i] = *(const u32x4*)(U + (row + t) * DIN + lane * 8); }
        u32x4 gq[8];
#pragma unroll
        for (int i = 0; i < 8; ++i) { const int idx = tid + 512 * i; gq[i] = *(const u32x4*)(U + (row + (idx >> 6)) * DIN + 512 + (idx & 63) * 8); }
        const float* cw = p.in[I_RGCW] + (size_t)l * 4 * DR + lane * 8; const float* cb = p.in[I_RGCB] + l * DR + lane * 8;
        float wj[4][8], bc[8];
#pragma unroll
        for (int j = 0; j < 4; ++j) { const f32x4 a0 = *(const f32x4*)(cw + j * DR), a1 = *(const f32x4*)(cw + j * DR + 4);
            wj[j][0] = a0.x; wj[j][1] = a0.y; wj[j][2] = a0.z; wj[j][3] = a0.w; wj[j][4] = a1.x; wj[j][5] = a1.y; wj[j][6] = a1.z; wj[j][7] = a1.w; }
        { const f32x4 a0 = *(const f32x4*)cb, a1 = *(const f32x4*)(cb + 4); bc[0] = a0.x; bc[1] = a0.y; bc[2] = a0.z; bc[3] = a0.w; bc[4] = a1.x; bc[5] = a1.y; bc[6] = a1.z; bc[7] = a1.w; }
#pragma unroll
        for (int tt = 0; tt < 8; ++tt) { float o[8];
#pragma unroll
            for (int e = 0; e < 8; ++e) { float a = bc[e];
#pragma unroll
                for (int j = 0; j < 4; ++j) { const unsigned wv = xr[tt + j][e >> 1]; a += wj[j][e] * ((e & 1) ? bfhi(wv) : bflo(wv)); }
                o[e] = a; }
            u32x4 w; w.x = pk2(o[0], o[1]); w.y = pk2(o[2], o[3]); w.z = pk2(o[4], o[5]); w.w = pk2(o[6], o[7]);
            *(LAS u32x4*)(lds + (8 * wave + tt) * XC_PITCH + lane * 16) = w; }
        if (k == 31 && wave == 7) {
#pragma unroll
            for (int j = 0; j < 3; ++j) { const u32x4 wv = xr[8 + j]; float* op = p.out + O_PRG + ((size_t)(l * NB + b) * 3 + j) * DR + lane * 8;
                *(f32x4*)op = (f32x4){bflo(wv.x), bfhi(wv.x), bflo(wv.y), bfhi(wv.y)}; *(f32x4*)(op + 4) = (f32x4){bflo(wv.z), bfhi(wv.z), bflo(wv.w), bfhi(wv.w)}; } }
#pragma unroll
        for (int i = 0; i < 8; ++i) { const int idx = tid + 512 * i; *(LAS u32x4*)(lds + GR_OFF + (idx >> 6) * 1024 + (idx & 63) * 16) = gq[i]; }
    }
    __syncthreads();
    const bf16* RGW = (const bf16*)(p.ws + WS_RGW) + (size_t)(l * 2) * 8 * 4096;
    float2* AGG = (float2*)(p.ws + WS_AGG);
#pragma unroll
    for (int ct = 0; ct < 4; ++ct) {
        const int c = h * 64 + 16 * ct + fr;
        bf16x8 wf[2][2];
#pragma unroll
        for (int g = 0; g < 2; ++g)
#pragma unroll
            for (int ks = 0; ks < 2; ++ks) wf[g][ks] = *(const bf16x8*)(RGW + (size_t)((g * 8 + h) * 64 + 16 * ct + fr) * 64 + 32 * ks + 8 * fq);
        const float ba = p.in[I_BA][l * DR + c], bx = p.in[I_BX][l * DR + c], sp8 = ((const float*)(p.ws + WS_SP8))[l * DR + c];
        float Ac = 1.f, Bc = 0.f;
#pragma unroll
        for (int tt = 0; tt < 4; ++tt) {
            const bf16x8 xf0 = *(const LAS bf16x8*)(lds + (16 * tt + fr) * XC_PITCH + (h * 64 + 8 * fq) * 2);
            const bf16x8 xf1 = *(const LAS bf16x8*)(lds + (16 * tt + fr) * XC_PITCH + (h * 64 + 32 + 8 * fq) * 2);
            f32x4 racc = {0.f, 0.f, 0.f, 0.f}, iacc = {0.f, 0.f, 0.f, 0.f};
            racc = __builtin_amdgcn_mfma_f32_16x16x32_bf16(xf0, wf[0][0], racc, 0, 0, 0); racc = __builtin_amdgcn_mfma_f32_16x16x32_bf16(xf1, wf[0][1], racc, 0, 0, 0);
            iacc = __builtin_amdgcn_mfma_f32_16x16x32_bf16(xf0, wf[1][0], iacc, 0, 0, 0); iacc = __builtin_amdgcn_mfma_f32_16x16x32_bf16(xf1, wf[1][1], iacc, 0, 0, 0);
            float hq = 0.f, pq = 1.f;
#pragma unroll
            for (int e = 0; e < 4; ++e) { const float xcv = bf2f(*(const LAS bf16*)(lds + (16 * tt + 4 * fq + e) * XC_PITCH + c * 2));
                const float r = sigmoidf_(racc[e] + ba), ig = sigmoidf_(iacc[e] + bx); float a, mult; lru_coef(sp8 * r, a, mult);
                hq = a * hq + mult * (ig * xcv); pq *= a; S.Hl[ct][tt][e] = hq; S.Pl[ct][tt][e] = pq; }
            float Ai = pq, Bi = hq;
            { const float A1 = __shfl_up(Ai, 16), B1 = __shfl_up(Bi, 16); if (fq >= 1) { Bi = Ai * B1 + Bi; Ai = A1 * Ai; } }
            { const float A2 = __shfl_up(Ai, 32), B2 = __shfl_up(Bi, 32); if (fq >= 2) { Bi = Ai * B2 + Bi; Ai = A2 * Ai; } }
            float Ae = __shfl_up(Ai, 16), Be = __shfl_up(Bi, 16); if (fq == 0) { Ae = 1.f; Be = 0.f; }
            const float Ap = Ac * Ae, Bp = Ae * Bc + Be;
#pragma unroll
            for (int e = 0; e < 4; ++e) { S.Hl[ct][tt][e] += S.Pl[ct][tt][e] * Bp; S.Pl[ct][tt][e] *= Ap; }
            const float At = __shfl(Ai, 48 + fr), Bt = __shfl(Bi, 48 + fr);
            Bc = At * Bc + Bt; Ac = Ac * At;
            asm volatile("" ::: "memory");
        }
        if (fq == 0) AGG[(size_t)(b * 32 + k) * DR + c] = make_float2(Ac, Bc);
    }
}
__device__ __forceinline__ void rglru_part2(CParams& p, int l, int b, int k, LAS unsigned char* lds, const RgState& S) {
    const int tid = otid(), lane = tid & 63, h = tid >> 6, fr = lane & 15, fq = lane >> 4;
    bf16* YM = (bf16*)(p.ws + WS_YM);
    const float2* AGG = (const float2*)(p.ws + WS_AGG);
    { float carry = 0.f; const float2* ap = AGG + (size_t)(b * 32) * DR + tid;
#pragma unroll 8
        for (int kk = 0; kk < k; ++kk) { const float2 ab = ap[(size_t)kk * DR]; carry = ab.x * carry + ab.y; }
        *(LAS float*)(lds + CARRY_OFF + tid * 4) = carry; }
    __syncthreads();
#pragma unroll
    for (int ct = 0; ct < 4; ++ct) {
        const int c = h * 64 + 16 * ct + fr; const float carry = *(const LAS float*)(lds + CARRY_OFF + c * 4);
#pragma unroll
        for (int tt = 0; tt < 4; ++tt)
#pragma unroll
            for (int e = 0; e < 4; ++e) { const float hv = S.Hl[ct][tt][e] + S.Pl[ct][tt][e] * carry;
                LAS bf16* gp = (LAS bf16*)(lds + GR_OFF + (16 * tt + 4 * fq + e) * 1024 + c * 2);
                *gp = (bf16)f2bf(hv * gelu_tanh(bf2f(*gp)));
                if (k == 31 && tt == 3 && e == 3 && fq == 3) p.out[O_PH + (size_t)(l * NB + b) * DR + c] = hv; }
    }
    __syncthreads();
    const size_t row = (size_t)b * SEQ + k * 64;
#pragma unroll
    for (int i = 0; i < 8; ++i) { const int idx = tid + 512 * i; *(u32x4*)(YM + (row + (idx >> 6)) * D + (idx & 63) * 8) = *(const LAS u32x4*)(lds + GR_OFF + (idx >> 6) * 1024 + (idx & 63) * 16); }
}

__device__ __forceinline__ void attn_prompt_unit(CParams& p, int l, int b, int h, int qb, LAS unsigned char* lds) {
    const int tid = otid(), lane = tid & 63, wave = tid >> 6, r32 = lane & 31, half = lane >> 5;
    const bf16* QB = (const bf16*)(p.ws + WS_QB); bf16* OB = (bf16*)(p.ws + WS_YM);
    const bf16* KB = (const bf16*)(p.ws + WS_KB) + (size_t)l * MROWS * D; const bf16* VT = (const bf16*)(p.ws + WS_VT) + (size_t)l * MROWS * D;
#pragma unroll 8
    for (int i = 0; i < 16; ++i) { const int idx = tid + 512 * i, key = idx >> 5, ch = idx & 31;
        const u32x4 v = *(const u32x4*)(KB + (size_t)(b * NMEM + key) * D + h * HD + ch * 8);
        *(LAS u32x4*)(lds + key * 512 + ((ch ^ (key & 31)) << 4)) = v; }
    const size_t qrow = (size_t)b * SEQ + qb * 256 + wave * 32 + r32;
    const bf16* qp = QB + qrow * D + h * HD + 8 * half;
    bf16x8 qf[8];
#pragma unroll
    for (int ks = 0; ks < 8; ++ks) qf[ks] = *(const bf16x8*)(qp + ks * 16);
    __syncthreads();
    f32x16 acc[8];
#pragma unroll
    for (int kb = 0; kb < 8; ++kb)
#pragma unroll
        for (int j = 0; j < 16; ++j) acc[kb][j] = 0.f;
#pragma unroll
    for (int kh = 0; kh < 2; ++kh) {
#pragma unroll
        for (int k8 = 0; k8 < 8; ++k8) { const int ks = kh * 8 + k8;
#pragma unroll
            for (int kb = 0; kb < 8; ++kb) { const int key = 32 * kb + r32;
                const bf16x8 a = *(const LAS bf16x8*)(lds + key * 512 + (((2 * ks + half) ^ r32) << 4));
                acc[kb] = __builtin_amdgcn_mfma_f32_32x32x16_bf16(a, qf[k8], acc[kb], 0, 0, 0); }
            if (kh == 0) qf[k8] = *(const bf16x8*)(qp + (8 + k8) * 16); }
    }
    float mx = -3.0e38f;
#pragma unroll
    for (int kb = 0; kb < 8; ++kb)
#pragma unroll
        for (int j = 0; j < 16; ++j) mx = fmaxf(mx, acc[kb][j]);
    mx = fmaxf(mx, __shfl_xor(mx, 32));
    float sum = 0.f;
#pragma unroll
    for (int kb = 0; kb < 8; ++kb)
#pragma unroll
        for (int j = 0; j < 16; ++j) { const float e = __builtin_amdgcn_exp2f(acc[kb][j] - mx); acc[kb][j] = e; sum += e; }
    sum += __shfl_xor(sum, 32);
    const float inv = 1.0f / sum;
    bf16x8 pf[8][2];
#pragma unroll
    for (int kb = 0; kb < 8; ++kb)
#pragma unroll
        for (int jj = 0; jj < 2; ++jj) { u32x4 w; w.x = pk2(acc[kb][8 * jj + 0], acc[kb][8 * jj + 1]); w.y = pk2(acc[kb][8 * jj + 2], acc[kb][8 * jj + 3]);
            w.z = pk2(acc[kb][8 * jj + 4], acc[kb][8 * jj + 5]); w.w = pk2(acc[kb][8 * jj + 6], acc[kb][8 * jj + 7]); pf[kb][jj] = __builtin_bit_cast(bf16x8, w); }
    __syncthreads();
#pragma unroll 8
    for (int i = 0; i < 16; ++i) { const int idx = tid + 512 * i, d = idx >> 5, ch = idx & 31;
        const u32x4 v = *(const u32x4*)(VT + ((size_t)((b * NH + h) * HD + d)) * NMEM + ch * 8);
        const int c8 = 2 * ch; u32x2 lo; lo.x = v.x; lo.y = v.y; u32x2 hi; hi.x = v.z; hi.y = v.w;
        *(LAS u32x2*)(lds + d * 512 + ((c8 ^ (d & 63)) << 3)) = lo; *(LAS u32x2*)(lds + d * 512 + (((c8 + 1) ^ (d & 63)) << 3)) = hi; }
    __syncthreads();
#pragma unroll
    for (int db = 0; db < 8; ++db) {
        f32x16 o;
#pragma unroll
        for (int j = 0; j < 16; ++j) o[j] = 0.f;
        const int dim = 32 * db + r32;
#pragma unroll
        for (int kb = 0; kb < 8; ++kb)
#pragma unroll
            for (int jj = 0; jj < 2; ++jj) { const int c8 = 8 * kb + 4 * jj + half;
                const u32x2 lo = *(const LAS u32x2*)(lds + dim * 512 + ((c8 ^ (dim & 63)) << 3)), hi = *(const LAS u32x2*)(lds + dim * 512 + (((c8 + 2) ^ (dim & 63)) << 3));
                u32x4 w; w.x = lo.x; w.y = lo.y; w.z = hi.x; w.w = hi.y;
                o = __builtin_amdgcn_mfma_f32_32x32x16_bf16(__builtin_bit_cast(bf16x8, w), pf[kb][jj], o, 0, 0, 0); }
#pragma unroll
        for (int g = 0; g < 4; ++g) { u32x2 w; w.x = pk2(o[4 * g] * inv, o[4 * g + 1] * inv); w.y = pk2(o[4 * g + 2] * inv, o[4 * g + 3] * inv);
            *(u32x2*)(OB + qrow * D + h * HD + 32 * db + 8 * g + 4 * half) = w; }
    }
    __syncthreads();
}

__device__ __forceinline__ void attn_sample_unit(CParams& p, int l, int sb, int h, LAS unsigned char* lds) {
    const int tid = otid(), lane = tid & 63, wave = tid >> 6;
    const bf16* QB = (const bf16*)(p.ws + WS_QB); bf16* OB = (bf16*)(p.ws + WS_YM);
    const float* CK = p.in[I_CK] + ((size_t)(l * SB + sb) * NMEM) * D + h * HD; const float* CV = p.in[I_CV] + ((size_t)(l * SB + sb) * NMEM) * D + h * HD;
    LAS f32x4* sc = (LAS f32x4*)lds;
    LAS float* red = (LAS float*)(lds + 8192);
    const size_t row0 = (size_t)TP + sb * SS;
    {
        const int ksub = lane >> 4, dseg = lane & 15;
        f32x4 q[4][4];
#pragma unroll
        for (int t = 0; t < 4; ++t)
#pragma unroll
            for (int jj = 0; jj < 4; ++jj) { const u32x2 w = *(const u32x2*)(QB + (row0 + t) * D + h * HD + jj * 64 + dseg * 4);
                q[t][jj] = (f32x4){bflo(w.x), bfhi(w.x), bflo(w.y), bfhi(w.y)}; }
#pragma unroll 4
        for (int it = 0; it < 8; ++it) { const int key = wave * 32 + it * 4 + ksub;
            f32x4 kv[4];
#pragma unroll
            for (int jj = 0; jj < 4; ++jj) kv[jj] = *(const f32x4*)(CK + (size_t)key * D + jj * 64 + dseg * 4);
            float s[4];
#pragma unroll
            for (int t = 0; t < 4; ++t) { float a = 0.f;
#pragma unroll
                for (int jj = 0; jj < 4; ++jj) a += (kv[jj].x * q[t][jj].x + kv[jj].y * q[t][jj].y) + (kv[jj].z * q[t][jj].z + kv[jj].w * q[t][jj].w);
                a += __shfl_xor(a, 1); a += __shfl_xor(a, 2); a += __shfl_xor(a, 4); a += __shfl_xor(a, 8); s[t] = a; }
            if (dseg == 0) sc[key] = (f32x4){s[0], s[1], s[2], s[3]}; }
    }
    __syncthreads();
    if (wave < 4) { const int t = wave; float v[4]; float mx = -3.0e38f;
#pragma unroll
        for (int j = 0; j < 4; ++j) { v[j] = ((const LAS float*)lds)[(lane * 4 + j) * 4 + t]; mx = fmaxf(mx, v[j]); }
#pragma unroll
        for (int o = 1; o < 64; o <<= 1) mx = fmaxf(mx, __shfl_xor(mx, o));
        float sum = 0.f;
#pragma unroll
        for (int j = 0; j < 4; ++j) { v[j] = __builtin_amdgcn_exp2f(v[j] - mx); sum += v[j]; }
        sum = wave_sum(sum); const float inv = 1.0f / sum;
#pragma unroll
        for (int j = 0; j < 4; ++j) ((LAS float*)lds)[(lane * 4 + j) * 4 + t] = v[j] * inv; }
    __syncthreads();
    {
        f32x4 o[4];
#pragma unroll
        for (int t = 0; t < 4; ++t) o[t] = (f32x4){0.f, 0.f, 0.f, 0.f};
#pragma unroll 16
        for (int m = 0; m < 32; ++m) { const int key = wave * 32 + m; const f32x4 v = *(const f32x4*)(CV + (size_t)key * D + lane * 4); const f32x4 pr = sc[key];
            o[0] += v * pr.x; o[1] += v * pr.y; o[2] += v * pr.z; o[3] += v * pr.w; }
#pragma unroll
        for (int t = 0; t < 4; ++t) *(LAS f32x4*)(red + (wave * 4 + t) * 256 + lane * 4) = o[t];
    }
    __syncthreads();
    { const int t = tid >> 7, d2 = tid & 127; float a0 = 0.f, a1 = 0.f;
#pragma unroll
        for (int w = 0; w < 8; ++w) { const f32x2 v = *(const LAS f32x2*)(red + (w * 4 + t) * 256 + d2 * 2); a0 += v.x; a1 += v.y; }
        *(unsigned*)(OB + (row0 + t) * D + h * HD + d2 * 2) = pk2(a0, a1); }
    __syncthreads();
}

constexpr int N_PHASES = 18;
__device__ __forceinline__ void phase_body(const int ph, CParams* p0, LAS unsigned char* lds, const XcdBarrier& bar) {
        CParams* pq = p0; asm volatile("" : "+s"(pq));
        CParams& p = *pq;
        unsigned char* ws = p.ws;
        float* X = (float*)(ws + WS_X); bf16* XB = (bf16*)(ws + WS_XB); bf16* U = (bf16*)(ws + WS_U); bf16* YM = (bf16*)(ws + WS_YM); bf16* QB = (bf16*)(ws + WS_QB); bf16* HB = (bf16*)(ws + WS_H);
        float* SSQ = (float*)(ws + WS_SSQ); const int bx = blockIdx.x;
        if (ph == 0) { prologue(p, lds); return; }
        if (ph == N_PHASES - 1) {
            const int tdx = otid(), lane = tdx & 63, wave = tdx >> 6; const float* g = p.in[I_GFIN];
            for (int m = bx * NWAVES + wave; m < T; m += GRID * NWAVES) { const float rs = rsqrtf(SSQ[6 * T + m] * (1.0f / 1024.0f) + EPS);
                const f32x4* xr = (const f32x4*)(X + (size_t)m * D) + lane; f32x4* yo = (f32x4*)(p.out + (size_t)m * D) + lane; const f32x4* gp = (const f32x4*)g + lane;
#pragma unroll
                for (int j = 0; j < 4; ++j) yo[64 * j] = xr[64 * j] * rs * gp[64 * j]; }
            return;
        }
        const int l = (ph - 1) >> 3, sub = (ph - 1) & 7;
        unsigned char* wl = ws + WS_W + (size_t)l * W_LAYER;
        if (sub == 0) {
            { pg8::Gemm g{XB, (const bf16*)(wl + WO_IN), T, DIN, D}; pg8::StaticOrder S; S.init(T, DIN, GRID, bx);
              pg8::EpiScaleBf16 E{U, DIN, SSQ + (size_t)(3 * l) * T, 1.0f};
              pg8::gemm_phase<pg8::EpiScaleBf16, pg8::StaticOrder, true, true>(lds, g, S, E); }
            if (l == 0) {
                for (int ll = 0; ll < 2; ++ll) { pg8::Gemm g{(const bf16*)(ws + WS_MEMB), (const bf16*)(ws + WS_W + (size_t)ll * W_LAYER + WO_KV), MROWS, 2048, D};
                    pg8::StaticOrder S; S.init(MROWS, 2048, GRID, (bx + 128 + 64 * ll) & 255);
                    pg8::EpiKV E{p.out + O_PMK + (size_t)ll * MROWS * D, p.out + O_PMV + (size_t)ll * MROWS * D, (bf16*)(ws + WS_KB) + (size_t)ll * MROWS * D, (bf16*)(ws + WS_VT) + (size_t)ll * MROWS * D, (const float*)(ws + WS_SSQM)};
                    pg8::gemm_phase<pg8::EpiKV, pg8::StaticOrder, true, true>(lds, g, S, E); }
            }
        } else if (sub == 1) {
            const int b = bx >> 5, k = bx & 31;
            conf_prompt_item(p, l, b, 2 * k, lds); conf_prompt_item(p, l, b, 2 * k + 1, lds);
            if (bx < SB) sample_mixer_item(p, l, bx, lds);
            RgState S; rglru_part1(p, l, b, k, lds, S);
            xcd_barrier(bar);
            rglru_part2(p, l, b, k, lds, S);
        } else if (sub == 2) {
            pg8::Gemm g{YM, (const bf16*)(wl + WO_OUT), T, D, D}; pg8::StaticOrder S; S.init(T, D, GRID, bx);
            pg8::EpiRes E{X, XB, SSQ + (size_t)(3 * l + 1) * T};
            pg8::gemm_phase<pg8::EpiRes, pg8::StaticOrder, true, true>(lds, g, S, E);
        } else if (sub == 3) {
            pg8::Gemm g{XB, (const bf16*)(wl + WO_Q), T, D, D}; pg8::StaticOrder S; S.init(T, D, GRID, bx);
            pg8::EpiScaleBf16 E{QB, D, SSQ + (size_t)(3 * l + 1) * T, QSCALE};
            pg8::gemm_phase<pg8::EpiScaleBf16, pg8::StaticOrder, true, true>(lds, g, S, E);
        } else if (sub == 4) {
            for (int u = bx; u < NB * NH * 8; u += GRID) attn_prompt_unit(p, l, u >> 5, (u >> 3) & 3, u & 7, lds);
            for (int u = bx; u < SB * NH; u += GRID) attn_sample_unit(p, l, u >> 2, u & 3, lds);
        } else if (sub == 5) {
            pg8::Gemm g{YM, (const bf16*)(wl + WO_O), T, D, D}; pg8::StaticOrder S; S.init(T, D, GRID, bx);
            pg8::EpiRes E{X, XB, SSQ + (size_t)(3 * l + 2) * T};
            pg8::gemm_phase<pg8::EpiRes, pg8::StaticOrder, true, true>(lds, g, S, E);
        } else if (sub == 6) {
            pg8::Gemm g{XB, (const bf16*)(wl + WO_GU), T, 2 * DFF, D}; pg8::StaticOrder S; S.init(T, 2 * DFF, GRID, bx);
            pg8::EpiGateUp E{HB, DFF, SSQ + (size_t)(3 * l + 2) * T};
            pg8::gemm_phase<pg8::EpiGateUp, pg8::StaticOrder, true, true>(lds, g, S, E);
        } else {
            pg8::Gemm g{HB, (const bf16*)(wl + WO_D), T, D, DFF}; pg8::StaticOrder S; S.init(T, D, GRID, bx);
            pg8::EpiRes E{X, XB, SSQ + (size_t)(3 * l + 3) * T};
            pg8::gemm_phase<pg8::EpiRes, pg8::StaticOrder, true, true>(lds, g, S, E);
        }
}
__global__ void __launch_bounds__(NTHREADS, 2) hymba_fwd(Params p_formal) {
    extern __shared__ __attribute__((aligned(16))) unsigned char lds_raw[];
    LAS unsigned char* lds = (LAS unsigned char*)lds_raw;
    cg::grid_group grid = cg::this_grid();
    if (gridDim.x != GRID) return;
    CParams* p0 = (CParams*)__builtin_amdgcn_kernarg_segment_ptr();
    const int ph_lo = p0->ph_lo, ph_hi = p0->ph_hi;
    if (ph_lo < 0) grid.sync();
    if (threadIdx.x < 2) ((volatile LAS unsigned*)(lds + LDS_BARW))[threadIdx.x] = 0u;
    __syncthreads();
    const XcdBarrier bar = xcd_barrier_post((unsigned*)(p0->ws + WS_BAR), (volatile LAS unsigned*)(lds + LDS_BARW));
#ifndef EXP_SYNC
#define EXP_SYNC 0
#endif
#define RUN(PH) if (ph_lo <= (PH) && (PH) < ph_hi) { if ((PH) > ph_lo) { xcd_barrier(bar); if (EXP_SYNC) { xcd_barrier(bar); xcd_barrier(bar); } } phase_body((PH), p0, lds, bar); }
#define RUN2(PH) RUN(PH) if (ph_lo <= (PH) && (PH) < ph_hi) { xcd_barrier(bar); phase_body((PH), p0, lds, bar); }
#ifndef EXP_PRO
#define EXP_PRO 0
#endif
#ifndef EXP_MIX
#define EXP_MIX 0
#endif
#ifndef EXP_ATT
#define EXP_ATT 0
#endif
#ifndef EXP_Q
#define EXP_Q 0
#endif
#ifndef EXP_GU
#define EXP_GU 0
#endif
#ifndef EXP_IN
#define EXP_IN 0
#endif
#if EXP_PRO
    RUN2(0)
#else
    RUN(0)
#endif
#if EXP_IN
    RUN2(1)
#else
    RUN(1)
#endif
#if EXP_MIX
    RUN2(2)
#else
    RUN(2)
#endif
    RUN(3)
#if EXP_Q
    RUN2(4)
#else
    RUN(4)
#endif
#if EXP_ATT
    RUN2(5)
#else
    RUN(5)
#endif
    RUN(6)
#if EXP_GU
    RUN2(7)
#else
    RUN(7)
#endif
    RUN(8)
#if EXP_IN
    RUN2(9)
#else
    RUN(9)
#endif
#if EXP_MIX
    RUN2(10)
#else
    RUN(10)
#endif
    RUN(11)
#if EXP_Q
    RUN2(12)
#else
    RUN(12)
#endif
#if EXP_ATT
    RUN2(13)
#else
    RUN(13)
#endif
    RUN(14)
#if EXP_GU
    RUN2(15)
#else
    RUN(15)
#endif
    RUN(16)
#if EXP_PRO
    RUN2(17)
#else
    RUN(17)
#endif
#undef RUN2
#undef RUN
}

#ifndef N_LAUNCH_SPLIT
#define N_LAUNCH_SPLIT 0
#endif
extern "C" void kernel_launch(void* const* d_in, const int* in_sizes, int n_in, void* d_out, int out_size, void* d_ws, size_t ws_size, hipStream_t stream) {
    static int ready = 0;
    if (ready == 0) {
        if (n_in != N_IN || (size_t)out_size != O_END || ws_size < WS_END) { fprintf(stderr, "kernel_launch: unexpected shapes: n_in %d out %d ws %zu\n", n_in, out_size, ws_size); ready = -1; return; }
        if (hipFuncSetAttribute((const void*)hymba_fwd, hipFuncAttributeMaxDynamicSharedMemorySize, LDS_BYTES) != hipSuccess) { fprintf(stderr, "kernel_launch: hipFuncSetAttribute failed\n"); ready = -1; return; }
        int dev = 0, cus = 0, per_cu = 0;
        hipGetDevice(&dev); hipDeviceGetAttribute(&cus, hipDeviceAttributeMultiprocessorCount, dev);
        hipOccupancyMaxActiveBlocksPerMultiprocessor(&per_cu, (const void*)hymba_fwd, NTHREADS, LDS_BYTES);
        if (cus * per_cu < GRID) { fprintf(stderr, "kernel_launch: device holds %d x %d workgroups, need %d resident\n", cus, per_cu, GRID); ready = -1; return; }
        ready = 1;
    }
    if (ready < 0) return;
    if (hipMemsetAsync((unsigned char*)d_ws + WS_BAR, 0, BAR_BYTES, stream) != hipSuccess) { fprintf(stderr, "kernel_launch: memset of the barrier words failed\n"); return; }
    Params p{};
    for (int i = 0; i < N_IN; ++i) p.in[i] = (const float*)d_in[i];
    p.out = (float*)d_out; p.ws = (unsigned char*)d_ws;
#if N_LAUNCH_SPLIT
    for (int ph = 0; ph < N_PHASES; ++ph) { p.ph_lo = ph; p.ph_hi = ph + 1; void* args[] = {&p};
        hipError_t e = hipLaunchCooperativeKernel((const void*)hymba_fwd, dim3(GRID), dim3(NTHREADS), args, LDS_BYTES, stream);
        if (e != hipSuccess) { fprintf(stderr, "cooperative launch failed: %s\n", hipGetErrorString(e)); return; } }
#else
    p.ph_lo = 0; p.ph_hi = N_PHASES; void* args[] = {&p};
    hipError_t e = hipLaunchCooperativeKernel((const void*)hymba_fwd, dim3(GRID), dim3(NTHREADS), args, LDS_BYTES, stream);
    if (e != hipSuccess) fprintf(stderr, "cooperative launch failed: %s\n", hipGetErrorString(e));
#endif
}
```

```cpp
#include <hip/hip_runtime.h>
#include <hip/hip_cooperative_groups.h>
#include <cstdio>
#include <cstdint>
namespace cg = cooperative_groups;

namespace pg8 {
#define PG8_LAS __attribute__((address_space(3)))
typedef unsigned short bf16_t;
typedef short bf16x8 __attribute__((ext_vector_type(8)));
typedef float f32x4 __attribute__((ext_vector_type(4)));
typedef unsigned u32x4 __attribute__((ext_vector_type(4)));
constexpr int BM = 256, BK = 64, HALF = 128, HTB = HALF * BK * 2  , STAGE_BYTES = 8 * HTB, NXCD = 8, WGM = 8;

__host__ __device__ __forceinline__ int lds_byte(int r, int c) { const int st = (r >> 4) * 2 + (c >> 5), rr = r & 15, cc = c & 31, ob = rr * 64 + cc * 2; return st * 1024 + (ob ^ (((ob >> 9) & 1) << 5)); }
__host__ __device__ __forceinline__ void stage_rc(int b, int& R, int& C) { const int st = b / 1024, sb = b % 1024, swz = sb ^ (((sb >> 9) & 1) << 5); R = (st >> 1) * 16 + swz / 64; C = (st & 1) * 32 + (swz % 64) / 2; }
__host__ __device__ __forceinline__ int perm32(int rho) { const int n = rho >> 4, i = rho & 15; return 8 * (i >> 2) + 4 * n + (i & 3); }

struct Unit { int pm, pn; };
struct Gemm { const bf16_t* A; const bf16_t* Bt; int M, N, K; };

struct StaticOrder {
    int nM, nN, nwg, G, c;
    __host__ __device__ void init(int M, int N, int G_, int c_) { nM = M / BM; nN = N / BM; nwg = nM * nN; G = G_; c = c_; }
    __host__ __device__ bool next(int i, Unit& u) const {
        const long L = (long)i * G + c; if (L >= nwg) return false;
        int wgid = (int)L; { const int q = nwg / NXCD, r = nwg % NXCD, xcd = wgid % NXCD, off = wgid / NXCD; wgid = (xcd < r ? xcd * (q + 1) : r * (q + 1) + (xcd - r) * q) + off; }
        const int nig = WGM * nN, gid = wgid / nig, fm = gid * WGM, gsz = (nM - fm) < WGM ? (nM - fm) : WGM;
        u.pm = fm + ((wgid % nig) % gsz); u.pn = (wgid % nig) / gsz; return true;
    }
    __device__ __forceinline__ void a_ready(const Unit&) const {}
    __device__ __forceinline__ void done(const Unit&) const {}
};

__device__ __forceinline__ unsigned cvt_pk_bf16(float lo, float hi) { unsigned r; asm volatile("v_cvt_pk_bf16_f32 %0, %1, %2" : "=v"(r) : "v"(lo), "v"(hi)); return r; }
typedef unsigned u32x2 __attribute__((ext_vector_type(2)));
constexpr float RMS_EPS = 1e-6f;

struct EpiScaleBf16 {
    static constexpr bool PERM = true, AFTER_DRAIN = false;
    bf16_t* O; int ldc; const float* ssq; float scale; int row_off;
    __device__ __forceinline__ void operator()(const f32x4 (&acc)[2][2][4][2], const Unit& u, int wr, int wc, int fr, int fq) const {
        const int row0 = row_off + u.pm * BM + wr * 64 + fr, col0 = u.pn * BM + wc * 32 + 8 * fq;
#pragma unroll
        for (int ai = 0; ai < 2; ++ai)
#pragma unroll
            for (int m = 0; m < 4; ++m) { const int row = row0 + ai * HALF + m * 16; const float r = rsqrtf(ssq[row] * (1.0f / 1024.0f) + RMS_EPS) * scale;
                bf16_t* rowp = O + (size_t)row * ldc + col0;
#pragma unroll
                for (int bj = 0; bj < 2; ++bj) { const f32x4 v0 = acc[ai][bj][m][0] * r, v1 = acc[ai][bj][m][1] * r;
                    u32x4 w; w.x = cvt_pk_bf16(v0[0], v0[1]); w.y = cvt_pk_bf16(v0[2], v0[3]); w.z = cvt_pk_bf16(v1[0], v1[1]); w.w = cvt_pk_bf16(v1[2], v1[3]);
                    *(u32x4*)(rowp + bj * HALF) = w; } }
    }
};
struct EpiGateUp {
    static constexpr bool PERM = true, AFTER_DRAIN = false;
    bf16_t* O; int ldc; const float* ssq; int row_off;
    __device__ __forceinline__ void operator()(const f32x4 (&acc)[2][2][4][2], const Unit& u, int wr, int wc, int fr, int fq) const {
        const int row0 = row_off + u.pm * BM + wr * 64 + fr, col0 = u.pn * HALF + wc * 32 + 8 * fq;
#pragma unroll
        for (int ai = 0; ai < 2; ++ai)
#pragma unroll
            for (int m = 0; m < 4; ++m) { const int row = row0 + ai * HALF + m * 16; const float r = rsqrtf(ssq[row] * (1.0f / 1024.0f) + RMS_EPS);
                float o[8];
#pragma unroll
                for (int n = 0; n < 2; ++n)
#pragma unroll
                    for (int j = 0; j < 4; ++j) { const float g = acc[ai][0][m][n][j] * r, up = acc[ai][1][m][n][j] * r;
                        o[n * 4 + j] = g * __builtin_amdgcn_rcpf(1.0f + __expf(-g)) * up; }
                u32x4 w; w.x = cvt_pk_bf16(o[0], o[1]); w.y = cvt_pk_bf16(o[2], o[3]); w.z = cvt_pk_bf16(o[4], o[5]); w.w = cvt_pk_bf16(o[6], o[7]);
                *(u32x4*)(O + (size_t)row * ldc + col0) = w; }
    }
};
struct EpiRes {
    static constexpr bool PERM = false, AFTER_DRAIN = false;
    float* X; bf16_t* XB; float* ssq_out;
    __device__ __forceinline__ void operator()(const f32x4 (&acc)[2][2][4][2], const Unit& u, int wr, int wc, int fr, int fq) const {
        const int row0 = u.pm * BM + wr * 64 + fr, col0 = u.pn * BM + wc * 32 + 4 * fq;
#pragma unroll
        for (int ai = 0; ai < 2; ++ai)
#pragma unroll
            for (int m = 0; m < 4; ++m) { const int row = row0 + ai * HALF + m * 16; const size_t off = (size_t)row * 1024 + col0; float s = 0.f;
#pragma unroll
                for (int bj = 0; bj < 2; ++bj)
#pragma unroll
                    for (int n = 0; n < 2; ++n) { const f32x4 xo = *(const f32x4*)(X + off + bj * HALF + n * 16); const f32x4 xn = xo + acc[ai][bj][m][n];
                        *(f32x4*)(X + off + bj * HALF + n * 16) = xn;
                        u32x2 w; w.x = cvt_pk_bf16(xn[0], xn[1]); w.y = cvt_pk_bf16(xn[2], xn[3]); *(u32x2*)(XB + off + bj * HALF + n * 16) = w;
                        s += (xn[0] * xn[0] + xn[1] * xn[1]) + (xn[2] * xn[2] + xn[3] * xn[3]); }
                s += __shfl_xor(s, 16); s += __shfl_xor(s, 32);
                if (fq == 0) atomicAdd(ssq_out + row, s);
                asm volatile("" ::: "memory"); }
    }
};
struct EpiKV {
    static constexpr bool PERM = false, AFTER_DRAIN = false;
    float* outK; float* outV; bf16_t* KB; bf16_t* VT; const float* ssq;
    __device__ __forceinline__ void operator()(const f32x4 (&acc)[2][2][4][2], const Unit& u, int wr, int wc, int fr, int fq) const {
        const int row0 = u.pm * BM + wr * 64 + fr; const bool isV = u.pn >= 4; const int col0 = (u.pn & 3) * BM + wc * 32 + 4 * fq;
        float* outp = isV ? outV : outK;
#pragma unroll
        for (int ai = 0; ai < 2; ++ai)
#pragma unroll
            for (int m = 0; m < 4; ++m) { const int row = row0 + ai * HALF + m * 16; const float r = rsqrtf(ssq[row] * (1.0f / 1024.0f) + RMS_EPS);
#pragma unroll
                for (int bj = 0; bj < 2; ++bj)
#pragma unroll
                    for (int n = 0; n < 2; ++n) { const int c = col0 + bj * HALF + n * 16; const f32x4 v = acc[ai][bj][m][n] * r;
                        *(f32x4*)(outp + (size_t)row * 1024 + c) = v;
                        if (!isV) { u32x2 w; w.x = cvt_pk_bf16(v[0], v[1]); w.y = cvt_pk_bf16(v[2], v[3]); *(u32x2*)(KB + (size_t)row * 1024 + c) = w; }
                        else { const int b = row >> 8, mm = row & 255, h = c >> 8, d = c & 255; bf16_t* vp = VT + ((size_t)((b * 4 + h) * 256 + d)) * 256 + mm;
                            const unsigned w0 = cvt_pk_bf16(v[0], v[1]), w1 = cvt_pk_bf16(v[2], v[3]);
                            vp[0] = (bf16_t)(w0 & 0xffffu); vp[256] = (bf16_t)(w0 >> 16); vp[512] = (bf16_t)(w1 & 0xffffu); vp[768] = (bf16_t)(w1 >> 16); } } }
    }
};

template <class Epi, class Sched, bool ALIGN_EPI = false, bool SP2 = false>
__device__ __forceinline__ void gemm_phase(PG8_LAS unsigned char* lds, const Gemm g, const Sched& S, const Epi& E) {
    int tid = threadIdx.x; asm volatile("" : "+v"(tid));
    const int wid = __builtin_amdgcn_readfirstlane(tid >> 6), lane = tid & 63, wr = wid >> 2, wc = wid & 3, fr = lane & 15, fq = lane >> 4;
    const int K = g.K, nt = K / BK;
    unsigned voffA[2], voffB[2];
#pragma unroll
    for (int i = 0; i < 2; ++i) { int R, C; stage_rc(tid * 16 + i * 8192, R, C); const int Rb = Epi::PERM ? ((R & ~31) + perm32(R & 31)) : R;
        voffA[i] = (unsigned)(R * K + C) * 2u; voffB[i] = (unsigned)(Rb * K + C) * 2u; }
    const size_t kstep = (size_t)(BK * 2);
    const size_t hstep = (size_t)HALF * K * 2;
    const size_t tstep = 2 * hstep;
    const unsigned ldsw = (unsigned)wid * 1024u;
    const int aoff = lds_byte(wr * 64 + fr, fq * 8), boff = lds_byte(wc * 32 + fr, fq * 8);
#define PG8_SA(b, h) (((b) * 2 + (h)) * HTB)
#define PG8_SB(b, h) ((4 + (b) * 2 + (h)) * HTB)
#define PG8_STAGE(bufoff, gbase, voff) do { _Pragma("unroll") for (int _i = 0; _i < 2; ++_i) \
        __builtin_amdgcn_global_load_lds((const unsigned*)((const char*)(gbase) + (voff)[_i]), (PG8_LAS unsigned*)(lds + (bufoff) + ldsw + _i * 8192), 16, 0, 0); } while (0)
#define PG8_LDA(dst, b, h) do { _Pragma("unroll") for (int m = 0; m < 4; ++m) _Pragma("unroll") for (int k = 0; k < 2; ++k) dst[m][k] = *(const PG8_LAS bf16x8*)(lds + PG8_SA(b, h) + aoff + m * 2048 + k * 1024); } while (0)
#define PG8_LDB(dst, b, h) do { _Pragma("unroll") for (int n = 0; n < 2; ++n) _Pragma("unroll") for (int k = 0; k < 2; ++k) dst[n][k] = *(const PG8_LAS bf16x8*)(lds + PG8_SB(b, h) + boff + n * 2048 + k * 1024); } while (0)
#define PG8_MMA(ai, bj, At, Bt) do { __builtin_amdgcn_s_setprio(1); _Pragma("unroll") for (int m = 0; m < 4; ++m) _Pragma("unroll") for (int n = 0; n < 2; ++n) _Pragma("unroll") for (int k = 0; k < 2; ++k) \
        acc[ai][bj][m][n] = __builtin_amdgcn_mfma_f32_16x16x32_bf16(Bt[n][k], At[m][k], acc[ai][bj][m][n], 0, 0, 0); __builtin_amdgcn_s_setprio(0); } while (0)
#define PG8_WAIT_V(n) asm volatile("s_waitcnt vmcnt(" #n ")" ::: "memory")
#define PG8_WAIT_L(n) asm volatile("s_waitcnt lgkmcnt(" #n ")" ::: "memory")
#define PG8_BAR __builtin_amdgcn_s_barrier()
#define PG8_SCHED __builtin_amdgcn_sched_barrier(0)
    Unit cur, nxt; int ui = 0;
    if (!S.next(0, cur)) return;
    f32x4 acc[2][2][4][2];
#pragma unroll
    for (int a = 0; a < 2; ++a)
#pragma unroll
        for (int b = 0; b < 2; ++b)
#pragma unroll
            for (int m = 0; m < 4; ++m)
#pragma unroll
                for (int n = 0; n < 2; ++n) acc[a][b][m][n] = (f32x4){0.f, 0.f, 0.f, 0.f};
    bf16x8 At[4][2], B0[2][2], B1[2][2];
    const char* cA = (const char*)g.A + (size_t)cur.pm * tstep; const char* cB = (const char*)g.Bt + (size_t)cur.pn * tstep;
    S.a_ready(cur);
    if constexpr (SP2) {
        PG8_STAGE(PG8_SB(0, 0), cB, voffB); PG8_STAGE(PG8_SB(0, 1), cB + hstep, voffB); PG8_STAGE(PG8_SA(0, 0), cA, voffA); PG8_STAGE(PG8_SA(0, 1), cA + hstep, voffA);
        if (wr == 1) PG8_BAR;
        PG8_WAIT_V(2); PG8_BAR;
        PG8_STAGE(PG8_SB(1, 0), cB + kstep, voffB); PG8_STAGE(PG8_SA(1, 0), cA + kstep, voffA); PG8_STAGE(PG8_SB(1, 1), cB + hstep + kstep, voffB);
        PG8_WAIT_V(6); PG8_BAR;
    } else {
        PG8_STAGE(PG8_SB(0, 0), cB, voffB); PG8_STAGE(PG8_SA(0, 0), cA, voffA); PG8_STAGE(PG8_SB(0, 1), cB + hstep, voffB); PG8_STAGE(PG8_SA(0, 1), cA + hstep, voffA);
        if (wr == 1) PG8_BAR;
        PG8_WAIT_V(4); PG8_BAR;
        PG8_STAGE(PG8_SB(1, 0), cB + kstep, voffB); PG8_STAGE(PG8_SA(1, 0), cA + kstep, voffA); PG8_STAGE(PG8_SB(1, 1), cB + hstep + kstep, voffB);
        PG8_WAIT_V(6); PG8_BAR;
    }
    for (;;) {
        const bool has_next = S.next(ui + 1, nxt);
        const char* nA = has_next ? (const char*)g.A + (size_t)nxt.pm * tstep : cA; const char* nB = has_next ? (const char*)g.Bt + (size_t)nxt.pn * tstep : cB;
        for (int t = 0; t < nt; t += 2) {
            const bool last = (t == nt - 2);
            const char* a1 = cA + (size_t)(t + 1) * kstep;
            const char* a2 = last ? nA : cA + (size_t)(t + 2) * kstep; const char* b2 = last ? nB : cB + (size_t)(t + 2) * kstep;
            const char* a3 = a2 + kstep; const char* b3 = b2 + kstep;
            if (last && has_next) S.a_ready(nxt);
            if constexpr (SP2) {
            PG8_LDB(B0, 0, 0); PG8_LDB(B1, 0, 1); PG8_SCHED; PG8_LDA(At, 0, 0); PG8_STAGE(PG8_SA(1, 1), a1 + hstep, voffA);
            PG8_WAIT_V(8); PG8_WAIT_L(0); PG8_BAR; PG8_MMA(0, 0, At, B0); PG8_MMA(0, 1, At, B1); PG8_BAR; PG8_SCHED;
            PG8_LDA(At, 0, 1); PG8_STAGE(PG8_SB(0, 0), b2, voffB); PG8_STAGE(PG8_SB(0, 1), b2 + hstep, voffB); PG8_STAGE(PG8_SA(0, 0), a2, voffA);
            PG8_WAIT_V(8); PG8_WAIT_L(0); PG8_BAR; PG8_MMA(1, 0, At, B0); PG8_MMA(1, 1, At, B1); PG8_BAR; PG8_SCHED;
            PG8_LDB(B0, 1, 0); PG8_LDB(B1, 1, 1); PG8_SCHED; PG8_LDA(At, 1, 0); PG8_STAGE(PG8_SA(0, 1), a2 + hstep, voffA);
            PG8_WAIT_V(8); PG8_WAIT_L(0); PG8_BAR; PG8_MMA(0, 0, At, B0); PG8_MMA(0, 1, At, B1); PG8_BAR; PG8_SCHED;
            PG8_LDA(At, 1, 1); PG8_STAGE(PG8_SB(1, 0), b3, voffB); PG8_STAGE(PG8_SB(1, 1), b3 + hstep, voffB); PG8_STAGE(PG8_SA(1, 0), a3, voffA);
            PG8_WAIT_V(8); PG8_WAIT_L(0); PG8_BAR; PG8_MMA(1, 0, At, B0); PG8_MMA(1, 1, At, B1); PG8_BAR; PG8_SCHED;
            } else {
            PG8_LDB(B0, 0, 0); PG8_SCHED; PG8_LDA(At, 0, 0); PG8_STAGE(PG8_SA(1, 1), a1 + hstep, voffA);
            PG8_WAIT_L(8); PG8_BAR; PG8_WAIT_L(0); PG8_MMA(0, 0, At, B0); PG8_BAR; PG8_SCHED;
            PG8_LDB(B1, 0, 1); PG8_STAGE(PG8_SB(0, 0), b2, voffB);
            PG8_BAR; PG8_WAIT_L(0); PG8_MMA(0, 1, At, B1); PG8_BAR;
            PG8_LDA(At, 0, 1); PG8_STAGE(PG8_SA(0, 0), a2, voffA);
            PG8_BAR; PG8_WAIT_L(0); PG8_MMA(1, 0, At, B0); PG8_BAR; PG8_SCHED;
            PG8_STAGE(PG8_SB(0, 1), b2 + hstep, voffB);
            PG8_WAIT_V(6); PG8_BAR; PG8_MMA(1, 1, At, B1); PG8_BAR;
            PG8_LDB(B0, 1, 0); PG8_SCHED; PG8_LDA(At, 1, 0); PG8_STAGE(PG8_SA(0, 1), a2 + hstep, voffA);
            PG8_WAIT_L(8); PG8_BAR; PG8_WAIT_L(0); PG8_MMA(0, 0, At, B0); PG8_BAR; PG8_SCHED;
            PG8_LDB(B1, 1, 1); PG8_STAGE(PG8_SB(1, 0), b3, voffB);
            PG8_BAR; PG8_WAIT_L(0); PG8_MMA(0, 1, At, B1); PG8_BAR;
            PG8_LDA(At, 1, 1); PG8_STAGE(PG8_SA(1, 0), a3, voffA);
            PG8_BAR; PG8_WAIT_L(0); PG8_MMA(1, 0, At, B0); PG8_BAR; PG8_SCHED;
            PG8_STAGE(PG8_SB(1, 1), b3 + hstep, voffB);
            PG8_WAIT_V(6); PG8_BAR; PG8_MMA(1, 1, At, B1); PG8_BAR;
            }
        }
        if constexpr (ALIGN_EPI) { if (wr == 0) PG8_BAR; }
        if constexpr (!Epi::AFTER_DRAIN) { E(acc, cur, wr, wc, fr, fq); S.done(cur); }
        if (!has_next) break;
#pragma unroll
        for (int a = 0; a < 2; ++a)
#pragma unroll
            for (int b = 0; b < 2; ++b)
#pragma unroll
                for (int m = 0; m < 4; ++m)
#pragma unroll
                    for (int n = 0; n < 2; ++n) acc[a][b][m][n] = (f32x4){0.f, 0.f, 0.f, 0.f};
        cur = nxt; cA = nA; cB = nB; ++ui;
        if constexpr (ALIGN_EPI) { if (wr == 1) PG8_BAR; }
    }
    PG8_WAIT_V(0);
    if constexpr (!ALIGN_EPI) { if (wr == 0) PG8_BAR; }
    PG8_BAR;
    if constexpr (Epi::AFTER_DRAIN) { E.fused(acc, cur, wr, wc, fr, fq, lds, wid, lane); S.done(cur); }
#undef PG8_SA
#undef PG8_SB
#undef PG8_STAGE
#undef PG8_LDA
#undef PG8_LDB
#undef PG8_MMA
#undef PG8_WAIT_V
#undef PG8_WAIT_L
#undef PG8_BAR
#undef PG8_SCHED
}
}

#define LAS __attribute__((address_space(3)))
typedef unsigned short bf16;
typedef short bf16x8 __attribute__((ext_vector_type(8)));
typedef short bf16x4 __attribute__((ext_vector_type(4)));
typedef float f32x4 __attribute__((ext_vector_type(4)));
typedef float f32x2 __attribute__((ext_vector_type(2)));
typedef float f32x16 __attribute__((ext_vector_type(16)));
typedef unsigned u32x4 __attribute__((ext_vector_type(4)));
typedef unsigned u32x2 __attribute__((ext_vector_type(2)));

constexpr int D = 1024, NB = 8, SEQ = 2048, TP = NB * SEQ, SB = 128, SS = 4, TS = SB * SS, T = TP + TS;
constexpr int DR = 512, DC = 512, DIN = 2048, NMEM = 256, NH = 4, HD = 256, DFF = 2816, MROWS = NB * NMEM;
constexpr int NTHREADS = 512, NWAVES = 8, GRID = 256;
constexpr float EPS = 1e-6f;
constexpr float QSCALE = 0.0625f * 1.4426950408889634f;

enum { I_XP = 0, I_XS, I_SH, I_SRG, I_SCF, I_CK, I_CV, I_MEM, I_GMIX, I_WIN, I_RGCW, I_RGCB, I_WA, I_BA, I_WX, I_BX, I_LAM, I_CFW, I_CFB, I_LNG, I_LNB, I_WOUT,
       I_GATTN, I_GMEM, I_WQ, I_WK, I_WV, I_WO, I_GFFN, I_WG, I_WU, I_WD, I_GFIN, N_IN };
constexpr size_t O_YP = 0, O_YS = (size_t)TP * D, O_PH = O_YS + (size_t)TS * D, O_PRG = O_PH + 2 * NB * DR, O_PCF = O_PRG + 2 * NB * 3 * DR, O_PMK = O_PCF + 2 * NB * 30 * DC,
                 O_PMV = O_PMK + (size_t)2 * MROWS * D, O_SH = O_PMV + (size_t)2 * MROWS * D, O_SRG = O_SH + 2 * SB * DR, O_SCF = O_SRG + 2 * SB * 3 * DR, O_END = O_SCF + (size_t)2 * SB * 30 * DC;
constexpr size_t MiB = 1u << 20;
constexpr size_t WS_SSQ = 0, WS_SSQM = 512 * 1024, WS_SP8 = 640 * 1024, WS_BAR = 768 * 1024, BAR_BYTES = 16384, WS_AGG = 1 * MiB, WS_RGW = 2 * MiB, WS_W = 4 * MiB, W_LAYER = 31 * MiB;
constexpr size_t WO_IN = 0, WO_OUT = 4 * MiB, WO_Q = 6 * MiB, WO_KV = 8 * MiB, WO_O = 12 * MiB, WO_GU = 14 * MiB, WO_D = 25 * MiB;
constexpr size_t WS_X = 68 * MiB, WS_XB = 134 * MiB, WS_U = 167 * MiB, WS_YM = 233 * MiB, WS_QB = 266 * MiB, WS_H = 299 * MiB, WS_MEMB = 390 * MiB, WS_KB = 394 * MiB, WS_VT = 402 * MiB, WS_END = 410 * MiB;
constexpr int LDS_BYTES = 147456, LDS_BARW = LDS_BYTES - 64;

struct Params { const float* in[N_IN]; float* out; unsigned char* ws; int ph_lo, ph_hi; };
typedef const __attribute__((address_space(4))) Params CParams;
__device__ __forceinline__ int otid() { int t = threadIdx.x; asm volatile("" : "+v"(t)); return t; }

__device__ __forceinline__ unsigned f2bf(float f) { unsigned u = __builtin_bit_cast(unsigned, f); return (u + 0x7fffu + ((u >> 16) & 1u)) >> 16; }
__device__ __forceinline__ unsigned pk2(float lo, float hi) { return f2bf(lo) | (f2bf(hi) << 16); }
__device__ __forceinline__ float bf2f(unsigned short b) { return __builtin_bit_cast(float, ((unsigned)b) << 16); }
__device__ __forceinline__ float bflo(unsigned w) { return __builtin_bit_cast(float, w << 16); }
__device__ __forceinline__ float bfhi(unsigned w) { return __builtin_bit_cast(float, w & 0xffff0000u); }
__device__ __forceinline__ float wave_sum(float v) {
#pragma unroll
    for (int o = 1; o < 64; o <<= 1) v += __shfl_xor(v, o);
    return v;
}
__device__ __forceinline__ float sigmoidf_(float x) { return __builtin_amdgcn_rcpf(1.0f + __expf(-x)); }
__device__ __forceinline__ float gelu_tanh(float x) {
    const float u = 0.7978845608028654f * (x + 0.044715f * x * x * x);
    const float t = 1.0f - 2.0f * __builtin_amdgcn_rcpf(1.0f + __expf(2.0f * u));
    return 0.5f * x * (1.0f + t);
}
__device__ __forceinline__ float softplusf_(float x) { return x > 15.f ? x : log1pf(__expf(x)); }
__device__ __forceinline__ void lru_coef(float la, float& a, float& mult) {
    a = __expf(la); const float x = 2.0f * la;
    const float ser = -x * (1.0f + x * (0.5f + x * (0.16666667f + x * (0.041666667f + x * (0.0083333333f + x * 0.0013888889f)))));
    const float om = (x > -0.25f) ? ser : (1.0f - a * a);
    mult = sqrtf(om);
}

#define XB_TMO      128
#define XB_XCNT(j)  (256  + 64 * (j))
#define XB_XSUB(j)  (1280 + 64 * (j))
#define XB_XGEN(j)  (2304 + 64 * (j))
#define XB_TOP      3328
#define XB_TOPGEN   3392
#define XCD_BAR_WORDS 3456
#define XB_SPIN_CAP (1u << 18)

__device__ __forceinline__ unsigned xb_ld(unsigned* p)              { return __hip_atomic_load(p, __ATOMIC_RELAXED, __HIP_MEMORY_SCOPE_AGENT); }
__device__ __forceinline__ unsigned xb_add(unsigned* p, unsigned v) { return __hip_atomic_fetch_add(p, v, __ATOMIC_RELAXED, __HIP_MEMORY_SCOPE_AGENT); }
__device__ __forceinline__ unsigned xb_xcc_id() { return (unsigned)__builtin_amdgcn_s_getreg((3 << 11) | 20) & 0xFu; }
#define XB_SPIN(cond, bar) do { unsigned _sp = 0; while (cond) { __builtin_amdgcn_s_sleep(1); \
    if ((++_sp & 255u) == 0u) { if (xb_ld(&(bar)[XB_TMO])) break; if (_sp > XB_SPIN_CAP) { atomicAdd(&(bar)[XB_TMO], 1u); break; } } } } while (0)

struct XcdBarrier {
    unsigned* bar; unsigned x;
    volatile LAS unsigned* st;
};

__device__ __forceinline__ XcdBarrier xcd_barrier_post(unsigned* bar, volatile LAS unsigned* st) {
    XcdBarrier b; b.bar = bar; b.x = xb_xcc_id(); b.st = st;
    if (threadIdx.x == 0) (void)xb_add(&bar[XB_XCNT(b.x)], 1u);
    return b;
}
__device__ __forceinline__ void xcd_barrier_complete(unsigned* bar, unsigned x, unsigned& nloc, unsigned& nx) {
    const unsigned G = gridDim.x * gridDim.y * gridDim.z;
    unsigned sum, cnt, mine, sp = 0u;
    for (;;) {
        sum = 0u; cnt = 0u; mine = 0u;
#pragma unroll
        for (unsigned j = 0; j < 16; ++j) { const unsigned c = xb_ld(&bar[XB_XCNT(j)]); sum += c; cnt += (c > 0u) ? 1u : 0u; mine = (j == x) ? c : mine; }
        if (sum == G) break;
        __builtin_amdgcn_s_sleep(1);
        if ((++sp & 255u) == 0u) { if (xb_ld(&bar[XB_TMO])) break; if (sp > XB_SPIN_CAP) { atomicAdd(&bar[XB_TMO], 1u); break; } }
    }
    nloc = mine > 0u ? mine : 1u; nx = cnt > 0u ? cnt : 1u;
}

__device__ __forceinline__ void xcd_barrier(const XcdBarrier& b) {
    asm volatile("s_waitcnt vmcnt(0)" ::: "memory");
    __syncthreads();
    if (threadIdx.x == 0) {
        unsigned* bar = b.bar;
        __builtin_amdgcn_s_waitcnt(0);
        unsigned nloc = b.st[0], nx = b.st[1];
        if (nloc == 0u) { xcd_barrier_complete(bar, b.x, nloc, nx); b.st[0] = nloc; b.st[1] = nx; }
        const unsigned old = xb_add(&bar[XB_XSUB(b.x)], 1u);
        const unsigned gen = old / nloc;
        if (old + 1u == (gen + 1u) * nloc) {
            __builtin_amdgcn_fence(__ATOMIC_RELEASE, "agent");
            asm volatile("s_waitcnt vmcnt(0)" ::: "memory");
            const unsigned og = xb_add(&bar[XB_TOP], 1u);
            const unsigned tg = og / nx;
            if (og + 1u == (tg + 1u) * nx) xb_add(&bar[XB_TOPGEN], 1u);
            else XB_SPIN(xb_ld(&bar[XB_TOPGEN]) == tg, bar);
            __builtin_amdgcn_fence(__ATOMIC_ACQUIRE, "agent");
            xb_add(&bar[XB_XGEN(b.x)], 1u);
            asm volatile("s_waitcnt vmcnt(0)" ::: "memory");
        } else {
            XB_SPIN(xb_ld(&bar[XB_XGEN(b.x)]) == gen, bar);
            __builtin_amdgcn_fence(__ATOMIC_ACQUIRE, "agent");
            asm volatile("s_waitcnt vmcnt(0)" ::: "memory");
        }
    }
    __syncthreads();
}

__device__ __forceinline__ void transpose_item(const float* W, int K, int N, const float* gain, bf16* WT, int dst_row0, LAS float* scr, int k0, int n0, int lane) {
    const int kr = lane >> 4, nq = lane & 15;
    f32x4 v[16];
#pragma unroll
    for (int i = 0; i < 16; ++i) v[i] = *(const f32x4*)(W + (size_t)(k0 + 4 * i + kr) * N + n0 + 4 * nq);
#pragma unroll
    for (int i = 0; i < 16; ++i) { const int kk = 4 * i + kr; const float g = gain ? gain[k0 + kk] : 1.0f; LAS float* d = scr + kk * 65 + 4 * nq;
        d[0] = v[i].x * g; d[1] = v[i].y * g; d[2] = v[i].z * g; d[3] = v[i].w * g; }
    asm volatile("s_waitcnt lgkmcnt(0)" ::: "memory");
    const int c = lane & 7;
#pragma unroll
    for (int j = 0; j < 8; ++j) { const int n = (lane >> 3) + 8 * j; const LAS float* s = scr + (8 * c) * 65 + n;
        u32x4 o; o.x = pk2(s[0 * 65], s[1 * 65]); o.y = pk2(s[2 * 65], s[3 * 65]); o.z = pk2(s[4 * 65], s[5 * 65]); o.w = pk2(s[6 * 65], s[7 * 65]);
        *(u32x4*)(WT + (size_t)(dst_row0 + n) * K + k0 + 8 * c) = o; }
    asm volatile("s_waitcnt lgkmcnt(0)" ::: "memory");
}
__device__ __forceinline__ void prologue(CParams& p, LAS unsigned char* lds) {
    const int tid = otid(), lane = tid & 63, wave = tid >> 6;
    const int gw = blockIdx.x * NWAVES + wave, NGW = gridDim.x * NWAVES;
    LAS float* scr = (LAS float*)(lds + wave * 18432);
    unsigned char* ws = p.ws;
    constexpr int I_SQ = 256, I_INN = 512, I_GU = 704, PER_LAYER = I_INN + 5 * I_SQ + 3 * I_GU;
    for (int it = gw; it < 2 * PER_LAYER; it += NGW) {
        const int l = it / PER_LAYER; int r = it % PER_LAYER;
        unsigned char* wl = ws + WS_W + (size_t)l * W_LAYER;
        const float* W; const float* gain = nullptr; bf16* WT; int K = D, N = D, mode = 0;
        int off = 0;
        if (r < I_INN) { W = p.in[I_WIN] + (size_t)l * D * DIN; gain = p.in[I_GMIX] + l * D; WT = (bf16*)(wl + WO_IN); N = DIN; }
        else if ((r -= I_INN) < I_SQ) { W = p.in[I_WOUT] + (size_t)l * D * D; WT = (bf16*)(wl + WO_OUT); }
        else if ((r -= I_SQ) < I_SQ) { W = p.in[I_WQ] + (size_t)l * D * D; gain = p.in[I_GATTN] + l * D; WT = (bf16*)(wl + WO_Q); }
        else if ((r -= I_SQ) < I_SQ) { W = p.in[I_WK] + (size_t)l * D * D; gain = p.in[I_GMEM] + l * D; WT = (bf16*)(wl + WO_KV); }
        else if ((r -= I_SQ) < I_SQ) { W = p.in[I_WV] + (size_t)l * D * D; gain = p.in[I_GMEM] + l * D; WT = (bf16*)(wl + WO_KV); off = 1024; }
        else if ((r -= I_SQ) < I_SQ) { W = p.in[I_WO] + (size_t)l * D * D; WT = (bf16*)(wl + WO_O); }
        else if ((r -= I_SQ) < I_GU) { W = p.in[I_WG] + (size_t)l * D * DFF; gain = p.in[I_GFFN] + l * D; WT = (bf16*)(wl + WO_GU); N = DFF; mode = 1; }
        else if ((r -= I_GU) < I_GU) { W = p.in[I_WU] + (size_t)l * D * DFF; gain = p.in[I_GFFN] + l * D; WT = (bf16*)(wl + WO_GU); N = DFF; mode = 2; }
        else { r -= I_GU; W = p.in[I_WD] + (size_t)l * DFF * D; WT = (bf16*)(wl + WO_D); K = DFF; }
        const int nblk = N / 64, kb = r / nblk, nb = r % nblk, k0 = 64 * kb, n0 = 64 * nb;
        int dst0 = n0 + off;
        if (mode) dst0 = (n0 >> 7) * 256 + (n0 & 127) + (mode == 2 ? 128 : 0);
        transpose_item(W, K, N, gain, WT, dst0, scr, k0, n0, lane);
    }
    float* X = (float*)(ws + WS_X); bf16* XB = (bf16*)(ws + WS_XB); float* SSQ = (float*)(ws + WS_SSQ); float* SSQM = (float*)(ws + WS_SSQM); bf16* MEMB = (bf16*)(ws + WS_MEMB);
    for (int m = gw; m < T + MROWS; m += NGW) {
        const bool ismem = m >= T; const int mr = ismem ? m - T : m;
        const float* src = ismem ? p.in[I_MEM] + (size_t)mr * D : (m < TP ? p.in[I_XP] + (size_t)m * D : p.in[I_XS] + (size_t)(m - TP) * D);
        const f32x4* xr = (const f32x4*)src + lane; f32x4 v[4]; float s = 0.f;
#pragma unroll
        for (int j = 0; j < 4; ++j) { v[j] = xr[64 * j]; s += (v[j].x * v[j].x + v[j].y * v[j].y) + (v[j].z * v[j].z + v[j].w * v[j].w); }
        s = wave_sum(s);
        bf16* ob = ismem ? MEMB + (size_t)mr * D : XB + (size_t)m * D;
        unsigned long long* o8 = (unsigned long long*)ob + lane;
#pragma unroll
        for (int j = 0; j < 4; ++j) o8[64 * j] = (unsigned long long)pk2(v[j].x, v[j].y) | ((unsigned long long)pk2(v[j].z, v[j].w) << 32);
        if (!ismem) { f32x4* xo = (f32x4*)(X + (size_t)m * D) + lane;
#pragma unroll
            for (int j = 0; j < 4; ++j) xo[64 * j] = v[j];
            if (lane == 0) SSQ[m] = s; }
        else if (lane == 0) SSQM[mr] = s;
    }
    for (int i = blockIdx.x * NTHREADS + tid; i < 6 * T; i += gridDim.x * NTHREADS) SSQ[T + i] = 0.f;
    bf16* RGW = (bf16*)(ws + WS_RGW);
    for (int i = blockIdx.x * NTHREADS + tid; i < 2 * 2 * 8 * 64 * 64; i += gridDim.x * NTHREADS) {
        const int l = i >> 16, g = (i >> 15) & 1, h = (i >> 12) & 7, j = (i >> 6) & 63, ii = i & 63;
        const float* src = (g ? p.in[I_WX] : p.in[I_WA]) + (size_t)((l * 8 + h) * 64 + ii) * 64 + j;
        RGW[i] = (bf16)f2bf(*src);
    }
    float* SP8 = (float*)(ws + WS_SP8);
    for (int i = blockIdx.x * NTHREADS + tid; i < 2 * DR; i += gridDim.x * NTHREADS) SP8[i] = -8.0f * softplusf_(-p.in[I_LAM][i]);
}

__device__ __forceinline__ void conf_prompt_item(CParams& p, int l, int b, int ck, LAS unsigned char* lds) {
    const int tid = otid(), lane = tid & 63, wave = tid >> 6, c = tid;
    const bf16* U = (const bf16*)(p.ws + WS_U); bf16* YM = (bf16*)(p.ws + WS_YM);
    LAS float* cO = (LAS float*)lds;
    const int t0 = ck * 32; const size_t rowb = (size_t)b * SEQ;
    LAS float* cL = (LAS float*)lds;
#pragma unroll 1
    for (int i0 = 0; i0 < 8; i0 += 4) {
        u32x4 va[4], vg[4];
#pragma unroll
        for (int i = 0; i < 4; ++i) { const int r = wave + 8 * (i0 + i), t = t0 - 30 + r; va[i] = (u32x4){0u, 0u, 0u, 0u}; vg[i] = va[i];
            if (r < 62 && t >= 0) { const bf16* up = U + (rowb + t) * DIN + lane * 8; va[i] = *(const u32x4*)(up + 1024); vg[i] = *(const u32x4*)(up + 1536); } }
#pragma unroll
        for (int i = 0; i < 4; ++i) { const int r = wave + 8 * (i0 + i);
            if (r < 62) { f32x4 c0, c1;
                c0.x = bflo(va[i].x) * sigmoidf_(bflo(vg[i].x)); c0.y = bfhi(va[i].x) * sigmoidf_(bfhi(vg[i].x)); c0.z = bflo(va[i].y) * sigmoidf_(bflo(vg[i].y)); c0.w = bfhi(va[i].y) * sigmoidf_(bfhi(vg[i].y));
                c1.x = bflo(va[i].z) * sigmoidf_(bflo(vg[i].z)); c1.y = bfhi(va[i].z) * sigmoidf_(bfhi(vg[i].z)); c1.z = bflo(va[i].w) * sigmoidf_(bflo(vg[i].w)); c1.w = bfhi(va[i].w) * sigmoidf_(bfhi(vg[i].w));
                *(LAS f32x4*)(cL + r * 512 + lane * 8) = c0; *(LAS f32x4*)(cL + r * 512 + lane * 8 + 4) = c1;
                if (ck == 63 && r >= 32) { float* op = p.out + O_PCF + ((size_t)(l * NB + b) * 30 + (r - 32)) * DC + lane * 8; *(f32x4*)op = c0; *(f32x4*)(op + 4) = c1; } } }
    }
    __syncthreads();
    const float* wp = p.in[I_CFW] + (size_t)l * 31 * DC + c; const float bias = p.in[I_CFB][l * DC + c];
    float w[31];
#pragma unroll
    for (int j = 0; j < 31; ++j) w[j] = wp[j * DC];
#pragma unroll 1
    for (int t4 = 0; t4 < 32; t4 += 4) { float a0 = bias, a1 = bias, a2 = bias, a3 = bias; const LAS float* cp = cL + t4 * 512 + c;
#pragma unroll
        for (int j = 0; j < 34; ++j) { const float v = cp[j * 512];
            if (j < 31) a0 += w[j] * v;
            if (j >= 1 && j < 32) a1 += w[j - 1] * v;
            if (j >= 2 && j < 33) a2 += w[j - 2] * v;
            if (j >= 3) a3 += w[j - 3] * v; }
        cO[(t4 + 0) * 512 + c] = a0; cO[(t4 + 1) * 512 + c] = a1; cO[(t4 + 2) * 512 + c] = a2; cO[(t4 + 3) * 512 + c] = a3; }
    __syncthreads();
    const f32x4* gp = (const f32x4*)(p.in[I_LNG] + l * DC + lane * 8); const f32x4* bp = (const f32x4*)(p.in[I_LNB] + l * DC + lane * 8);
    const f32x4 g0 = gp[0], g1 = gp[1], b0 = bp[0], b1 = bp[1];
#pragma unroll
    for (int i = 0; i < 4; ++i) { const int t = wave + 8 * i;
        const f32x4 x0 = *(const LAS f32x4*)(cO + t * 512 + lane * 8), x1 = *(const LAS f32x4*)(cO + t * 512 + lane * 8 + 4);
        const float mean = wave_sum((x0.x + x0.y) + (x0.z + x0.w) + (x1.x + x1.y) + (x1.z + x1.w)) * (1.0f / 512.0f);
        const f32x4 d0 = x0 - mean, d1 = x1 - mean;
        const float var = wave_sum((d0.x * d0.x + d0.y * d0.y) + (d0.z * d0.z + d0.w * d0.w) + (d1.x * d1.x + d1.y * d1.y) + (d1.z * d1.z + d1.w * d1.w)) * (1.0f / 512.0f);
        const float rs = rsqrtf(var + EPS);
        f32x4 y0 = d0 * rs * g0 + b0, y1 = d1 * rs * g1 + b1;
#pragma unroll
        for (int j = 0; j < 4; ++j) { y0[j] = y0[j] * sigmoidf_(y0[j]); y1[j] = y1[j] * sigmoidf_(y1[j]); }
        u32x4 o; o.x = pk2(y0.x, y0.y); o.y = pk2(y0.z, y0.w); o.z = pk2(y1.x, y1.y); o.w = pk2(y1.z, y1.w);
        *(u32x4*)(YM + (rowb + t0 + t) * D + 512 + lane * 8) = o; }
    __syncthreads();
}

__device__ __forceinline__ void sample_mixer_item(CParams& p, int l, int sb, LAS unsigned char* lds) {
    const int tid = otid(), lane = tid & 63, wave = tid >> 6, c = tid;
    const bf16* U = (const bf16*)(p.ws + WS_U); bf16* YM = (bf16*)(p.ws + WS_YM);
    LAS float* xcS = (LAS float*)lds;
    LAS float* cS = (LAS float*)(lds + 8192);
    const size_t row0 = (size_t)TP + sb * SS;
    float xp[7];
    { const float* st = p.in[I_SRG] + ((size_t)(l * SB + sb) * 3) * DR + c; xp[0] = st[0]; xp[1] = st[DR]; xp[2] = st[2 * DR]; }
    float gr[4];
#pragma unroll
    for (int t = 0; t < 4; ++t) { const bf16* up = U + (row0 + t) * DIN; xp[3 + t] = bf2f(up[c]); gr[t] = bf2f(up[512 + c]); }
#pragma unroll
    for (int j = 0; j < 3; ++j) p.out[O_SRG + ((size_t)(l * SB + sb) * 3 + j) * DR + c] = xp[4 + j];
    float xc[4];
    { const float* cw = p.in[I_RGCW] + (size_t)l * 4 * DR + c; const float w0 = cw[0], w1 = cw[DR], w2 = cw[2 * DR], w3 = cw[3 * DR], bc = p.in[I_RGCB][l * DR + c];
#pragma unroll
      for (int t = 0; t < 4; ++t) { xc[t] = bc + w0 * xp[t] + w1 * xp[t + 1] + w2 * xp[t + 2] + w3 * xp[t + 3]; xcS[t * 512 + c] = xc[t]; } }
    __syncthreads();
    float ra[4], ia[4];
    { const float ba = p.in[I_BA][l * DR + c], bx = p.in[I_BX][l * DR + c];
#pragma unroll
      for (int t = 0; t < 4; ++t) { ra[t] = ba; ia[t] = bx; }
      const int h = c >> 6, jj = c & 63;
      const float* wa = p.in[I_WA] + (size_t)((l * 8 + h) * 64) * 64 + jj; const float* wx = p.in[I_WX] + (size_t)((l * 8 + h) * 64) * 64 + jj;
#pragma unroll 16
      for (int i = 0; i < 64; ++i) { const float a = wa[i * 64], x = wx[i * 64];
#pragma unroll
          for (int t = 0; t < 4; ++t) { const float xv = xcS[t * 512 + h * 64 + i]; ra[t] += xv * a; ia[t] += xv * x; } } }
    { const float sp8 = ((const float*)(p.ws + WS_SP8))[l * DR + c];
      float hs = p.in[I_SH][(size_t)(l * SB + sb) * DR + c];
#pragma unroll
      for (int t = 0; t < 4; ++t) { const float r = sigmoidf_(ra[t]), ig = sigmoidf_(ia[t]); float a, mult; lru_coef(sp8 * r, a, mult);
          hs = a * hs + mult * (ig * xc[t]);
          YM[(row0 + t) * D + c] = (bf16)f2bf(hs * gelu_tanh(gr[t])); }
      p.out[O_SH + (size_t)(l * SB + sb) * DR + c] = hs; }
    { float cp[34];
      const float* st = p.in[I_SCF] + ((size_t)(l * SB + sb) * 30) * DC + c;
#pragma unroll
      for (int j = 0; j < 30; ++j) cp[j] = st[j * DC];
#pragma unroll
      for (int t = 0; t < 4; ++t) { const bf16* up = U + (row0 + t) * DIN; cp[30 + t] = bf2f(up[1024 + c]) * sigmoidf_(bf2f(up[1536 + c])); }
#pragma unroll
      for (int j = 0; j < 30; ++j) p.out[O_SCF + ((size_t)(l * SB + sb) * 30 + j) * DC + c] = cp[4 + j];
      const float* wp = p.in[I_CFW] + (size_t)l * 31 * DC + c; const float bias = p.in[I_CFB][l * DC + c];
      float a4[4] = {bias, bias, bias, bias};
#pragma unroll
      for (int j = 0; j < 31; ++j) { const float w = wp[j * DC];
#pragma unroll
          for (int t = 0; t < 4; ++t) a4[t] += w * cp[t + j]; }
#pragma unroll
      for (int t = 0; t < 4; ++t) cS[t * 512 + c] = a4[t]; }
    __syncthreads();
    if (wave < 4) { const int t = wave;
        const f32x4* gp = (const f32x4*)(p.in[I_LNG] + l * DC + lane * 8); const f32x4* bp = (const f32x4*)(p.in[I_LNB] + l * DC + lane * 8);
        const f32x4 g0 = gp[0], g1 = gp[1], b0 = bp[0], b1 = bp[1];
        const f32x4 x0 = *(const LAS f32x4*)(cS + t * 512 + lane * 8), x1 = *(const LAS f32x4*)(cS + t * 512 + lane * 8 + 4);
        const float mean = wave_sum((x0.x + x0.y) + (x0.z + x0.w) + (x1.x + x1.y) + (x1.z + x1.w)) * (1.0f / 512.0f);
        const f32x4 d0 = x0 - mean, d1 = x1 - mean;
        const float var = wave_sum((d0.x * d0.x + d0.y * d0.y) + (d0.z * d0.z + d0.w * d0.w) + (d1.x * d1.x + d1.y * d1.y) + (d1.z * d1.z + d1.w * d1.w)) * (1.0f / 512.0f);
        const float rs = rsqrtf(var + EPS);
        f32x4 y0 = d0 * rs * g0 + b0, y1 = d1 * rs * g1 + b1;
#pragma unroll
        for (int j = 0; j < 4; ++j) { y0[j] = y0[j] * sigmoidf_(y0[j]); y1[j] = y1[j] * sigmoidf_(y1[j]); }
        u32x4 o; o.x = pk2(y0.x, y0.y); o.y = pk2(y0.z, y0.w); o.z = pk2(y1.x, y1.y); o.w = pk2(y1.z, y1.w);
        *(u32x4*)(YM + (row0 + t) * D + 512 + lane * 8) = o; }
    __syncthreads();
}

constexpr int GR_OFF = 69632, CARRY_OFF = 137216;
constexpr int XC_PITCH = 1040;
struct RgState { float Hl[4][4][4]; float Pl[4][4][4]; };

__device__ __forceinline__ void rglru_part1(CParams& p, int l, int b, int k, LAS unsigned char* lds, RgState& S) {
    const int tid = otid(), lane = tid & 63, h = tid >> 6, fr = lane & 15, fq = lane >> 4;
    const bf16* U = (const bf16*)(p.ws + WS_U);
    {
        const int wave = h; const size_t row = (size_t)b * SEQ + k * 64;
        u32x4 xr[11];
#pragma unroll
        for (int i = 0; i < 11; ++i) { const int t = 8 * wave - 3 + i; xr[i] = (u32x4){0u, 0u, 0u, 0u};
            if (k > 0 || t >= 0) xr[i] = *(const u32x4*)(U + (row + t) * DIN + lane * 8); }
        u32x4 gq[8];
#pragma unroll
        for (int i = 0; i < 8; ++i) { const int idx = tid + 512 * i; gq[i] = *(const u32x4*)(U + (row + (idx >> 6)) * DIN + 512 + (idx & 63) * 8); }
        const float* cw = p.in[I_RGCW] + (size_t)l * 4 * DR + lane * 8; const float* cb = p.in[I_RGCB] + l * DR + lane * 8;
        float wj[4][8], bc[8];
#pragma unroll
        for (int j = 0; j < 4; ++j) { const f32x4 a0 = *(const f32x4*)(cw + j * DR), a1 = *(const f32x4*)(cw + j * DR + 4);
            wj[j][0] = a0.x; wj[j][1] = a0.y; wj[j][2] = a0.z; wj[j][3] = a0.w; wj[j][4] = a1.x; wj[j][5] = a1.y; wj[j][6] = a1.z; wj[j][7] = a1.w; }
        { const f32x4 a0 = *(const f32x4*)cb, a1 = *(const f32x4*)(cb + 4); bc[0] = a0.x; bc[1] = a0.y; bc[2] = a0.z; bc[3] = a0.w; bc[4] = a1.x; bc[5] = a1.y; bc[6] = a1.z; bc[7] = a1.w; }
#pragma unroll
        for (int tt = 0; tt < 8; ++tt) { float o[8];
#pragma unroll
            for (int e = 0; e < 8; ++e) { float a = bc[e];
#pragma unroll
                for (int j = 0; j < 4; ++j) { const unsigned wv = xr[tt + j][e >> 1]; a += wj[j][e] * ((e & 1) ? bfhi(wv) : bflo(wv)); }
                o[e] = a; }
            u32x4 w; w.x = pk2(o[0], o[1]); w.y = pk2(o[2], o[3]); w.z = pk2(o[4], o[5]); w.w = pk2(o[6], o[7]);
            *(LAS u32x4*)(lds + (8 * wave + tt) * XC_PITCH + lane * 16) = w; }
        if (k == 31 && wave == 7) {
#pragma unroll
            for (int j = 0; j < 3; ++j) { const u32x4 wv = xr[8 + j]; float* op = p.out + O_PRG + ((size_t)(l * NB + b) * 3 + j) * DR + lane * 8;
                *(f32x4*)op = (f32x4){bflo(wv.x), bfhi(wv.x), bflo(wv.y), bfhi(wv.y)}; *(f32x4*)(op + 4) = (f32x4){bflo(wv.z), bfhi(wv.z), bflo(wv.w), bfhi(wv.w)}; } }
#pragma unroll
        for (int i = 0; i < 8; ++i) { const int idx = tid + 512 * i; *(LAS u32x4*)(lds + GR_OFF + (idx >> 6) * 1024 + (idx & 63) * 16) = gq[i]; }
    }
    __syncthreads();
    const bf16* RGW = (const bf16*)(p.ws + WS_RGW) + (size_t)(l * 2) * 8 * 4096;
    float2* AGG = (float2*)(p.ws + WS_AGG);
#pragma unroll
    for (int ct = 0; ct < 4; ++ct) {
        const int c = h * 64 + 16 * ct + fr;
        bf16x8 wf[2][2];
#pragma unroll
        for (int g = 0; g < 2; ++g)
#pragma unroll
            for (int ks = 0; ks < 2; ++ks) wf[g][ks] = *(const bf16x8*)(RGW + (size_t)((g * 8 + h) * 64 + 16 * ct + fr) * 64 + 32 * ks + 8 * fq);
        const float ba = p.in[I_BA][l * DR + c], bx = p.in[I_BX][l * DR + c], sp8 = ((const float*)(p.ws + WS_SP8))[l * DR + c];
        float Ac = 1.f, Bc = 0.f;
#pragma unroll
        for (int tt = 0; tt < 4; ++tt) {
            const bf16x8 xf0 = *(const LAS bf16x8*)(lds + (16 * tt + fr) * XC_PITCH + (h * 64 + 8 * fq) * 2);
            const bf16x8 xf1 = *(const LAS bf16x8*)(lds + (16 * tt + fr) * XC_PITCH + (h * 64 + 32 + 8 * fq) * 2);
            f32x4 racc = {0.f, 0.f, 0.f, 0.f}, iacc = {0.f, 0.f, 0.f, 0.f};
            racc = __builtin_amdgcn_mfma_f32_16x16x32_bf16(xf0, wf[0][0], racc, 0, 0, 0); racc = __builtin_amdgcn_mfma_f32_16x16x32_bf16(xf1, wf[0][1], racc, 0, 0, 0);
            iacc = __builtin_amdgcn_mfma_f32_16x16x32_bf16(xf0, wf[1][0], iacc, 0, 0, 0); iacc = __builtin_amdgcn_mfma_f32_16x16x32_bf16(xf1, wf[1][1], iacc, 0, 0, 0);
            float hq = 0.f, pq = 1.f;
#pragma unroll
            for (int e = 0; e < 4; ++e) { const float xcv = bf2f(*(const LAS bf16*)(lds + (16 * tt + 4 * fq + e) * XC_PITCH + c * 2));
                const float r = sigmoidf_(racc[e] + ba), ig = sigmoidf_(iacc[e] + bx); float a, mult; lru_coef(sp8 * r, a, mult);
                hq = a * hq + mult * (ig * xcv); pq *= a; S.Hl[ct][tt][e] = hq; S.Pl[ct][tt][e] = pq; }
            float Ai = pq, Bi = hq;
            { const float A1 = __shfl_up(Ai, 16), B1 = __shfl_up(Bi, 16); if (fq >= 1) { Bi = Ai * B1 + Bi; Ai = A1 * Ai; } }
            { const float A2 = __shfl_up(Ai, 32), B2 = __shfl_up(Bi, 32); if (fq >= 2) { Bi = Ai * B2 + Bi; Ai = A2 * Ai; } }
            float Ae = __shfl_up(Ai, 16), Be = __shfl_up(Bi, 16); if (fq == 0) { Ae = 1.f; Be = 0.f; }
            const float Ap = Ac * Ae, Bp = Ae * Bc + Be;
#pragma unroll
            for (int e = 0; e < 4; ++e) { S.Hl[ct][tt][e] += S.Pl[ct][tt][e] * Bp; S.Pl[ct][tt][e] *= Ap; }
            const float At = __shfl(Ai, 48 + fr), Bt = __shfl(Bi, 48 + fr);
            Bc = At * Bc + Bt; Ac = Ac * At;
            asm volatile("" ::: "memory");
        }
        if (fq == 0) AGG[(size_t)(b * 32 + k) * DR + c] = make_float2(Ac, Bc);
    }
}
__device__ __forceinline__ void rglru_part2(CParams& p, int l, int b, int k, LAS unsigned char* lds, const RgState& S) {
    const int tid = otid(), lane = tid & 63, h = tid >> 6, fr = lane & 15, fq = lane >> 4;
    bf16* YM = (bf16*)(p.ws + WS_YM);
    const float2* AGG = (const float2*)(p.ws + WS_AGG);
    { float carry = 0.f; const float2* ap = AGG + (size_t)(b * 32) * DR + tid;
#pragma unroll 8
        for (int kk = 0; kk < k; ++kk) { const float2 ab = ap[(size_t)kk * DR]; carry = ab.x * carry + ab.y; }
        *(LAS float*)(lds + CARRY_OFF + tid * 4) = carry; }
    __syncthreads();
#pragma unroll
    for (int ct = 0; ct < 4; ++ct) {
        const int c = h * 64 + 16 * ct + fr; const float carry = *(const LAS float*)(lds + CARRY_OFF + c * 4);
#pragma unroll
        for (int tt = 0; tt < 4; ++tt)
#pragma unroll
            for (int e = 0; e < 4; ++e) { const float hv = S.Hl[ct][tt][e] + S.Pl[ct][tt][e] * carry;
                LAS bf16* gp = (LAS bf16*)(lds + GR_OFF + (16 * tt + 4 * fq + e) * 1024 + c * 2);
                *gp = (bf16)f2bf(hv * gelu_tanh(bf2f(*gp)));
                if (k == 31 && tt == 3 && e == 3 && fq == 3) p.out[O_PH + (size_t)(l * NB + b) * DR + c] = hv; }
    }
    __syncthreads();
    const size_t row = (size_t)b * SEQ + k * 64;
#pragma unroll
    for (int i = 0; i < 8; ++i) { const int idx = tid + 512 * i; *(u32x4*)(YM + (row + (idx >> 6)) * D + (idx & 63) * 8) = *(const LAS u32x4*)(lds + GR_OFF + (idx >> 6) * 1024 + (idx & 63) * 16); }
}

__device__ __forceinline__ void attn_prompt_unit(CParams& p, int l, int b, int h, int qb, LAS unsigned char* lds) {
    const int tid = otid(), lane = tid & 63, wave = tid >> 6, r32 = lane & 31, half = lane >> 5;
    const bf16* QB = (const bf16*)(p.ws + WS_QB); bf16* OB = (bf16*)(p.ws + WS_YM);
    const bf16* KB = (const bf16*)(p.ws + WS_KB) + (size_t)l * MROWS * D; const bf16* VT = (const bf16*)(p.ws + WS_VT) + (size_t)l * MROWS * D;
#pragma unroll 8
    for (int i = 0; i < 16; ++i) { const int idx = tid + 512 * i, key = idx >> 5, ch = idx & 31;
        const u32x4 v = *(const u32x4*)(KB + (size_t)(b * NMEM + key) * D + h * HD + ch * 8);
        *(LAS u32x4*)(lds + key * 512 + ((ch ^ (key & 31)) << 4)) = v; }
    const size_t qrow = (size_t)b * SEQ + qb * 256 + wave * 32 + r32;
    const bf16* qp = QB + qrow * D + h * HD + 8 * half;
    bf16x8 qf[8];
#pragma unroll
    for (int ks = 0; ks < 8; ++ks) qf[ks] = *(const bf16x8*)(qp + ks * 16);
    __syncthreads();
    f32x16 acc[8];
#pragma unroll
    for (int kb = 0; kb < 8; ++kb)
#pragma unroll
        for (int j = 0; j < 16; ++j) acc[kb][j] = 0.f;
#pragma unroll
    for (int kh = 0; kh < 2; ++kh) {
#pragma unroll
        for (int k8 = 0; k8 < 8; ++k8) { const int ks = kh * 8 + k8;
#pragma unroll
            for (int kb = 0; kb < 8; ++kb) { const int key = 32 * kb + r32;
                const bf16x8 a = *(const LAS bf16x8*)(lds + key * 512 + (((2 * ks + half) ^ r32) << 4));
                acc[kb] = __builtin_amdgcn_mfma_f32_32x32x16_bf16(a, qf[k8], acc[kb], 0, 0, 0); }
            if (kh == 0) qf[k8] = *(const bf16x8*)(qp + (8 + k8) * 16); }
    }
    float mx = -3.0e38f;
#pragma unroll
    for (int kb = 0; kb < 8; ++kb)
#pragma unroll
        for (int j = 0; j < 16; ++j) mx = fmaxf(mx, acc[kb][j]);
    mx = fmaxf(mx, __shfl_xor(mx, 32));
    float sum = 0.f;
#pragma unroll
    for (int kb = 0; kb < 8; ++kb)
#pragma unroll
        for (int j = 0; j < 16; ++j) { const float e = __builtin_amdgcn_exp2f(acc[kb][j] - mx); acc[kb][j] = e; sum += e; }
    sum += __shfl_xor(sum, 32);
    const float inv = 1.0f / sum;
    bf16x8 pf[8][2];
#pragma unroll
    for (int kb = 0; kb < 8; ++kb)
#pragma unroll
        for (int jj = 0; jj < 2; ++jj) { u32x4 w; w.x = pk2(acc[kb][8 * jj + 0], acc[kb][8 * jj + 1]); w.y = pk2(acc[kb][8 * jj + 2], acc[kb][8 * jj + 3]);
            w.z = pk2(acc[kb][8 * jj + 4], acc[kb][8 * jj + 5]); w.w = pk2(acc[kb][8 * jj + 6], acc[kb][8 * jj + 7]); pf[kb][jj] = __builtin_bit_cast(bf16x8, w); }
    __syncthreads();
#pragma unroll 8
    for (int i = 0; i < 16; ++i) { const int idx = tid + 512 * i, d = idx >> 5, ch = idx & 31;
        const u32x4 v = *(const u32x4*)(VT + ((size_t)((b * NH + h) * HD + d)) * NMEM + ch * 8);
        const int c8 = 2 * ch; u32x2 lo; lo.x = v.x; lo.y = v.y; u32x2 hi; hi.x = v.z; hi.y = v.w;
        *(LAS u32x2*)(lds + d * 512 + ((c8 ^ (d & 63)) << 3)) = lo; *(LAS u32x2*)(lds + d * 512 + (((c8 + 1) ^ (d & 63)) << 3)) = hi; }
    __syncthreads();
#pragma unroll
    for (int db = 0; db < 8; ++db) {
        f32x16 o;
#pragma unroll
        for (int j = 0; j < 16; ++j) o[j] = 0.f;
        const int dim = 32 * db + r32;
#pragma unroll
        for (int kb = 0; kb < 8; ++kb)
#pragma unroll
            for (int jj = 0; jj < 2; ++jj) { const int c8 = 8 * kb + 4 * jj + half;
                const u32x2 lo = *(const LAS u32x2*)(lds + dim * 512 + ((c8 ^ (dim & 63)) << 3)), hi = *(const LAS u32x2*)(lds + dim * 512 + (((c8 + 2) ^ (dim & 63)) << 3));
                u32x4 w; w.x = lo.x; w.y = lo.y; w.z = hi.x; w.w = hi.y;
                o = __builtin_amdgcn_mfma_f32_32x32x16_bf16(__builtin_bit_cast(bf16x8, w), pf[kb][jj], o, 0, 0, 0); }
#pragma unroll
        for (int g = 0; g < 4; ++g) { u32x2 w; w.x = pk2(o[4 * g] * inv, o[4 * g + 1] * inv); w.y = pk2(o[4 * g + 2] * inv, o[4 * g + 3] * inv);
            *(u32x2*)(OB + qrow * D + h * HD + 32 * db + 8 * g + 4 * half) = w; }
    }
    __syncthreads();
}

__device__ __forceinline__ void attn_sample_unit(CParams& p, int l, int sb, int h, LAS unsigned char* lds) {
    const int tid = otid(), lane = tid & 63, wave = tid >> 6;
    const bf16* QB = (const bf16*)(p.ws + WS_QB); bf16* OB = (bf16*)(p.ws + WS_YM);
    const float* CK = p.in[I_CK] + ((size_t)(l * SB + sb) * NMEM) * D + h * HD; const float* CV = p.in[I_CV] + ((size_t)(l * SB + sb) * NMEM) * D + h * HD;
    LAS f32x4* sc = (LAS f32x4*)lds;
    LAS float* red = (LAS float*)(lds + 8192);
    const size_t row0 = (size_t)TP + sb * SS;
    {
        const int ksub = lane >> 4, dseg = lane & 15;
        f32x4 q[4][4];
#pragma unroll
        for (int t = 0; t < 4; ++t)
#pragma unroll
            for (int jj = 0; jj < 4; ++jj) { const u32x2 w = *(const u32x2*)(QB + (row0 + t) * D + h * HD + jj * 64 + dseg * 4);
                q[t][jj] = (f32x4){bflo(w.x), bfhi(w.x), bflo(w.y), bfhi(w.y)}; }
#pragma unroll 4
        for (int it = 0; it < 8; ++it) { const int key = wave * 32 + it * 4 + ksub;
            f32x4 kv[4];
#pragma unroll
            for (int jj = 0; jj < 4; ++jj) kv[jj] = *(const f32x4*)(CK + (size_t)key * D + jj * 64 + dseg * 4);
            float s[4];
#pragma unroll
            for (int t = 0; t < 4; ++t) { float a = 0.f;
#pragma unroll
                for (int jj = 0; jj < 4; ++jj) a += (kv[jj].x * q[t][jj].x + kv[jj].y * q[t][jj].y) + (kv[jj].z * q[t][jj].z + kv[jj].w * q[t][jj].w);
                a += __shfl_xor(a, 1); a += __shfl_xor(a, 2); a += __shfl_xor(a, 4); a += __shfl_xor(a, 8); s[t] = a; }
            if (dseg == 0) sc[key] = (f32x4){s[0], s[1], s[2], s[3]}; }
    }
    __syncthreads();
    if (wave < 4) { const int t = wave; float v[4]; float mx = -3.0e38f;
#pragma unroll
        for (int j = 0; j < 4; ++j) { v[j] = ((const LAS float*)lds)[(lane * 4 + j) * 4 + t]; mx = fmaxf(mx, v[j]); }
#pragma unroll
        for (int o = 1; o < 64; o <<= 1) mx = fmaxf(mx, __shfl_xor(mx, o));
        float sum = 0.f;
#pragma unroll
        for (int j = 0; j < 4; ++j) { v[j] = __builtin_amdgcn_exp2f(v[j] - mx); sum += v[j]; }
        sum = wave_sum(sum); const float inv = 1.0f / sum;
#pragma unroll
        for (int j = 0; j < 4; ++j) ((LAS float*)lds)[(lane * 4 + j) * 4 + t] = v[j] * inv; }
    __syncthreads();
    {
        f32x4 o[4];
#pragma unroll
        for (int t = 0; t < 4; ++t) o[t] = (f32x4){0.f, 0.f, 0.f, 0.f};
#pragma unroll 16
        for (int m = 0; m < 32; ++m) { const int key = wave * 32 + m; const f32x4 v = *(const f32x4*)(CV + (size_t)key * D + lane * 4); const f32x4 pr = sc[key];
            o[0] += v * pr.x; o[1] += v * pr.y; o[2] += v * pr.z; o[3] += v * pr.w; }
#pragma unroll
        for (int t = 0; t < 4; ++t) *(LAS f32x4*)(red + (wave * 4 + t) * 256 + lane * 4) = o[t];
    }
    __syncthreads();
    { const int t = tid >> 7, d2 = tid & 127; float a0 = 0.f, a1 = 0.f;
#pragma unroll
        for (int w = 0; w < 8; ++w) { const f32x2 v = *(const LAS f32x2*)(red + (w * 4 + t) * 256 + d2 * 2); a0 += v.x; a1 += v.y; }
        *(unsigned*)(OB + (row0 + t) * D + h * HD + d2 * 2) = pk2(a0, a1); }
    __syncthreads();
}

struct TailScale {
    bf16* O; int ldc; const float* ssq; float scale;
    __device__ __forceinline__ void operator()(int row, int col, f32x4 v, int) const { const int gr = TP + row; const float r = rsqrtf(ssq[gr] * (1.0f / 1024.0f) + EPS) * scale;
        u32x2 w; w.x = pk2(v.x * r, v.y * r); w.y = pk2(v.z * r, v.w * r); *(u32x2*)(O + (size_t)gr * ldc + col) = w; }
};
struct TailRes {
    float* X; bf16* XB; float* ssq_out;
    __device__ __forceinline__ void operator()(int row, int col, f32x4 v, int c4) const { const size_t off = (size_t)(TP + row) * D + col;
        const f32x4 xn = *(const f32x4*)(X + off) + v; *(f32x4*)(X + off) = xn;
        u32x2 w; w.x = pk2(xn.x, xn.y); w.y = pk2(xn.z, xn.w); *(u32x2*)(XB + off) = w;
        float s = (xn.x * xn.x + xn.y * xn.y) + (xn.z * xn.z + xn.w * xn.w);
        s += __shfl_xor(s, 1); s += __shfl_xor(s, 2); s += __shfl_xor(s, 4);
        if (c4 == 0) atomicAdd(ssq_out + TP + row, s); }
};
template <int CT, class Epi>
__device__ __forceinline__ void tail_gemm(const bf16* A, const bf16* Bt, int K, int N, LAS unsigned char* lds, const Epi& E) {
    const int tid = otid(), lane = tid & 63, wave = tid >> 6, fr = lane & 15, fq = lane >> 4;
    constexpr int NC = 16 * CT; const int npc = N / NC;
    LAS float* red = (LAS float*)lds;
    for (int pc = blockIdx.x; pc < 8 * npc; pc += gridDim.x) {
        const int row0 = (pc / npc) * 64, col0 = (pc % npc) * NC; const int ksl = K / 8, nks = ksl / 32;
        f32x4 acc[4][CT];
#pragma unroll
        for (int rt = 0; rt < 4; ++rt)
#pragma unroll
            for (int ct = 0; ct < CT; ++ct) acc[rt][ct] = (f32x4){0.f, 0.f, 0.f, 0.f};
        const bf16* ap = A + (size_t)(row0 + fr) * K + wave * ksl + 8 * fq; const bf16* bp = Bt + (size_t)(col0 + fr) * K + wave * ksl + 8 * fq;
#pragma unroll 4
        for (int ks = 0; ks < nks; ++ks) { bf16x8 af[4], bfr[CT];
#pragma unroll
            for (int rt = 0; rt < 4; ++rt) af[rt] = *(const bf16x8*)(ap + (size_t)rt * 16 * K + ks * 32);
#pragma unroll
            for (int ct = 0; ct < CT; ++ct) bfr[ct] = *(const bf16x8*)(bp + (size_t)ct * 16 * K + ks * 32);
#pragma unroll
            for (int rt = 0; rt < 4; ++rt)
#pragma unroll
                for (int ct = 0; ct < CT; ++ct) acc[rt][ct] = __builtin_amdgcn_mfma_f32_16x16x32_bf16(bfr[ct], af[rt], acc[rt][ct], 0, 0, 0); }
#pragma unroll
        for (int rt = 0; rt < 4; ++rt)
#pragma unroll
            for (int ct = 0; ct < CT; ++ct) *(LAS f32x4*)(red + (size_t)((wave * 64 + 16 * rt + fr) * NC + 16 * ct + 4 * fq)) = acc[rt][ct];
        __syncthreads();
#pragma unroll
        for (int it0 = 0; it0 < 64 * NC / 4; it0 += NTHREADS) { const int it = it0 + tid, r = it / (NC / 4), c4 = it % (NC / 4); f32x4 s = (f32x4){0.f, 0.f, 0.f, 0.f};
#pragma unroll
            for (int w = 0; w < 8; ++w) s += *(const LAS f32x4*)(red + (size_t)((w * 64 + r) * NC + c4 * 4));
            E(row0 + r, col0 + c4 * 4, s, c4 & 7); }
        __syncthreads();
    }
}

constexpr int N_PHASES = 18;
__device__ __forceinline__ void phase_body(const int ph, CParams* p0, LAS unsigned char* lds, const XcdBarrier& bar) {
        CParams* pq = p0; asm volatile("" : "+s"(pq));
        CParams& p = *pq;
        unsigned char* ws = p.ws;
        float* X = (float*)(ws + WS_X); bf16* XB = (bf16*)(ws + WS_XB); bf16* U = (bf16*)(ws + WS_U); bf16* YM = (bf16*)(ws + WS_YM); bf16* QB = (bf16*)(ws + WS_QB); bf16* HB = (bf16*)(ws + WS_H);
        float* SSQ = (float*)(ws + WS_SSQ); const int bx = blockIdx.x;
        if (ph == 0) { prologue(p, lds); return; }
        if (ph == N_PHASES - 1) {
            const int tdx = otid(), lane = tdx & 63, wave = tdx >> 6; const float* g = p.in[I_GFIN];
            for (int m = bx * NWAVES + wave; m < T; m += GRID * NWAVES) { const float rs = rsqrtf(SSQ[6 * T + m] * (1.0f / 1024.0f) + EPS);
                const f32x4* xr = (const f32x4*)(X + (size_t)m * D) + lane; f32x4* yo = (f32x4*)(p.out + (size_t)m * D) + lane; const f32x4* gp = (const f32x4*)g + lane;
#pragma unroll
                for (int j = 0; j < 4; ++j) yo[64 * j] = xr[64 * j] * rs * gp[64 * j]; }
            return;
        }
        const int l = (ph - 1) >> 3, sub = (ph - 1) & 7;
        unsigned char* wl = ws + WS_W + (size_t)l * W_LAYER;
        if (sub == 0) {
            { pg8::Gemm g{XB, (const bf16*)(wl + WO_IN), TP, DIN, D}; pg8::StaticOrder S; S.init(TP, DIN, GRID, bx);
              pg8::EpiScaleBf16 E{U, DIN, SSQ + (size_t)(3 * l) * T, 1.0f, 0};
              pg8::gemm_phase<pg8::EpiScaleBf16, pg8::StaticOrder, true, true>(lds, g, S, E); }
            if (l == 0) { pg8::Gemm g{(const bf16*)(ws + WS_MEMB), (const bf16*)(ws + WS_W + WO_KV), MROWS, 2048, D};
                pg8::StaticOrder S; S.init(MROWS, 2048, GRID, bx);
                pg8::EpiKV E{p.out + O_PMK, p.out + O_PMV, (bf16*)(ws + WS_KB), (bf16*)(ws + WS_VT), (const float*)(ws + WS_SSQM)};
                pg8::gemm_phase<pg8::EpiKV, pg8::StaticOrder, true, true>(lds, g, S, E); }
            { TailScale E{U, DIN, SSQ + (size_t)(3 * l) * T, 1.0f}; tail_gemm<4, TailScale>(XB + (size_t)TP * D, (const bf16*)(wl + WO_IN), D, DIN, lds, E); }
        } else if (sub == 1) {
            const int b = bx >> 5, k = bx & 31;
            conf_prompt_item(p, l, b, 2 * k, lds); conf_prompt_item(p, l, b, 2 * k + 1, lds);
            if (bx < SB) sample_mixer_item(p, l, bx, lds);
            RgState S; rglru_part1(p, l, b, k, lds, S);
            xcd_barrier(bar);
            rglru_part2(p, l, b, k, lds, S);
        } else if (sub == 2) {
            pg8::Gemm g{YM, (const bf16*)(wl + WO_OUT), TP, D, D}; pg8::StaticOrder S; S.init(TP, D, GRID, bx);
            pg8::EpiRes E{X, XB, SSQ + (size_t)(3 * l + 1) * T};
            pg8::gemm_phase<pg8::EpiRes, pg8::StaticOrder, true, true>(lds, g, S, E);
            TailRes ET{X, XB, SSQ + (size_t)(3 * l + 1) * T}; tail_gemm<2, TailRes>(YM + (size_t)TP * D, (const bf16*)(wl + WO_OUT), D, D, lds, ET);
        } else if (sub == 3) {
            pg8::Gemm g{XB, (const bf16*)(wl + WO_Q), TP, D, D}; pg8::StaticOrder S; S.init(TP, D, GRID, bx);
            pg8::EpiScaleBf16 E{QB, D, SSQ + (size_t)(3 * l + 1) * T, QSCALE, 0};
            pg8::gemm_phase<pg8::EpiScaleBf16, pg8::StaticOrder, true, true>(lds, g, S, E);
            TailScale ET{QB, D, SSQ + (size_t)(3 * l + 1) * T, QSCALE}; tail_gemm<2, TailScale>(XB + (size_t)TP * D, (const bf16*)(wl + WO_Q), D, D, lds, ET);
        } else if (sub == 4) {
            for (int u = bx; u < NB * NH * 8; u += GRID) attn_prompt_unit(p, l, u >> 5, (u >> 3) & 3, u & 7, lds);
            for (int u = bx; u < SB * NH; u += GRID) attn_sample_unit(p, l, u >> 2, u & 3, lds);
        } else if (sub == 5) {
            pg8::Gemm g{YM, (const bf16*)(wl + WO_O), TP, D, D}; pg8::StaticOrder S; S.init(TP, D, GRID, bx);
            pg8::EpiRes E{X, XB, SSQ + (size_t)(3 * l + 2) * T};
            pg8::gemm_phase<pg8::EpiRes, pg8::StaticOrder, true, true>(lds, g, S, E);
            TailRes ET{X, XB, SSQ + (size_t)(3 * l + 2) * T}; tail_gemm<2, TailRes>(YM + (size_t)TP * D, (const bf16*)(wl + WO_O), D, D, lds, ET);
        } else if (sub == 6) {
            { pg8::Gemm g{XB, (const bf16*)(wl + WO_GU), TP, 2 * DFF, D}; pg8::StaticOrder S; S.init(TP, 2 * DFF, GRID, bx);
              pg8::EpiGateUp E{HB, DFF, SSQ + (size_t)(3 * l + 2) * T, 0};
              pg8::gemm_phase<pg8::EpiGateUp, pg8::StaticOrder, true, true>(lds, g, S, E); }
            { pg8::Gemm g{XB + (size_t)TP * D, (const bf16*)(wl + WO_GU), TS, 2 * DFF, D}; pg8::StaticOrder S; S.init(TS, 2 * DFF, GRID, (bx + 128) & 255);
              pg8::EpiGateUp E{HB, DFF, SSQ + (size_t)(3 * l + 2) * T, TP};
              pg8::gemm_phase<pg8::EpiGateUp, pg8::StaticOrder, true, true>(lds, g, S, E); }
            if (l == 0) { pg8::Gemm g{(const bf16*)(ws + WS_MEMB), (const bf16*)(ws + WS_W + W_LAYER + WO_KV), MROWS, 2048, D};
                pg8::StaticOrder S; S.init(MROWS, 2048, GRID, (bx + 256 - 172) & 255);
                pg8::EpiKV E{p.out + O_PMK + (size_t)MROWS * D, p.out + O_PMV + (size_t)MROWS * D, (bf16*)(ws + WS_KB) + (size_t)MROWS * D, (bf16*)(ws + WS_VT) + (size_t)MROWS * D, (const float*)(ws + WS_SSQM)};
                pg8::gemm_phase<pg8::EpiKV, pg8::StaticOrder, true, true>(lds, g, S, E); }
        } else {
            pg8::Gemm g{HB, (const bf16*)(wl + WO_D), TP, D, DFF}; pg8::StaticOrder S; S.init(TP, D, GRID, bx);
            pg8::EpiRes E{X, XB, SSQ + (size_t)(3 * l + 3) * T};
            pg8::gemm_phase<pg8::EpiRes, pg8::StaticOrder, true, true>(lds, g, S, E);
            TailRes ET{X, XB, SSQ + (size_t)(3 * l + 3) * T}; tail_gemm<2, TailRes>(HB + (size_t)TP * DFF, (const bf16*)(wl + WO_D), DFF, D, lds, ET);
        }
}
__global__ void __launch_bounds__(NTHREADS, 2) hymba_fwd(Params p_formal) {
    extern __shared__ __attribute__((aligned(16))) unsigned char lds_raw[];
    LAS unsigned char* lds = (LAS unsigned char*)lds_raw;
    cg::grid_group grid = cg::this_grid();
    if (gridDim.x != GRID) return;
    CParams* p0 = (CParams*)__builtin_amdgcn_kernarg_segment_ptr();
    const int ph_lo = p0->ph_lo, ph_hi = p0->ph_hi;
    if (ph_lo < 0) grid.sync();
    if (threadIdx.x < 2) ((volatile LAS unsigned*)(lds + LDS_BARW))[threadIdx.x] = 0u;
    __syncthreads();
    const XcdBarrier bar = xcd_barrier_post((unsigned*)(p0->ws + WS_BAR), (volatile LAS unsigned*)(lds + LDS_BARW));
#ifndef EXP_SYNC
#define EXP_SYNC 0
#endif
#define RUN(PH) if (ph_lo <= (PH) && (PH) < ph_hi) { if ((PH) > ph_lo) { xcd_barrier(bar); if (EXP_SYNC) { xcd_barrier(bar); xcd_barrier(bar); } } phase_body((PH), p0, lds, bar); }
#define RUN2(PH) RUN(PH) if (ph_lo <= (PH) && (PH) < ph_hi) { xcd_barrier(bar); phase_body((PH), p0, lds, bar); }
#ifndef EXP_PRO
#define EXP_PRO 0
#endif
#ifndef EXP_MIX
#define EXP_MIX 0
#endif
#ifndef EXP_ATT
#define EXP_ATT 0
#endif
#ifndef EXP_Q
#define EXP_Q 0
#endif
#ifndef EXP_GU
#define EXP_GU 0
#endif
#ifndef EXP_IN
#define EXP_IN 0
#endif
#if EXP_PRO
    RUN2(0)
#else
    RUN(0)
#endif
#if EXP_IN
    RUN2(1)
#else
    RUN(1)
#endif
#if EXP_MIX
    RUN2(2)
#else
    RUN(2)
#endif
    RUN(3)
#if EXP_Q
    RUN2(4)
#else
    RUN(4)
#endif
#if EXP_ATT
    RUN2(5)
#else
    RUN(5)
#endif
    RUN(6)
#if EXP_GU
    RUN2(7)
#else
    RUN(7)
#endif
    RUN(8)
#if EXP_IN
    RUN2(9)
#else
    RUN(9)
#endif
#if EXP_MIX
    RUN2(10)
#else
    RUN(10)
#endif
    RUN(11)
#if EXP_Q
    RUN2(12)
#else
    RUN(12)
#endif
#if EXP_ATT
    RUN2(13)
#else
    RUN(13)
#endif
    RUN(14)
#if EXP_GU
    RUN2(15)
#else
    RUN(15)
#endif
    RUN(16)
#if EXP_PRO
    RUN2(17)
#else
    RUN(17)
#endif
#undef RUN2
#undef RUN
}

#ifndef N_LAUNCH_SPLIT
#define N_LAUNCH_SPLIT 0
#endif
extern "C" void kernel_launch(void* const* d_in, const int* in_sizes, int n_in, void* d_out, int out_size, void* d_ws, size_t ws_size, hipStream_t stream) {
    static int ready = 0;
    if (ready == 0) {
        if (n_in != N_IN || (size_t)out_size != O_END || ws_size < WS_END) { fprintf(stderr, "kernel_launch: unexpected shapes: n_in %d out %d ws %zu\n", n_in, out_size, ws_size); ready = -1; return; }
        if (hipFuncSetAttribute((const void*)hymba_fwd, hipFuncAttributeMaxDynamicSharedMemorySize, LDS_BYTES) != hipSuccess) { fprintf(stderr, "kernel_launch: hipFuncSetAttribute failed\n"); ready = -1; return; }
        int dev = 0, cus = 0, per_cu = 0;
        hipGetDevice(&dev); hipDeviceGetAttribute(&cus, hipDeviceAttributeMultiprocessorCount, dev);
        hipOccupancyMaxActiveBlocksPerMultiprocessor(&per_cu, (const void*)hymba_fwd, NTHREADS, LDS_BYTES);
        if (cus * per_cu < GRID) { fprintf(stderr, "kernel_launch: device holds %d x %d workgroups, need %d resident\n", cus, per_cu, GRID); ready = -1; return; }
        ready = 1;
    }
    if (ready < 0) return;
    if (hipMemsetAsync((unsigned char*)d_ws + WS_BAR, 0, BAR_BYTES, stream) != hipSuccess) { fprintf(stderr, "kernel_launch: memset of the barrier words failed\n"); return; }
    Params p{};
    for (int i = 0; i < N_IN; ++i) p.in[i] = (const float*)d_in[i];
    p.out = (float*)d_out; p.ws = (unsigned char*)d_ws;
#if N_LAUNCH_SPLIT
    for (int ph = 0; ph < N_PHASES; ++ph) { p.ph_lo = ph; p.ph_hi = ph + 1; void* args[] = {&p};
        hipError_t e = hipLaunchCooperativeKernel((const void*)hymba_fwd, dim3(GRID), dim3(NTHREADS), args, LDS_BYTES, stream);
        if (e != hipSuccess) { fprintf(stderr, "cooperative launch failed: %s\n", hipGetErrorString(e)); return; } }
#else
    p.ph_lo = 0; p.ph_hi = N_PHASES; void* args[] = {&p};
    hipError_t e = hipLaunchCooperativeKernel((const void*)hymba_fwd, dim3(GRID), dim3(NTHREADS), args, LDS_BYTES, stream);
    if (e != hipSuccess) fprintf(stderr, "cooperative launch failed: %s\n", hipGetErrorString(e));
#endif
}
```

```cpp
#include <hip/hip_runtime.h>
#include <hip/hip_cooperative_groups.h>
#include <cstdio>
#include <cstdint>
namespace cg = cooperative_groups;

namespace pg8 {
#define PG8_LAS __attribute__((address_space(3)))
typedef unsigned short bf16_t;
typedef short bf16x8 __attribute__((ext_vector_type(8)));
typedef float f32x4 __attribute__((ext_vector_type(4)));
typedef unsigned u32x4 __attribute__((ext_vector_type(4)));
constexpr int BM = 256, BK = 64, HALF = 128, HTB = HALF * BK * 2  , STAGE_BYTES = 8 * HTB, NXCD = 8, WGM = 8;

__host__ __device__ __forceinline__ int lds_byte(int r, int c) { const int st = (r >> 4) * 2 + (c >> 5), rr = r & 15, cc = c & 31, ob = rr * 64 + cc * 2; return st * 1024 + (ob ^ (((ob >> 9) & 1) << 5)); }
__host__ __device__ __forceinline__ void stage_rc(int b, int& R, int& C) { const int st = b / 1024, sb = b % 1024, swz = sb ^ (((sb >> 9) & 1) << 5); R = (st >> 1) * 16 + swz / 64; C = (st & 1) * 32 + (swz % 64) / 2; }
__host__ __device__ __forceinline__ int perm32(int rho) { const int n = rho >> 4, i = rho & 15; return 8 * (i >> 2) + 4 * n + (i & 3); }

struct Unit { int pm, pn; };
struct Gemm { const bf16_t* A; const bf16_t* Bt; int M, N, K; };

struct StaticOrder {
    int nM, nN, nwg, G, c;
    __host__ __device__ void init(int M, int N, int G_, int c_) { nM = M / BM; nN = N / BM; nwg = nM * nN; G = G_; c = c_; }
    __host__ __device__ bool next(int i, Unit& u) const {
        const long L = (long)i * G + c; if (L >= nwg) return false;
        int wgid = (int)L; { const int q = nwg / NXCD, r = nwg % NXCD, xcd = wgid % NXCD, off = wgid / NXCD; wgid = (xcd < r ? xcd * (q + 1) : r * (q + 1) + (xcd - r) * q) + off; }
        const int nig = WGM * nN, gid = wgid / nig, fm = gid * WGM, gsz = (nM - fm) < WGM ? (nM - fm) : WGM;
        u.pm = fm + ((wgid % nig) % gsz); u.pn = (wgid % nig) / gsz; return true;
    }
    __device__ __forceinline__ void a_ready(const Unit&) const {}
    __device__ __forceinline__ void done(const Unit&) const {}
};

__device__ __forceinline__ unsigned cvt_pk_bf16(float lo, float hi) { unsigned r; asm volatile("v_cvt_pk_bf16_f32 %0, %1, %2" : "=v"(r) : "v"(lo), "v"(hi)); return r; }
typedef unsigned u32x2 __attribute__((ext_vector_type(2)));
constexpr float RMS_EPS = 1e-6f;

struct EpiScaleBf16 {
    static constexpr bool PERM = true, AFTER_DRAIN = false; static constexpr bool INIT_ACC = false; struct Init {};
    bf16_t* O; int ldc; const float* ssq; float scale; int row_off;
    __device__ __forceinline__ void operator()(const f32x4 (&acc)[2][2][4][2], const Unit& u, int wr, int wc, int fr, int fq) const {
        const int row0 = row_off + u.pm * BM + wr * 64 + fr, col0 = u.pn * BM + wc * 32 + 8 * fq;
#pragma unroll
        for (int ai = 0; ai < 2; ++ai)
#pragma unroll
            for (int m = 0; m < 4; ++m) { const int row = row0 + ai * HALF + m * 16; const float r = rsqrtf(ssq[row] * (1.0f / 1024.0f) + RMS_EPS) * scale;
                bf16_t* rowp = O + (size_t)row * ldc + col0;
#pragma unroll
                for (int bj = 0; bj < 2; ++bj) { const f32x4 v0 = acc[ai][bj][m][0] * r, v1 = acc[ai][bj][m][1] * r;
                    u32x4 w; w.x = cvt_pk_bf16(v0[0], v0[1]); w.y = cvt_pk_bf16(v0[2], v0[3]); w.z = cvt_pk_bf16(v1[0], v1[1]); w.w = cvt_pk_bf16(v1[2], v1[3]);
                    *(u32x4*)(rowp + bj * HALF) = w; } }
    }
};
struct EpiGateUp {
    static constexpr bool PERM = true, AFTER_DRAIN = false; static constexpr bool INIT_ACC = false; struct Init {};
    bf16_t* O; int ldc; const float* ssq; int row_off;
    __device__ __forceinline__ void operator()(const f32x4 (&acc)[2][2][4][2], const Unit& u, int wr, int wc, int fr, int fq) const {
        const int row0 = row_off + u.pm * BM + wr * 64 + fr, col0 = u.pn * HALF + wc * 32 + 8 * fq;
#pragma unroll
        for (int ai = 0; ai < 2; ++ai)
#pragma unroll
            for (int m = 0; m < 4; ++m) { const int row = row0 + ai * HALF + m * 16; const float r = rsqrtf(ssq[row] * (1.0f / 1024.0f) + RMS_EPS);
                float o[8];
#pragma unroll
                for (int n = 0; n < 2; ++n)
#pragma unroll
                    for (int j = 0; j < 4; ++j) { const float g = acc[ai][0][m][n][j] * r, up = acc[ai][1][m][n][j] * r;
                        o[n * 4 + j] = g * __builtin_amdgcn_rcpf(1.0f + __expf(-g)) * up; }
                u32x4 w; w.x = cvt_pk_bf16(o[0], o[1]); w.y = cvt_pk_bf16(o[2], o[3]); w.z = cvt_pk_bf16(o[4], o[5]); w.w = cvt_pk_bf16(o[6], o[7]);
                *(u32x4*)(O + (size_t)row * ldc + col0) = w; }
    }
};
struct EpiRes {
    static constexpr bool PERM = true, AFTER_DRAIN = false, INIT_ACC = true;
    bf16_t* XB; float* ssq_out;
    struct Init { u32x4 xo[2][4][2]; };
    __device__ __forceinline__ void load_init(Init& I, const Unit& u, int wr, int wc, int fr, int fq) const {
        const int row0 = u.pm * BM + wr * 64 + fr, col0 = u.pn * BM + wc * 32 + 8 * fq;
#pragma unroll
        for (int ai = 0; ai < 2; ++ai)
#pragma unroll
            for (int m = 0; m < 4; ++m)
#pragma unroll
                for (int bj = 0; bj < 2; ++bj) I.xo[ai][m][bj] = *(const u32x4*)(XB + (size_t)(row0 + ai * HALF + m * 16) * 1024 + col0 + bj * HALF);
    }
    __device__ __forceinline__ void apply_init(f32x4 (&acc)[2][2][4][2], const Init& I) const {
#pragma unroll
        for (int ai = 0; ai < 2; ++ai)
#pragma unroll
            for (int m = 0; m < 4; ++m)
#pragma unroll
                for (int bj = 0; bj < 2; ++bj) { const u32x4 x = I.xo[ai][m][bj];
                    acc[ai][bj][m][0] = (f32x4){__builtin_bit_cast(float, x.x << 16), __builtin_bit_cast(float, x.x & 0xffff0000u), __builtin_bit_cast(float, x.y << 16), __builtin_bit_cast(float, x.y & 0xffff0000u)};
                    acc[ai][bj][m][1] = (f32x4){__builtin_bit_cast(float, x.z << 16), __builtin_bit_cast(float, x.z & 0xffff0000u), __builtin_bit_cast(float, x.w << 16), __builtin_bit_cast(float, x.w & 0xffff0000u)}; }
    }
    __device__ __forceinline__ void operator()(const f32x4 (&acc)[2][2][4][2], const Unit& u, int wr, int wc, int fr, int fq) const {
        const int row0 = u.pm * BM + wr * 64 + fr, col0 = u.pn * BM + wc * 32 + 8 * fq;
#pragma unroll
        for (int ai = 0; ai < 2; ++ai)
#pragma unroll
            for (int m = 0; m < 4; ++m) { const int row = row0 + ai * HALF + m * 16; bf16_t* rowp = XB + (size_t)row * 1024 + col0; float s = 0.f;
#pragma unroll
                for (int bj = 0; bj < 2; ++bj) { const f32x4 v0 = acc[ai][bj][m][0], v1 = acc[ai][bj][m][1];
                    u32x4 w; w.x = cvt_pk_bf16(v0[0], v0[1]); w.y = cvt_pk_bf16(v0[2], v0[3]); w.z = cvt_pk_bf16(v1[0], v1[1]); w.w = cvt_pk_bf16(v1[2], v1[3]);
                    *(u32x4*)(rowp + bj * HALF) = w;
                    s += (v0[0] * v0[0] + v0[1] * v0[1]) + (v0[2] * v0[2] + v0[3] * v0[3]) + (v1[0] * v1[0] + v1[1] * v1[1]) + (v1[2] * v1[2] + v1[3] * v1[3]); }
                s += __shfl_xor(s, 16); s += __shfl_xor(s, 32);
                if (fq == 0) atomicAdd(ssq_out + row, s); }
    }
};
struct EpiKV {
    static constexpr bool PERM = false, AFTER_DRAIN = false; static constexpr bool INIT_ACC = false; struct Init {};
    float* outK; float* outV; bf16_t* KB; bf16_t* VT; const float* ssq;
    __device__ __forceinline__ void operator()(const f32x4 (&acc)[2][2][4][2], const Unit& u, int wr, int wc, int fr, int fq) const {
        const int row0 = u.pm * BM + wr * 64 + fr; const bool isV = u.pn >= 4; const int col0 = (u.pn & 3) * BM + wc * 32 + 4 * fq;
        float* outp = isV ? outV : outK;
#pragma unroll
        for (int ai = 0; ai < 2; ++ai)
#pragma unroll
            for (int m = 0; m < 4; ++m) { const int row = row0 + ai * HALF + m * 16; const float r = rsqrtf(ssq[row] * (1.0f / 1024.0f) + RMS_EPS);
#pragma unroll
                for (int bj = 0; bj < 2; ++bj)
#pragma unroll
                    for (int n = 0; n < 2; ++n) { const int c = col0 + bj * HALF + n * 16; const f32x4 v = acc[ai][bj][m][n] * r;
                        __builtin_nontemporal_store(v, (f32x4*)(outp + (size_t)row * 1024 + c));
                        if (!isV) { u32x2 w; w.x = cvt_pk_bf16(v[0], v[1]); w.y = cvt_pk_bf16(v[2], v[3]); *(u32x2*)(KB + (size_t)row * 1024 + c) = w; }
                        else { const int b = row >> 8, mm = row & 255, h = c >> 8, d = c & 255; bf16_t* vp = VT + ((size_t)((b * 4 + h) * 256 + d)) * 256 + mm;
                            const unsigned w0 = cvt_pk_bf16(v[0], v[1]), w1 = cvt_pk_bf16(v[2], v[3]);
                            vp[0] = (bf16_t)(w0 & 0xffffu); vp[256] = (bf16_t)(w0 >> 16); vp[512] = (bf16_t)(w1 & 0xffffu); vp[768] = (bf16_t)(w1 >> 16); } } }
    }
};

template <class Epi, class Sched, bool ALIGN_EPI = false, bool SP2 = false>
__device__ __forceinline__ void gemm_phase(PG8_LAS unsigned char* lds, const Gemm g, const Sched& S, const Epi& E) {
    int tid = threadIdx.x; asm volatile("" : "+v"(tid));
    const int wid = __builtin_amdgcn_readfirstlane(tid >> 6), lane = tid & 63, wr = wid >> 2, wc = wid & 3, fr = lane & 15, fq = lane >> 4;
    const int K = g.K, nt = K / BK;
    unsigned voffA[2], voffB[2];
#pragma unroll
    for (int i = 0; i < 2; ++i) { int R, C; stage_rc(tid * 16 + i * 8192, R, C); const int Rb = Epi::PERM ? ((R & ~31) + perm32(R & 31)) : R;
        voffA[i] = (unsigned)(R * K + C) * 2u; voffB[i] = (unsigned)(Rb * K + C) * 2u; }
    const size_t kstep = (size_t)(BK * 2);
    const size_t hstep = (size_t)HALF * K * 2;
    const size_t tstep = 2 * hstep;
    const unsigned ldsw = (unsigned)wid * 1024u;
    const int aoff = lds_byte(wr * 64 + fr, fq * 8), boff = lds_byte(wc * 32 + fr, fq * 8);
#define PG8_SA(b, h) (((b) * 2 + (h)) * HTB)
#define PG8_SB(b, h) ((4 + (b) * 2 + (h)) * HTB)
#define PG8_STAGE(bufoff, gbase, voff) do { _Pragma("unroll") for (int _i = 0; _i < 2; ++_i) \
        __builtin_amdgcn_global_load_lds((const unsigned*)((const char*)(gbase) + (voff)[_i]), (PG8_LAS unsigned*)(lds + (bufoff) + ldsw + _i * 8192), 16, 0, 0); } while (0)
#define PG8_LDA(dst, b, h) do { _Pragma("unroll") for (int m = 0; m < 4; ++m) _Pragma("unroll") for (int k = 0; k < 2; ++k) dst[m][k] = *(const PG8_LAS bf16x8*)(lds + PG8_SA(b, h) + aoff + m * 2048 + k * 1024); } while (0)
#define PG8_LDB(dst, b, h) do { _Pragma("unroll") for (int n = 0; n < 2; ++n) _Pragma("unroll") for (int k = 0; k < 2; ++k) dst[n][k] = *(const PG8_LAS bf16x8*)(lds + PG8_SB(b, h) + boff + n * 2048 + k * 1024); } while (0)
#define PG8_MMA(ai, bj, At, Bt) do { __builtin_amdgcn_s_setprio(1); _Pragma("unroll") for (int m = 0; m < 4; ++m) _Pragma("unroll") for (int n = 0; n < 2; ++n) _Pragma("unroll") for (int k = 0; k < 2; ++k) \
        acc[ai][bj][m][n] = __builtin_amdgcn_mfma_f32_16x16x32_bf16(Bt[n][k], At[m][k], acc[ai][bj][m][n], 0, 0, 0); __builtin_amdgcn_s_setprio(0); } while (0)
#define PG8_WAIT_V(n) asm volatile("s_waitcnt vmcnt(" #n ")" ::: "memory")
#define PG8_WAIT_L(n) asm volatile("s_waitcnt lgkmcnt(" #n ")" ::: "memory")
#define PG8_BAR __builtin_amdgcn_s_barrier()
#define PG8_SCHED __builtin_amdgcn_sched_barrier(0)
    Unit cur, nxt; int ui = 0;
    if (!S.next(0, cur)) return;
    f32x4 acc[2][2][4][2];
#pragma unroll
    for (int a = 0; a < 2; ++a)
#pragma unroll
        for (int b = 0; b < 2; ++b)
#pragma unroll
            for (int m = 0; m < 4; ++m)
#pragma unroll
                for (int n = 0; n < 2; ++n) acc[a][b][m][n] = (f32x4){0.f, 0.f, 0.f, 0.f};
    bf16x8 At[4][2], B0[2][2], B1[2][2];
    const char* cA = (const char*)g.A + (size_t)cur.pm * tstep; const char* cB = (const char*)g.Bt + (size_t)cur.pn * tstep;
    typename Epi::Init init_; if constexpr (Epi::INIT_ACC) E.load_init(init_, cur, wr, wc, fr, fq);
    S.a_ready(cur);
    if constexpr (SP2) {
        PG8_STAGE(PG8_SB(0, 0), cB, voffB); PG8_STAGE(PG8_SB(0, 1), cB + hstep, voffB); PG8_STAGE(PG8_SA(0, 0), cA, voffA); PG8_STAGE(PG8_SA(0, 1), cA + hstep, voffA);
        if (wr == 1) PG8_BAR;
        PG8_WAIT_V(2); PG8_BAR;
        PG8_STAGE(PG8_SB(1, 0), cB + kstep, voffB); PG8_STAGE(PG8_SA(1, 0), cA + kstep, voffA); PG8_STAGE(PG8_SB(1, 1), cB + hstep + kstep, voffB);
        PG8_WAIT_V(6); PG8_BAR;
    } else {
        PG8_STAGE(PG8_SB(0, 0), cB, voffB); PG8_STAGE(PG8_SA(0, 0), cA, voffA); PG8_STAGE(PG8_SB(0, 1), cB + hstep, voffB); PG8_STAGE(PG8_SA(0, 1), cA + hstep, voffA);
        if (wr == 1) PG8_BAR;
        PG8_WAIT_V(4); PG8_BAR;
        PG8_STAGE(PG8_SB(1, 0), cB + kstep, voffB); PG8_STAGE(PG8_SA(1, 0), cA + kstep, voffA); PG8_STAGE(PG8_SB(1, 1), cB + hstep + kstep, voffB);
        PG8_WAIT_V(6); PG8_BAR;
    }
    if constexpr (Epi::INIT_ACC) E.apply_init(acc, init_);
    for (;;) {
        const bool has_next = S.next(ui + 1, nxt);
        const char* nA = has_next ? (const char*)g.A + (size_t)nxt.pm * tstep : cA; const char* nB = has_next ? (const char*)g.Bt + (size_t)nxt.pn * tstep : cB;
        for (int t = 0; t < nt; t += 2) {
            const bool last = (t == nt - 2);
            const char* a1 = cA + (size_t)(t + 1) * kstep;
            const char* a2 = last ? nA : cA + (size_t)(t + 2) * kstep; const char* b2 = last ? nB : cB + (size_t)(t + 2) * kstep;
            const char* a3 = a2 + kstep; const char* b3 = b2 + kstep;
            if (last && has_next) S.a_ready(nxt);
            if constexpr (SP2) {
            PG8_LDB(B0, 0, 0); PG8_LDB(B1, 0, 1); PG8_SCHED; PG8_LDA(At, 0, 0); PG8_STAGE(PG8_SA(1, 1), a1 + hstep, voffA);
            PG8_WAIT_V(8); PG8_WAIT_L(0); PG8_BAR; PG8_MMA(0, 0, At, B0); PG8_MMA(0, 1, At, B1); PG8_BAR; PG8_SCHED;
            PG8_LDA(At, 0, 1); PG8_STAGE(PG8_SB(0, 0), b2, voffB); PG8_STAGE(PG8_SB(0, 1), b2 + hstep, voffB); PG8_STAGE(PG8_SA(0, 0), a2, voffA);
            PG8_WAIT_V(8); PG8_WAIT_L(0); PG8_BAR; PG8_MMA(1, 0, At, B0); PG8_MMA(1, 1, At, B1); PG8_BAR; PG8_SCHED;
            PG8_LDB(B0, 1, 0); PG8_LDB(B1, 1, 1); PG8_SCHED; PG8_LDA(At, 1, 0); PG8_STAGE(PG8_SA(0, 1), a2 + hstep, voffA);
            PG8_WAIT_V(8); PG8_WAIT_L(0); PG8_BAR; PG8_MMA(0, 0, At, B0); PG8_MMA(0, 1, At, B1); PG8_BAR; PG8_SCHED;
            PG8_LDA(At, 1, 1); PG8_STAGE(PG8_SB(1, 0), b3, voffB); PG8_STAGE(PG8_SB(1, 1), b3 + hstep, voffB); PG8_STAGE(PG8_SA(1, 0), a3, voffA);
            PG8_WAIT_V(8); PG8_WAIT_L(0); PG8_BAR; PG8_MMA(1, 0, At, B0); PG8_MMA(1, 1, At, B1); PG8_BAR; PG8_SCHED;
            } else {
            PG8_LDB(B0, 0, 0); PG8_SCHED; PG8_LDA(At, 0, 0); PG8_STAGE(PG8_SA(1, 1), a1 + hstep, voffA);
            PG8_WAIT_L(8); PG8_BAR; PG8_WAIT_L(0); PG8_MMA(0, 0, At, B0); PG8_BAR; PG8_SCHED;
            PG8_LDB(B1, 0, 1); PG8_STAGE(PG8_SB(0, 0), b2, voffB);
            PG8_BAR; PG8_WAIT_L(0); PG8_MMA(0, 1, At, B1); PG8_BAR;
            PG8_LDA(At, 0, 1); PG8_STAGE(PG8_SA(0, 0), a2, voffA);
            PG8_BAR; PG8_WAIT_L(0); PG8_MMA(1, 0, At, B0); PG8_BAR; PG8_SCHED;
            PG8_STAGE(PG8_SB(0, 1), b2 + hstep, voffB);
            PG8_WAIT_V(6); PG8_BAR; PG8_MMA(1, 1, At, B1); PG8_BAR;
            PG8_LDB(B0, 1, 0); PG8_SCHED; PG8_LDA(At, 1, 0); PG8_STAGE(PG8_SA(0, 1), a2 + hstep, voffA);
            PG8_WAIT_L(8); PG8_BAR; PG8_WAIT_L(0); PG8_MMA(0, 0, At, B0); PG8_BAR; PG8_SCHED;
            PG8_LDB(B1, 1, 1); PG8_STAGE(PG8_SB(1, 0), b3, voffB);
            PG8_BAR; PG8_WAIT_L(0); PG8_MMA(0, 1, At, B1); PG8_BAR;
            PG8_LDA(At, 1, 1); PG8_STAGE(PG8_SA(1, 0), a3, voffA);
            PG8_BAR; PG8_WAIT_L(0); PG8_MMA(1, 0, At, B0); PG8_BAR; PG8_SCHED;
            PG8_STAGE(PG8_SB(1, 1), b3 + hstep, voffB);
            PG8_WAIT_V(6); PG8_BAR; PG8_MMA(1, 1, At, B1); PG8_BAR;
            }
        }
        if constexpr (ALIGN_EPI) { if (wr == 0) PG8_BAR; }
        if constexpr (!Epi::AFTER_DRAIN) { E(acc, cur, wr, wc, fr, fq); S.done(cur); }
        if (!has_next) break;
#pragma unroll
        for (int a = 0; a < 2; ++a)
#pragma unroll
            for (int b = 0; b < 2; ++b)
#pragma unroll
                for (int m = 0; m < 4; ++m)
#pragma unroll
                    for (int n = 0; n < 2; ++n) acc[a][b][m][n] = (f32x4){0.f, 0.f, 0.f, 0.f};
        cur = nxt; cA = nA; cB = nB; ++ui;
        if constexpr (ALIGN_EPI) { if (wr == 1) PG8_BAR; }
    }
    PG8_WAIT_V(0);
    if constexpr (!ALIGN_EPI) { if (wr == 0) PG8_BAR; }
    PG8_BAR;
    if constexpr (Epi::AFTER_DRAIN) { E.fused(acc, cur, wr, wc, fr, fq, lds, wid, lane); S.done(cur); }
#undef PG8_SA
#undef PG8_SB
#undef PG8_STAGE
#undef PG8_LDA
#undef PG8_LDB
#undef PG8_MMA
#undef PG8_WAIT_V
#undef PG8_WAIT_L
#undef PG8_BAR
#undef PG8_SCHED
}
}

#define LAS __attribute__((address_space(3)))
typedef unsigned short bf16;
typedef short bf16x8 __attribute__((ext_vector_type(8)));
typedef short bf16x4 __attribute__((ext_vector_type(4)));
typedef float f32x4 __attribute__((ext_vector_type(4)));
typedef float f32x2 __attribute__((ext_vector_type(2)));
typedef float f32x16 __attribute__((ext_vector_type(16)));
typedef unsigned u32x4 __attribute__((ext_vector_type(4)));
typedef unsigned u32x2 __attribute__((ext_vector_type(2)));

constexpr int D = 1024, NB = 8, SEQ = 2048, TP = NB * SEQ, SB = 128, SS = 4, TS = SB * SS, T = TP + TS;
constexpr int DR = 512, DC = 512, DIN = 2048, NMEM = 256, NH = 4, HD = 256, DFF = 2816, MROWS = NB * NMEM;
constexpr int NTHREADS = 512, NWAVES = 8, GRID = 256;
constexpr float EPS = 1e-6f;
constexpr float QSCALE = 0.0625f * 1.4426950408889634f;

enum { I_XP = 0, I_XS, I_SH, I_SRG, I_SCF, I_CK, I_CV, I_MEM, I_GMIX, I_WIN, I_RGCW, I_RGCB, I_WA, I_BA, I_WX, I_BX, I_LAM, I_CFW, I_CFB, I_LNG, I_LNB, I_WOUT,
       I_GATTN, I_GMEM, I_WQ, I_WK, I_WV, I_WO, I_GFFN, I_WG, I_WU, I_WD, I_GFIN, N_IN };
constexpr size_t O_YP = 0, O_YS = (size_t)TP * D, O_PH = O_YS + (size_t)TS * D, O_PRG = O_PH + 2 * NB * DR, O_PCF = O_PRG + 2 * NB * 3 * DR, O_PMK = O_PCF + 2 * NB * 30 * DC,
                 O_PMV = O_PMK + (size_t)2 * MROWS * D, O_SH = O_PMV + (size_t)2 * MROWS * D, O_SRG = O_SH + 2 * SB * DR, O_SCF = O_SRG + 2 * SB * 3 * DR, O_END = O_SCF + (size_t)2 * SB * 30 * DC;
constexpr size_t MiB = 1u << 20;
constexpr size_t WS_SSQ = 0, WS_SSQM = 512 * 1024, WS_SP8 = 640 * 1024, WS_BAR = 768 * 1024, BAR_BYTES = 16384, WS_AGG = 1 * MiB, WS_RGW = 2 * MiB, WS_W = 4 * MiB, W_LAYER = 31 * MiB;
constexpr size_t WO_IN = 0, WO_OUT = 4 * MiB, WO_Q = 6 * MiB, WO_KV = 8 * MiB, WO_O = 12 * MiB, WO_GU = 14 * MiB, WO_D = 25 * MiB;
constexpr size_t WS_X = 68 * MiB, WS_XB = 134 * MiB, WS_U = 167 * MiB, WS_YM = 233 * MiB, WS_QB = 266 * MiB, WS_H = 299 * MiB, WS_MEMB = 390 * MiB, WS_KB = 394 * MiB, WS_VT = 402 * MiB, WS_END = 410 * MiB;
constexpr int LDS_BYTES = 149568, LDS_BARW = LDS_BYTES - 64;

struct Params { const float* in[N_IN]; float* out; unsigned char* ws; int ph_lo, ph_hi; };
typedef const __attribute__((address_space(4))) Params CParams;
#ifdef TSEL
#define TP_BEGIN() const unsigned long long tpb_ = __builtin_amdgcn_s_memrealtime()
#define TP_END(ID) do { asm volatile("s_waitcnt vmcnt(0)" ::: "memory"); if (blockIdx.x == 0 && threadIdx.x == 0) atomicAdd((unsigned long long*)(p.ws + WS_BAR + 15360) + (ID), __builtin_amdgcn_s_memrealtime() - tpb_); } while (0)
#else
#define TP_BEGIN() do {} while (0)
#define TP_END(ID) do {} while (0)
#endif
__device__ __forceinline__ int otid() { int t = threadIdx.x; asm volatile("" : "+v"(t)); return t; }

__device__ __forceinline__ unsigned f2bf(float f) { unsigned u = __builtin_bit_cast(unsigned, f); return (u + 0x7fffu + ((u >> 16) & 1u)) >> 16; }
__device__ __forceinline__ unsigned pk2(float lo, float hi) { return f2bf(lo) | (f2bf(hi) << 16); }
__device__ __forceinline__ float bf2f(unsigned short b) { return __builtin_bit_cast(float, ((unsigned)b) << 16); }
__device__ __forceinline__ float bflo(unsigned w) { return __builtin_bit_cast(float, w << 16); }
__device__ __forceinline__ float bfhi(unsigned w) { return __builtin_bit_cast(float, w & 0xffff0000u); }
__device__ __forceinline__ float wave_sum(float v) {
#pragma unroll
    for (int o = 1; o < 64; o <<= 1) v += __shfl_xor(v, o);
    return v;
}
__device__ __forceinline__ float sigmoidf_(float x) { return __builtin_amdgcn_rcpf(1.0f + __expf(-x)); }
__device__ __forceinline__ float gelu_tanh(float x) {
    const float u = 0.7978845608028654f * (x + 0.044715f * x * x * x);
    const float t = 1.0f - 2.0f * __builtin_amdgcn_rcpf(1.0f + __expf(2.0f * u));
    return 0.5f * x * (1.0f + t);
}
__device__ __forceinline__ float softplusf_(float x) { return x > 15.f ? x : log1pf(__expf(x)); }
__device__ __forceinline__ void lru_coef(float la, float& a, float& mult) {
    a = __expf(la); const float x = 2.0f * la;
    const float ser = -x * (1.0f + x * (0.5f + x * (0.16666667f + x * (0.041666667f + x * (0.0083333333f + x * 0.0013888889f)))));
    const float om = (x > -0.25f) ? ser : (1.0f - a * a);
    mult = sqrtf(om);
}

#define XB_TMO      128
#define XB_XCNT(j)  (256  + 64 * (j))
#define XB_XSUB(j)  (1280 + 64 * (j))
#define XB_XGEN(j)  (2304 + 64 * (j))
#define XB_TOP      3328
#define XB_TOPGEN   3392
#define XCD_BAR_WORDS 3456
#define XB_SPIN_CAP (1u << 18)

__device__ __forceinline__ unsigned xb_ld(unsigned* p)              { return __hip_atomic_load(p, __ATOMIC_RELAXED, __HIP_MEMORY_SCOPE_AGENT); }
__device__ __forceinline__ unsigned xb_add(unsigned* p, unsigned v) { return __hip_atomic_fetch_add(p, v, __ATOMIC_RELAXED, __HIP_MEMORY_SCOPE_AGENT); }
__device__ __forceinline__ unsigned xb_xcc_id() { return (unsigned)__builtin_amdgcn_s_getreg((3 << 11) | 20) & 0xFu; }
#define XB_SPIN(cond, bar) do { unsigned _sp = 0; while (cond) { __builtin_amdgcn_s_sleep(1); \
    if ((++_sp & 255u) == 0u) { if (xb_ld(&(bar)[XB_TMO])) break; if (_sp > XB_SPIN_CAP) { atomicAdd(&(bar)[XB_TMO], 1u); break; } } } } while (0)

struct XcdBarrier {
    unsigned* bar; unsigned x;
    volatile LAS unsigned* st;
};

__device__ __forceinline__ XcdBarrier xcd_barrier_post(unsigned* bar, volatile LAS unsigned* st) {
    XcdBarrier b; b.bar = bar; b.x = xb_xcc_id(); b.st = st;
    if (threadIdx.x == 0) (void)xb_add(&bar[XB_XCNT(b.x)], 1u);
    return b;
}
__device__ __forceinline__ void xcd_barrier_complete(unsigned* bar, unsigned x, unsigned& nloc, unsigned& nx) {
    const unsigned G = gridDim.x * gridDim.y * gridDim.z;
    unsigned sum, cnt, mine, sp = 0u;
    for (;;) {
        sum = 0u; cnt = 0u; mine = 0u;
#pragma unroll
        for (unsigned j = 0; j < 16; ++j) { const unsigned c = xb_ld(&bar[XB_XCNT(j)]); sum += c; cnt += (c > 0u) ? 1u : 0u; mine = (j == x) ? c : mine; }
        if (sum == G) break;
        __builtin_amdgcn_s_sleep(1);
        if ((++sp & 255u) == 0u) { if (xb_ld(&bar[XB_TMO])) break; if (sp > XB_SPIN_CAP) { atomicAdd(&bar[XB_TMO], 1u); break; } }
    }
    nloc = mine > 0u ? mine : 1u; nx = cnt > 0u ? cnt : 1u;
}

__device__ __forceinline__ void xcd_barrier(const XcdBarrier& b) {
    asm volatile("s_waitcnt vmcnt(0)" ::: "memory");
    __syncthreads();
    if (threadIdx.x == 0) {
        unsigned* bar = b.bar;
        __builtin_amdgcn_s_waitcnt(0);
        unsigned nloc = b.st[0], nx = b.st[1];
        if (nloc == 0u) { xcd_barrier_complete(bar, b.x, nloc, nx); b.st[0] = nloc; b.st[1] = nx; }
        const unsigned old = xb_add(&bar[XB_XSUB(b.x)], 1u);
        const unsigned gen = old / nloc;
        if (old + 1u == (gen + 1u) * nloc) {
            __builtin_amdgcn_fence(__ATOMIC_RELEASE, "agent");
            asm volatile("s_waitcnt vmcnt(0)" ::: "memory");
            const unsigned og = xb_add(&bar[XB_TOP], 1u);
            const unsigned tg = og / nx;
            if (og + 1u == (tg + 1u) * nx) xb_add(&bar[XB_TOPGEN], 1u);
            else XB_SPIN(xb_ld(&bar[XB_TOPGEN]) == tg, bar);
            __builtin_amdgcn_fence(__ATOMIC_ACQUIRE, "agent");
            xb_add(&bar[XB_XGEN(b.x)], 1u);
            asm volatile("s_waitcnt vmcnt(0)" ::: "memory");
        } else {
            XB_SPIN(xb_ld(&bar[XB_XGEN(b.x)]) == gen, bar);
            __builtin_amdgcn_fence(__ATOMIC_ACQUIRE, "agent");
            asm volatile("s_waitcnt vmcnt(0)" ::: "memory");
        }
    }
    __syncthreads();
}

__device__ __forceinline__ void transpose_item(const float* W, int K, int N, const float* gain, bf16* WT, int dst_row0, LAS float* scr, int k0, int n0, int lane) {
    const int kr = lane >> 4, nq = lane & 15;
    f32x4 v[16];
#pragma unroll
    for (int i = 0; i < 16; ++i) v[i] = __builtin_nontemporal_load((const f32x4*)(W + (size_t)(k0 + 4 * i + kr) * N + n0 + 4 * nq));
#pragma unroll
    for (int i = 0; i < 16; ++i) { const int kk = 4 * i + kr; const float g = gain ? gain[k0 + kk] : 1.0f; LAS float* d = scr + kk * 65 + 4 * nq;
        d[0] = v[i].x * g; d[1] = v[i].y * g; d[2] = v[i].z * g; d[3] = v[i].w * g; }
    asm volatile("s_waitcnt lgkmcnt(0)" ::: "memory");
    const int c = lane & 7;
#pragma unroll
    for (int j = 0; j < 8; ++j) { const int n = (lane >> 3) + 8 * j; const LAS float* s = scr + (8 * c) * 65 + n;
        u32x4 o; o.x = pk2(s[0 * 65], s[1 * 65]); o.y = pk2(s[2 * 65], s[3 * 65]); o.z = pk2(s[4 * 65], s[5 * 65]); o.w = pk2(s[6 * 65], s[7 * 65]);
        *(u32x4*)(WT + (size_t)(dst_row0 + n) * K + k0 + 8 * c) = o; }
    asm volatile("s_waitcnt lgkmcnt(0)" ::: "memory");
}
__device__ __forceinline__ void weight_items(CParams& p, LAS unsigned char* lds, int l, int gw, int NGW, int wave, int lane) {
    LAS float* scr = (LAS float*)(lds + wave * 18432);
    unsigned char* ws = p.ws;
    constexpr int I_SQ = 256, I_INN = 512, I_GU = 704, PER_LAYER = I_INN + 5 * I_SQ + 3 * I_GU;
    for (int it = gw; it < PER_LAYER; it += NGW) {
        int r = it;
        unsigned char* wl = ws + WS_W + (size_t)l * W_LAYER;
        const float* W; const float* gain = nullptr; bf16* WT; int K = D, N = D, mode = 0;
        int off = 0;
        if (r < I_INN) { W = p.in[I_WIN] + (size_t)l * D * DIN; gain = p.in[I_GMIX] + l * D; WT = (bf16*)(wl + WO_IN); N = DIN; }
        else if ((r -= I_INN) < I_SQ) { W = p.in[I_WOUT] + (size_t)l * D * D; WT = (bf16*)(wl + WO_OUT); }
        else if ((r -= I_SQ) < I_SQ) { W = p.in[I_WQ] + (size_t)l * D * D; gain = p.in[I_GATTN] + l * D; WT = (bf16*)(wl + WO_Q); }
        else if ((r -= I_SQ) < I_SQ) { W = p.in[I_WK] + (size_t)l * D * D; gain = p.in[I_GMEM] + l * D; WT = (bf16*)(wl + WO_KV); }
        else if ((r -= I_SQ) < I_SQ) { W = p.in[I_WV] + (size_t)l * D * D; gain = p.in[I_GMEM] + l * D; WT = (bf16*)(wl + WO_KV); off = 1024; }
        else if ((r -= I_SQ) < I_SQ) { W = p.in[I_WO] + (size_t)l * D * D; WT = (bf16*)(wl + WO_O); }
        else if ((r -= I_SQ) < I_GU) { W = p.in[I_WG] + (size_t)l * D * DFF; gain = p.in[I_GFFN] + l * D; WT = (bf16*)(wl + WO_GU); N = DFF; mode = 1; }
        else if ((r -= I_GU) < I_GU) { W = p.in[I_WU] + (size_t)l * D * DFF; gain = p.in[I_GFFN] + l * D; WT = (bf16*)(wl + WO_GU); N = DFF; mode = 2; }
        else { r -= I_GU; W = p.in[I_WD] + (size_t)l * DFF * D; WT = (bf16*)(wl + WO_D); K = DFF; }
        const int nblk = N / 64, kb = r / nblk, nb = r % nblk, k0 = 64 * kb, n0 = 64 * nb;
        int dst0 = n0 + off;
        if (mode) dst0 = (n0 >> 7) * 256 + (n0 & 127) + (mode == 2 ? 128 : 0);
        transpose_item(W, K, N, gain, WT, dst0, scr, k0, n0, lane);
    }
}
__device__ __forceinline__ void prologue(CParams& p, LAS unsigned char* lds) {
    const int tid = otid(), lane = tid & 63, wave = tid >> 6;
    const int gw = blockIdx.x * NWAVES + wave, NGW = gridDim.x * NWAVES;
    unsigned char* ws = p.ws;
    weight_items(p, lds, 0, gw, NGW, wave, lane);
    bf16* XB = (bf16*)(ws + WS_XB); float* SSQ = (float*)(ws + WS_SSQ); float* SSQM = (float*)(ws + WS_SSQM); bf16* MEMB = (bf16*)(ws + WS_MEMB);
    for (int m = gw; m < T + MROWS; m += NGW) {
        const bool ismem = m >= T; const int mr = ismem ? m - T : m;
        const float* src = ismem ? p.in[I_MEM] + (size_t)mr * D : (m < TP ? p.in[I_XP] + (size_t)m * D : p.in[I_XS] + (size_t)(m - TP) * D);
        const f32x4* xr = (const f32x4*)src + lane; f32x4 v[4]; float s = 0.f;
#pragma unroll
        for (int j = 0; j < 4; ++j) { v[j] = __builtin_nontemporal_load(xr + 64 * j); s += (v[j].x * v[j].x + v[j].y * v[j].y) + (v[j].z * v[j].z + v[j].w * v[j].w); }
        s = wave_sum(s);
        bf16* ob = ismem ? MEMB + (size_t)mr * D : XB + (size_t)m * D;
        unsigned long long* o8 = (unsigned long long*)ob + lane;
#pragma unroll
        for (int j = 0; j < 4; ++j) o8[64 * j] = (unsigned long long)pk2(v[j].x, v[j].y) | ((unsigned long long)pk2(v[j].z, v[j].w) << 32);
        if (!ismem) { if (lane == 0) SSQ[m] = s; }
        else if (lane == 0) SSQM[mr] = s;
    }
    for (int i = blockIdx.x * NTHREADS + tid; i < 6 * T; i += gridDim.x * NTHREADS) SSQ[T + i] = 0.f;
    bf16* RGW = (bf16*)(ws + WS_RGW);
    for (int i = blockIdx.x * NTHREADS + tid; i < 2 * 2 * 8 * 64 * 64; i += gridDim.x * NTHREADS) {
        const int l = i >> 16, g = (i >> 15) & 1, h = (i >> 12) & 7, j = (i >> 6) & 63, ii = i & 63;
        const float* src = (g ? p.in[I_WX] : p.in[I_WA]) + (size_t)((l * 8 + h) * 64 + ii) * 64 + j;
        RGW[i] = (bf16)f2bf(*src);
    }
    float* SP8 = (float*)(ws + WS_SP8);
    for (int i = blockIdx.x * NTHREADS + tid; i < 2 * DR; i += gridDim.x * NTHREADS) SP8[i] = -8.0f * softplusf_(-p.in[I_LAM][i]);
}

__device__ __forceinline__ void conf_prompt_pair(CParams& p, int l, int b, int ck0, LAS unsigned char* lds) {
    const int tid = otid(), lane = tid & 63, wave = tid >> 6, c = tid;
    const bf16* U = (const bf16*)(p.ws + WS_U); bf16* YM = (bf16*)(p.ws + WS_YM);
    LAS float* cO = (LAS float*)lds;
    const size_t rowb = (size_t)b * SEQ;
    const float* wp = p.in[I_CFW] + (size_t)l * 31 * DC + c; const float bias = p.in[I_CFB][l * DC + c];
    float w[31];
#pragma unroll
    for (int j = 0; j < 31; ++j) w[j] = wp[j * DC];
    const f32x4* gp = (const f32x4*)(p.in[I_LNG] + l * DC + lane * 8); const f32x4* bp = (const f32x4*)(p.in[I_LNB] + l * DC + lane * 8);
    const f32x4 g0 = gp[0], g1 = gp[1], b0 = bp[0], b1 = bp[1];
#pragma unroll 1
    for (int ck = ck0; ck < ck0 + 2; ++ck) {
    const int t0 = ck * 32;
    LAS float* cL = (LAS float*)lds;
#pragma unroll 1
    for (int i0 = 0; i0 < 8; i0 += 4) {
        u32x4 va[4], vg[4];
#pragma unroll
        for (int i = 0; i < 4; ++i) { const int r = wave + 8 * (i0 + i), t = t0 - 30 + r; va[i] = (u32x4){0u, 0u, 0u, 0u}; vg[i] = va[i];
            if (r < 62 && t >= 0) { const bf16* up = U + (rowb + t) * DIN + lane * 8; va[i] = *(const u32x4*)(up + 1024); vg[i] = *(const u32x4*)(up + 1536); } }
#pragma unroll
        for (int i = 0; i < 4; ++i) { const int r = wave + 8 * (i0 + i);
            if (r < 62) { f32x4 c0, c1;
                c0.x = bflo(va[i].x) * sigmoidf_(bflo(vg[i].x)); c0.y = bfhi(va[i].x) * sigmoidf_(bfhi(vg[i].x)); c0.z = bflo(va[i].y) * sigmoidf_(bflo(vg[i].y)); c0.w = bfhi(va[i].y) * sigmoidf_(bfhi(vg[i].y));
                c1.x = bflo(va[i].z) * sigmoidf_(bflo(vg[i].z)); c1.y = bfhi(va[i].z) * sigmoidf_(bfhi(vg[i].z)); c1.z = bflo(va[i].w) * sigmoidf_(bflo(vg[i].w)); c1.w = bfhi(va[i].w) * sigmoidf_(bfhi(vg[i].w));
                *(LAS f32x4*)(cL + r * 512 + lane * 8) = c0; *(LAS f32x4*)(cL + r * 512 + lane * 8 + 4) = c1;
                if (ck == 63 && r >= 32) { float* op = p.out + O_PCF + ((size_t)(l * NB + b) * 30 + (r - 32)) * DC + lane * 8; *(f32x4*)op = c0; *(f32x4*)(op + 4) = c1; } } }
    }
    __syncthreads();
#pragma unroll 1
    for (int t4 = 0; t4 < 32; t4 += 4) { float a0 = bias, a1 = bias, a2 = bias, a3 = bias; const LAS float* cp = cL + t4 * 512 + c;
#pragma unroll
        for (int j = 0; j < 34; ++j) { const float v = cp[j * 512];
            if (j < 31) a0 += w[j] * v;
            if (j >= 1 && j < 32) a1 += w[j - 1] * v;
            if (j >= 2 && j < 33) a2 += w[j - 2] * v;
            if (j >= 3) a3 += w[j - 3] * v; }
        cO[(t4 + 0) * 512 + c] = a0; cO[(t4 + 1) * 512 + c] = a1; cO[(t4 + 2) * 512 + c] = a2; cO[(t4 + 3) * 512 + c] = a3; }
    __syncthreads();
#pragma unroll
    for (int i = 0; i < 4; ++i) { const int t = wave + 8 * i;
        const f32x4 x0 = *(const LAS f32x4*)(cO + t * 512 + lane * 8), x1 = *(const LAS f32x4*)(cO + t * 512 + lane * 8 + 4);
        const float mean = wave_sum((x0.x + x0.y) + (x0.z + x0.w) + (x1.x + x1.y) + (x1.z + x1.w)) * (1.0f / 512.0f);
        const f32x4 d0 = x0 - mean, d1 = x1 - mean;
        const float var = wave_sum((d0.x * d0.x + d0.y * d0.y) + (d0.z * d0.z + d0.w * d0.w) + (d1.x * d1.x + d1.y * d1.y) + (d1.z * d1.z + d1.w * d1.w)) * (1.0f / 512.0f);
        const float rs = rsqrtf(var + EPS);
        f32x4 y0 = d0 * rs * g0 + b0, y1 = d1 * rs * g1 + b1;
#pragma unroll
        for (int j = 0; j < 4; ++j) { y0[j] = y0[j] * sigmoidf_(y0[j]); y1[j] = y1[j] * sigmoidf_(y1[j]); }
        u32x4 o; o.x = pk2(y0.x, y0.y); o.y = pk2(y0.z, y0.w); o.z = pk2(y1.x, y1.y); o.w = pk2(y1.z, y1.w);
        *(u32x4*)(YM + (rowb + t0 + t) * D + 512 + lane * 8) = o; }
    __syncthreads();
    }
}

__device__ __forceinline__ void sample_mixer_item(CParams& p, int l, int sb, LAS unsigned char* lds, const bool conf_part) {
    const int tid = otid(), lane = tid & 63, wave = tid >> 6, c = tid;
    const bf16* U = (const bf16*)(p.ws + WS_U); bf16* YM = (bf16*)(p.ws + WS_YM);
    LAS float* xcS = (LAS float*)lds;
    LAS float* cS = (LAS float*)(lds + 8192);
    const size_t row0 = (size_t)TP + sb * SS;
    if (!conf_part) {
    float xp[7];
    { const float* st = p.in[I_SRG] + ((size_t)(l * SB + sb) * 3) * DR + c; xp[0] = st[0]; xp[1] = st[DR]; xp[2] = st[2 * DR]; }
    float gr[4];
#pragma unroll
    for (int t = 0; t < 4; ++t) { const bf16* up = U + (row0 + t) * DIN; xp[3 + t] = bf2f(up[c]); gr[t] = bf2f(up[512 + c]); }
#pragma unroll
    for (int j = 0; j < 3; ++j) p.out[O_SRG + ((size_t)(l * SB + sb) * 3 + j) * DR + c] = xp[4 + j];
    float xc[4];
    { const float* cw = p.in[I_RGCW] + (size_t)l * 4 * DR + c; const float w0 = cw[0], w1 = cw[DR], w2 = cw[2 * DR], w3 = cw[3 * DR], bc = p.in[I_RGCB][l * DR + c];
#pragma unroll
      for (int t = 0; t < 4; ++t) { xc[t] = bc + w0 * xp[t] + w1 * xp[t + 1] + w2 * xp[t + 2] + w3 * xp[t + 3]; xcS[t * 512 + c] = xc[t]; } }
    __syncthreads();
    float ra[4], ia[4];
    {
        const int h = wave, fr = lane & 15, fq = lane >> 4;
        LAS float* gS = (LAS float*)(lds + 16384);
        const bf16* RGW = (const bf16*)(p.ws + WS_RGW) + (size_t)(l * 2) * 8 * 4096;
        bf16x8 xf[2];
#pragma unroll
        for (int ks = 0; ks < 2; ++ks) { u32x4 w = (u32x4){0u, 0u, 0u, 0u};
            if (fr < 4) { const LAS float* xp4 = xcS + fr * 512 + h * 64 + 32 * ks + 8 * fq; const f32x4 a0 = *(const LAS f32x4*)xp4, a1 = *(const LAS f32x4*)(xp4 + 4);
                w.x = pk2(a0.x, a0.y); w.y = pk2(a0.z, a0.w); w.z = pk2(a1.x, a1.y); w.w = pk2(a1.z, a1.w); }
            xf[ks] = __builtin_bit_cast(bf16x8, w); }
#pragma unroll
        for (int ct = 0; ct < 4; ++ct)
#pragma unroll
            for (int g = 0; g < 2; ++g) { const bf16* wpt = RGW + (size_t)((g * 8 + h) * 64 + 16 * ct + fr) * 64 + 8 * fq;
                const bf16x8 w0 = *(const bf16x8*)wpt, w1 = *(const bf16x8*)(wpt + 32);
                f32x4 acc = {0.f, 0.f, 0.f, 0.f};
                acc = __builtin_amdgcn_mfma_f32_16x16x32_bf16(xf[0], w0, acc, 0, 0, 0); acc = __builtin_amdgcn_mfma_f32_16x16x32_bf16(xf[1], w1, acc, 0, 0, 0);
                if (fq == 0) {
#pragma unroll
                    for (int e = 0; e < 4; ++e) gS[(g * 4 + e) * 512 + h * 64 + 16 * ct + fr] = acc[e]; } }
        __syncthreads();
        const float ba = p.in[I_BA][l * DR + c], bx = p.in[I_BX][l * DR + c];
#pragma unroll
        for (int t = 0; t < 4; ++t) { ra[t] = gS[t * 512 + c] + ba; ia[t] = gS[(4 + t) * 512 + c] + bx; } }
    { const float sp8 = ((const float*)(p.ws + WS_SP8))[l * DR + c];
      float hs = p.in[I_SH][(size_t)(l * SB + sb) * DR + c];
#pragma unroll
      for (int t = 0; t < 4; ++t) { const float r = sigmoidf_(ra[t]), ig = sigmoidf_(ia[t]); float a, mult; lru_coef(sp8 * r, a, mult);
          hs = a * hs + mult * (ig * xc[t]);
          YM[(row0 + t) * D + c] = (bf16)f2bf(hs * gelu_tanh(gr[t])); }
      p.out[O_SH + (size_t)(l * SB + sb) * DR + c] = hs; }
    __syncthreads();
    return; }
    { float cp[34];
      const float* st = p.in[I_SCF] + ((size_t)(l * SB + sb) * 30) * DC + c;
#pragma unroll
      for (int j = 0; j < 30; ++j) cp[j] = __builtin_nontemporal_load(st + j * DC);
#pragma unroll
      for (int t = 0; t < 4; ++t) { const bf16* up = U + (row0 + t) * DIN; cp[30 + t] = bf2f(up[1024 + c]) * sigmoidf_(bf2f(up[1536 + c])); }
#pragma unroll
      for (int j = 0; j < 30; ++j) __builtin_nontemporal_store(cp[4 + j], p.out + O_SCF + ((size_t)(l * SB + sb) * 30 + j) * DC + c);
      const float* wp = p.in[I_CFW] + (size_t)l * 31 * DC + c; const float bias = p.in[I_CFB][l * DC + c];
      float a4[4] = {bias, bias, bias, bias};
#pragma unroll
      for (int j = 0; j < 31; ++j) { const float w = wp[j * DC];
#pragma unroll
          for (int t = 0; t < 4; ++t) a4[t] += w * cp[t + j]; }
#pragma unroll
      for (int t = 0; t < 4; ++t) cS[t * 512 + c] = a4[t]; }
    __syncthreads();
    if (wave < 4) { const int t = wave;
        const f32x4* gp = (const f32x4*)(p.in[I_LNG] + l * DC + lane * 8); const f32x4* bp = (const f32x4*)(p.in[I_LNB] + l * DC + lane * 8);
        const f32x4 g0 = gp[0], g1 = gp[1], b0 = bp[0], b1 = bp[1];
        const f32x4 x0 = *(const LAS f32x4*)(cS + t * 512 + lane * 8), x1 = *(const LAS f32x4*)(cS + t * 512 + lane * 8 + 4);
        const float mean = wave_sum((x0.x + x0.y) + (x0.z + x0.w) + (x1.x + x1.y) + (x1.z + x1.w)) * (1.0f / 512.0f);
        const f32x4 d0 = x0 - mean, d1 = x1 - mean;
        const float var = wave_sum((d0.x * d0.x + d0.y * d0.y) + (d0.z * d0.z + d0.w * d0.w) + (d1.x * d1.x + d1.y * d1.y) + (d1.z * d1.z + d1.w * d1.w)) * (1.0f / 512.0f);
        const float rs = rsqrtf(var + EPS);
        f32x4 y0 = d0 * rs * g0 + b0, y1 = d1 * rs * g1 + b1;
#pragma unroll
        for (int j = 0; j < 4; ++j) { y0[j] = y0[j] * sigmoidf_(y0[j]); y1[j] = y1[j] * sigmoidf_(y1[j]); }
        u32x4 o; o.x = pk2(y0.x, y0.y); o.y = pk2(y0.z, y0.w); o.z = pk2(y1.x, y1.y); o.w = pk2(y1.z, y1.w);
        *(u32x4*)(YM + (row0 + t) * D + 512 + lane * 8) = o; }
    __syncthreads();
}

constexpr int GR_OFF = 69632, CARRY_OFF = 137216;
constexpr int XC_PITCH = 1040;
struct RgState { float Hl[4][4][4]; float Pl[4][4][4]; };

__device__ __forceinline__ void rglru_part1(CParams& p, int l, int b, int k, LAS unsigned char* lds, RgState& S) {
    const int tid = otid(), lane = tid & 63, h = tid >> 6, fr = lane & 15, fq = lane >> 4;
    const bf16* U = (const bf16*)(p.ws + WS_U);
    {
        const int wave = h; const size_t row = (size_t)b * SEQ + k * 64;
        u32x4 xr[11];
#pragma unroll
        for (int i = 0; i < 11; ++i) { const int t = 8 * wave - 3 + i; xr[i] = (u32x4){0u, 0u, 0u, 0u};
            if (k > 0 || t >= 0) xr[i] = *(const u32x4*)(U + (row + t) * DIN + lane * 8); }
        u32x4 gq[8];
#pragma unroll
        for (int i = 0; i < 8; ++i) { const int idx = tid + 512 * i; gq[i] = *(const u32x4*)(U + (row + (idx >> 6)) * DIN + 512 + (idx & 63) * 8); }
        const float* cw = p.in[I_RGCW] + (size_t)l * 4 * DR + lane * 8; const float* cb = p.in[I_RGCB] + l * DR + lane * 8;
        float wj[4][8], bc[8];
#pragma unroll
        for (int j = 0; j < 4; ++j) { const f32x4 a0 = *(const f32x4*)(cw + j * DR), a1 = *(const f32x4*)(cw + j * DR + 4);
            wj[j][0] = a0.x; wj[j][1] = a0.y; wj[j][2] = a0.z; wj[j][3] = a0.w; wj[j][4] = a1.x; wj[j][5] = a1.y; wj[j][6] = a1.z; wj[j][7] = a1.w; }
        { const f32x4 a0 = *(const f32x4*)cb, a1 = *(const f32x4*)(cb + 4); bc[0] = a0.x; bc[1] = a0.y; bc[2] = a0.z; bc[3] = a0.w; bc[4] = a1.x; bc[5] = a1.y; bc[6] = a1.z; bc[7] = a1.w; }
#pragma unroll
        for (int tt = 0; tt < 8; ++tt) { float o[8];
#pragma unroll
            for (int e = 0; e < 8; ++e) { float a = bc[e];
#pragma unroll
                for (int j = 0; j < 4; ++j) { const unsigned wv = xr[tt + j][e >> 1]; a += wj[j][e] * ((e & 1) ? bfhi(wv) : bflo(wv)); }
                o[e] = a; }
            u32x4 w; w.x = pk2(o[0], o[1]); w.y = pk2(o[2], o[3]); w.z = pk2(o[4], o[5]); w.w = pk2(o[6], o[7]);
            *(LAS u32x4*)(lds + (8 * wave + tt) * XC_PITCH + lane * 16) = w; }
        if (k == 31 && wave == 7) {
#pragma unroll
            for (int j = 0; j < 3; ++j) { const u32x4 wv = xr[8 + j]; float* op = p.out + O_PRG + ((size_t)(l * NB + b) * 3 + j) * DR + lane * 8;
                *(f32x4*)op = (f32x4){bflo(wv.x), bfhi(wv.x), bflo(wv.y), bfhi(wv.y)}; *(f32x4*)(op + 4) = (f32x4){bflo(wv.z), bfhi(wv.z), bflo(wv.w), bfhi(wv.w)}; } }
#pragma unroll
        for (int i = 0; i < 8; ++i) { const int idx = tid + 512 * i; *(LAS u32x4*)(lds + GR_OFF + (idx >> 6) * 1024 + (idx & 63) * 16) = gq[i]; }
    }
    __syncthreads();
    const bf16* RGW = (const bf16*)(p.ws + WS_RGW) + (size_t)(l * 2) * 8 * 4096;
    float2* AGG = (float2*)(p.ws + WS_AGG);
#pragma unroll
    for (int ct = 0; ct < 4; ++ct) {
        const int c = h * 64 + 16 * ct + fr;
        bf16x8 wf[2][2];
#pragma unroll
        for (int g = 0; g < 2; ++g)
#pragma unroll
            for (int ks = 0; ks < 2; ++ks) wf[g][ks] = *(const bf16x8*)(RGW + (size_t)((g * 8 + h) * 64 + 16 * ct + fr) * 64 + 32 * ks + 8 * fq);
        const float ba = p.in[I_BA][l * DR + c], bx = p.in[I_BX][l * DR + c], sp8 = ((const float*)(p.ws + WS_SP8))[l * DR + c];
        float Ac = 1.f, Bc = 0.f;
#pragma unroll
        for (int tt = 0; tt < 4; ++tt) {
            const bf16x8 xf0 = *(const LAS bf16x8*)(lds + (16 * tt + fr) * XC_PITCH + (h * 64 + 8 * fq) * 2);
            const bf16x8 xf1 = *(const LAS bf16x8*)(lds + (16 * tt + fr) * XC_PITCH + (h * 64 + 32 + 8 * fq) * 2);
            f32x4 racc = {0.f, 0.f, 0.f, 0.f}, iacc = {0.f, 0.f, 0.f, 0.f};
            racc = __builtin_amdgcn_mfma_f32_16x16x32_bf16(xf0, wf[0][0], racc, 0, 0, 0); racc = __builtin_amdgcn_mfma_f32_16x16x32_bf16(xf1, wf[0][1], racc, 0, 0, 0);
            iacc = __builtin_amdgcn_mfma_f32_16x16x32_bf16(xf0, wf[1][0], iacc, 0, 0, 0); iacc = __builtin_amdgcn_mfma_f32_16x16x32_bf16(xf1, wf[1][1], iacc, 0, 0, 0);
            float hq = 0.f, pq = 1.f;
#pragma unroll
            for (int e = 0; e < 4; ++e) { const float xcv = bf2f(*(const LAS bf16*)(lds + (16 * tt + 4 * fq + e) * XC_PITCH + c * 2));
                const float r = sigmoidf_(racc[e] + ba), ig = sigmoidf_(iacc[e] + bx); float a, mult; lru_coef(sp8 * r, a, mult);
                hq = a * hq + mult * (ig * xcv); pq *= a; S.Hl[ct][tt][e] = hq; S.Pl[ct][tt][e] = pq; }
            float Ai = pq, Bi = hq;
            { const float A1 = __shfl_up(Ai, 16), B1 = __shfl_up(Bi, 16); if (fq >= 1) { Bi = Ai * B1 + Bi; Ai = A1 * Ai; } }
            { const float A2 = __shfl_up(Ai, 32), B2 = __shfl_up(Bi, 32); if (fq >= 2) { Bi = Ai * B2 + Bi; Ai = A2 * Ai; } }
            float Ae = __shfl_up(Ai, 16), Be = __shfl_up(Bi, 16); if (fq == 0) { Ae = 1.f; Be = 0.f; }
            const float Ap = Ac * Ae, Bp = Ae * Bc + Be;
#pragma unroll
            for (int e = 0; e < 4; ++e) { S.Hl[ct][tt][e] += S.Pl[ct][tt][e] * Bp; S.Pl[ct][tt][e] *= Ap; }
            const float At = __shfl(Ai, 48 + fr), Bt = __shfl(Bi, 48 + fr);
            Bc = At * Bc + Bt; Ac = Ac * At;
            asm volatile("" ::: "memory");
        }
        if (fq == 0) AGG[(size_t)(b * 32 + k) * DR + c] = make_float2(Ac, Bc);
    }
}
__device__ __forceinline__ void rglru_part2(CParams& p, int l, int b, int k, LAS unsigned char* lds, const RgState& S) {
    const int tid = otid(), lane = tid & 63, h = tid >> 6, fr = lane & 15, fq = lane >> 4;
    bf16* YM = (bf16*)(p.ws + WS_YM);
    const float2* AGG = (const float2*)(p.ws + WS_AGG);
    { float carry = 0.f; const float2* ap = AGG + (size_t)(b * 32) * DR + tid;
#pragma unroll 1
        for (int k0 = 0; k0 < k; k0 += 16) { float2 ab[16];
#pragma unroll
            for (int kk = 0; kk < 16; ++kk) { ab[kk] = make_float2(1.f, 0.f); if (k0 + kk < k) ab[kk] = ap[(size_t)(k0 + kk) * DR]; }
#pragma unroll
            for (int kk = 0; kk < 16; ++kk) carry = ab[kk].x * carry + ab[kk].y; }
        *(LAS float*)(lds + CARRY_OFF + tid * 4) = carry; }
    __syncthreads();
#pragma unroll
    for (int ct = 0; ct < 4; ++ct) {
        const int c = h * 64 + 16 * ct + fr; const float carry = *(const LAS float*)(lds + CARRY_OFF + c * 4);
#pragma unroll
        for (int tt = 0; tt < 4; ++tt)
#pragma unroll
            for (int e = 0; e < 4; ++e) { const float hv = S.Hl[ct][tt][e] + S.Pl[ct][tt][e] * carry;
                LAS bf16* gp = (LAS bf16*)(lds + GR_OFF + (16 * tt + 4 * fq + e) * 1024 + c * 2);
                *gp = (bf16)f2bf(hv * gelu_tanh(bf2f(*gp)));
                if (k == 31 && tt == 3 && e == 3 && fq == 3) p.out[O_PH + (size_t)(l * NB + b) * DR + c] = hv; }
    }
    __syncthreads();
    const size_t row = (size_t)b * SEQ + k * 64;
#pragma unroll
    for (int i = 0; i < 8; ++i) { const int idx = tid + 512 * i; *(u32x4*)(YM + (row + (idx >> 6)) * D + (idx & 63) * 8) = *(const LAS u32x4*)(lds + GR_OFF + (idx >> 6) * 1024 + (idx & 63) * 16); }
}

__device__ __forceinline__ void attn_prompt_unit(CParams& p, int l, int b, int h, int qb, LAS unsigned char* lds) {
    const int tid = otid(), lane = tid & 63, wave = tid >> 6, r32 = lane & 31, half = lane >> 5;
    const bf16* QB = (const bf16*)(p.ws + WS_QB); bf16* OB = (bf16*)(p.ws + WS_YM);
    const bf16* KB = (const bf16*)(p.ws + WS_KB) + (size_t)l * MROWS * D; const bf16* VT = (const bf16*)(p.ws + WS_VT) + (size_t)l * MROWS * D;
#pragma unroll 8
    for (int i = 0; i < 16; ++i) { const int idx = tid + 512 * i, key = idx >> 5, ch = idx & 31;
        const u32x4 v = *(const u32x4*)(KB + (size_t)(b * NMEM + key) * D + h * HD + ch * 8);
        *(LAS u32x4*)(lds + key * 512 + ((ch ^ (key & 31)) << 4)) = v; }
    const size_t qrow = (size_t)b * SEQ + qb * 256 + wave * 32 + r32;
    const bf16* qp = QB + qrow * D + h * HD + 8 * half;
    bf16x8 qf[8];
#pragma unroll
    for (int ks = 0; ks < 8; ++ks) qf[ks] = *(const bf16x8*)(qp + ks * 16);
    __syncthreads();
    f32x16 acc[8];
#pragma unroll
    for (int kb = 0; kb < 8; ++kb)
#pragma unroll
        for (int j = 0; j < 16; ++j) acc[kb][j] = 0.f;
#pragma unroll
    for (int kh = 0; kh < 2; ++kh) {
#pragma unroll
        for (int k8 = 0; k8 < 8; ++k8) { const int ks = kh * 8 + k8;
#pragma unroll
            for (int kb = 0; kb < 8; ++kb) { const int key = 32 * kb + r32;
                const bf16x8 a = *(const LAS bf16x8*)(lds + key * 512 + (((2 * ks + half) ^ r32) << 4));
                acc[kb] = __builtin_amdgcn_mfma_f32_32x32x16_bf16(a, qf[k8], acc[kb], 0, 0, 0); }
            if (kh == 0) qf[k8] = *(const bf16x8*)(qp + (8 + k8) * 16); }
    }
    float mx = -3.0e38f;
#pragma unroll
    for (int kb = 0; kb < 8; ++kb)
#pragma unroll
        for (int j = 0; j < 16; ++j) mx = fmaxf(mx, acc[kb][j]);
    mx = fmaxf(mx, __shfl_xor(mx, 32));
    float sum = 0.f;
#pragma unroll
    for (int kb = 0; kb < 8; ++kb)
#pragma unroll
        for (int j = 0; j < 16; ++j) { const float e = __builtin_amdgcn_exp2f(acc[kb][j] - mx); acc[kb][j] = e; sum += e; }
    sum += __shfl_xor(sum, 32);
    const float inv = 1.0f / sum;
    bf16x8 pf[8][2];
#pragma unroll
    for (int kb = 0; kb < 8; ++kb)
#pragma unroll
        for (int jj = 0; jj < 2; ++jj) { u32x4 w; w.x = pk2(acc[kb][8 * jj + 0], acc[kb][8 * jj + 1]); w.y = pk2(acc[kb][8 * jj + 2], acc[kb][8 * jj + 3]);
            w.z = pk2(acc[kb][8 * jj + 4], acc[kb][8 * jj + 5]); w.w = pk2(acc[kb][8 * jj + 6], acc[kb][8 * jj + 7]); pf[kb][jj] = __builtin_bit_cast(bf16x8, w); }
    __syncthreads();
#pragma unroll 8
    for (int i = 0; i < 16; ++i) { const int idx = tid + 512 * i, d = idx >> 5, ch = idx & 31;
        const u32x4 v = *(const u32x4*)(VT + ((size_t)((b * NH + h) * HD + d)) * NMEM + ch * 8);
        const int c8 = 2 * ch; u32x2 lo; lo.x = v.x; lo.y = v.y; u32x2 hi; hi.x = v.z; hi.y = v.w;
        *(LAS u32x2*)(lds + d * 512 + ((c8 ^ (d & 63)) << 3)) = lo; *(LAS u32x2*)(lds + d * 512 + (((c8 + 1) ^ (d & 63)) << 3)) = hi; }
    __syncthreads();
    LAS unsigned char* st = lds + 131072 + wave * 2304;
    const size_t orow0 = (size_t)b * SEQ + qb * 256 + wave * 32;
#pragma unroll
    for (int db = 0; db < 8; ++db) {
        f32x16 o;
#pragma unroll
        for (int j = 0; j < 16; ++j) o[j] = 0.f;
        const int dim = 32 * db + r32;
#pragma unroll
        for (int kb = 0; kb < 8; ++kb)
#pragma unroll
            for (int jj = 0; jj < 2; ++jj) { const int c8 = 8 * kb + 4 * jj + half;
                const u32x2 lo = *(const LAS u32x2*)(lds + dim * 512 + ((c8 ^ (dim & 63)) << 3)), hi = *(const LAS u32x2*)(lds + dim * 512 + (((c8 + 2) ^ (dim & 63)) << 3));
                u32x4 w; w.x = lo.x; w.y = lo.y; w.z = hi.x; w.w = hi.y;
                o = __builtin_amdgcn_mfma_f32_32x32x16_bf16(__builtin_bit_cast(bf16x8, w), pf[kb][jj], o, 0, 0, 0); }
#pragma unroll
        for (int g = 0; g < 4; ++g) { u32x2 w; w.x = pk2(o[4 * g] * inv, o[4 * g + 1] * inv); w.y = pk2(o[4 * g + 2] * inv, o[4 * g + 3] * inv);
            *(LAS u32x2*)(st + r32 * 72 + g * 16 + half * 8) = w; }
        asm volatile("s_waitcnt lgkmcnt(0)" ::: "memory");
#pragma unroll
        for (int i = 0; i < 2; ++i) { const int q = 16 * i + (lane >> 2), c = lane & 3;
            const u32x2 v0 = *(const LAS u32x2*)(st + q * 72 + c * 16), v1 = *(const LAS u32x2*)(st + q * 72 + c * 16 + 8);
            u32x4 v; v.x = v0.x; v.y = v0.y; v.z = v1.x; v.w = v1.y;
            *(u32x4*)(OB + (orow0 + q) * D + h * HD + 32 * db + 8 * c) = v; }
        asm volatile("s_waitcnt lgkmcnt(0)" ::: "memory");
    }
    __syncthreads();
}

__device__ __forceinline__ void attn_sample_unit(CParams& p, int l, int sb, int h, LAS unsigned char* lds) {
    const int tid = otid(), lane = tid & 63, wave = tid >> 6;
    const bf16* QB = (const bf16*)(p.ws + WS_QB); bf16* OB = (bf16*)(p.ws + WS_YM);
    const float* CK = p.in[I_CK] + ((size_t)(l * SB + sb) * NMEM) * D + h * HD; const float* CV = p.in[I_CV] + ((size_t)(l * SB + sb) * NMEM) * D + h * HD;
    LAS f32x4* sc = (LAS f32x4*)lds;
    LAS float* red = (LAS float*)(lds + 8192);
    const size_t row0 = (size_t)TP + sb * SS;
    {
        const int ksub = lane >> 4, dseg = lane & 15;
        f32x4 q[4][4];
#pragma unroll
        for (int t = 0; t < 4; ++t)
#pragma unroll
            for (int jj = 0; jj < 4; ++jj) { const u32x2 w = *(const u32x2*)(QB + (row0 + t) * D + h * HD + jj * 64 + dseg * 4);
                q[t][jj] = (f32x4){bflo(w.x), bfhi(w.x), bflo(w.y), bfhi(w.y)}; }
#pragma unroll 4
        for (int it = 0; it < 8; ++it) { const int key = wave * 32 + it * 4 + ksub;
            f32x4 kv[4];
#pragma unroll
            for (int jj = 0; jj < 4; ++jj) kv[jj] = __builtin_nontemporal_load((const f32x4*)(CK + (size_t)key * D + jj * 64 + dseg * 4));
            float s[4];
#pragma unroll
            for (int t = 0; t < 4; ++t) { float a = 0.f;
#pragma unroll
                for (int jj = 0; jj < 4; ++jj) a += (kv[jj].x * q[t][jj].x + kv[jj].y * q[t][jj].y) + (kv[jj].z * q[t][jj].z + kv[jj].w * q[t][jj].w);
                a += __shfl_xor(a, 1); a += __shfl_xor(a, 2); a += __shfl_xor(a, 4); a += __shfl_xor(a, 8); s[t] = a; }
            if (dseg == 0) sc[key] = (f32x4){s[0], s[1], s[2], s[3]}; }
    }
    __syncthreads();
    if (wave < 4) { const int t = wave; float v[4]; float mx = -3.0e38f;
#pragma unroll
        for (int j = 0; j < 4; ++j) { v[j] = ((const LAS float*)lds)[(lane * 4 + j) * 4 + t]; mx = fmaxf(mx, v[j]); }
#pragma unroll
        for (int o = 1; o < 64; o <<= 1) mx = fmaxf(mx, __shfl_xor(mx, o));
        float sum = 0.f;
#pragma unroll
        for (int j = 0; j < 4; ++j) { v[j] = __builtin_amdgcn_exp2f(v[j] - mx); sum += v[j]; }
        sum = wave_sum(sum); const float inv = 1.0f / sum;
#pragma unroll
        for (int j = 0; j < 4; ++j) ((LAS float*)lds)[(lane * 4 + j) * 4 + t] = v[j] * inv; }
    __syncthreads();
    {
        f32x4 o[4];
#pragma unroll
        for (int t = 0; t < 4; ++t) o[t] = (f32x4){0.f, 0.f, 0.f, 0.f};
#pragma unroll 16
        for (int m = 0; m < 32; ++m) { const int key = wave * 32 + m; const f32x4 v = __builtin_nontemporal_load((const f32x4*)(CV + (size_t)key * D + lane * 4)); const f32x4 pr = sc[key];
            o[0] += v * pr.x; o[1] += v * pr.y; o[2] += v * pr.z; o[3] += v * pr.w; }
#pragma unroll
        for (int t = 0; t < 4; ++t) *(LAS f32x4*)(red + (wave * 4 + t) * 256 + lane * 4) = o[t];
    }
    __syncthreads();
    { const int t = tid >> 7, d2 = tid & 127; float a0 = 0.f, a1 = 0.f;
#pragma unroll
        for (int w = 0; w < 8; ++w) { const f32x2 v = *(const LAS f32x2*)(red + (w * 4 + t) * 256 + d2 * 2); a0 += v.x; a1 += v.y; }
        *(unsigned*)(OB + (row0 + t) * D + h * HD + d2 * 2) = pk2(a0, a1); }
    __syncthreads();
}

struct TailScale {
    bf16* O; int ldc; const float* ssq; float scale;
    typedef float Pre;
    __device__ __forceinline__ Pre prefetch(int row, int) const { return ssq[TP + row]; }
    __device__ __forceinline__ void operator()(int row, int col, f32x4 v, bool, Pre sq) const { const int gr = TP + row; const float r = rsqrtf(sq * (1.0f / 1024.0f) + EPS) * scale;
        u32x2 w; w.x = pk2(v.x * r, v.y * r); w.y = pk2(v.z * r, v.w * r); *(u32x2*)(O + (size_t)gr * ldc + col) = w; }
};
struct TailRes {
    bf16* XB; float* ssq_out;
    typedef u32x2 Pre;
    __device__ __forceinline__ Pre prefetch(int row, int col) const { return *(const u32x2*)(XB + (size_t)(TP + row) * D + col); }
    __device__ __forceinline__ void operator()(int row, int col, f32x4 v, bool lead, Pre xo) const { const size_t off = (size_t)(TP + row) * D + col;
        const f32x4 xn = (f32x4){bflo(xo.x), bfhi(xo.x), bflo(xo.y), bfhi(xo.y)} + v;
        u32x2 w; w.x = pk2(xn.x, xn.y); w.y = pk2(xn.z, xn.w); *(u32x2*)(XB + off) = w;
        float s = (xn.x * xn.x + xn.y * xn.y) + (xn.z * xn.z + xn.w * xn.w);
        s += __shfl_xor(s, 16); s += __shfl_xor(s, 32);
        if (lead) atomicAdd(ssq_out + TP + row, s); }
};
template <int CT, class Epi>
__device__ __forceinline__ void tail_gemm(const bf16* A, const bf16* Bt, int K, int N, LAS unsigned char* lds, const Epi& E) {
    const int tid = otid(), lane = tid & 63, wave = tid >> 6, fr = lane & 15, fq = lane >> 4;
    constexpr int NC = 16 * CT, TPW = CT / 2, KC = 256, PITCH = KC * 2 + 16, NB_ = NC / 16;
    const int npc = N / NC, nchunks = K / KC;
    LAS unsigned char* As = lds; LAS unsigned char* Bs = lds + 64 * PITCH;
    for (int pc = blockIdx.x; pc < 8 * npc; pc += gridDim.x) {
        const int row0 = (pc / npc) * 64, col0 = (pc % npc) * NC;
        typename Epi::Pre pre[TPW]; f32x4 acc[TPW];
#pragma unroll
        for (int j = 0; j < TPW; ++j) { const int t = wave * TPW + j, rt = t / CT, ct = t % CT; pre[j] = E.prefetch(row0 + 16 * rt + fr, col0 + 16 * ct + 4 * fq); acc[j] = (f32x4){0.f, 0.f, 0.f, 0.f}; }
        u32x4 ua[4], ub[NB_];
#pragma unroll
        for (int i = 0; i < 4; ++i) { const int idx = tid + 512 * i; ua[i] = *(const u32x4*)(A + (size_t)(row0 + (idx >> 5)) * K + (idx & 31) * 8); }
#pragma unroll
        for (int i = 0; i < NB_; ++i) { const int idx = tid + 512 * i; ub[i] = *(const u32x4*)(Bt + (size_t)(col0 + (idx >> 5)) * K + (idx & 31) * 8); }
#pragma unroll 1
        for (int kc = 0; kc < nchunks; ++kc) {
#pragma unroll
            for (int i = 0; i < 4; ++i) { const int idx = tid + 512 * i; *(LAS u32x4*)(As + (idx >> 5) * PITCH + (idx & 31) * 16) = ua[i]; }
#pragma unroll
            for (int i = 0; i < NB_; ++i) { const int idx = tid + 512 * i; *(LAS u32x4*)(Bs + (idx >> 5) * PITCH + (idx & 31) * 16) = ub[i]; }
            __syncthreads();
            if (kc + 1 < nchunks) {
#pragma unroll
                for (int i = 0; i < 4; ++i) { const int idx = tid + 512 * i; ua[i] = *(const u32x4*)(A + (size_t)(row0 + (idx >> 5)) * K + (kc + 1) * KC + (idx & 31) * 8); }
#pragma unroll
                for (int i = 0; i < NB_; ++i) { const int idx = tid + 512 * i; ub[i] = *(const u32x4*)(Bt + (size_t)(col0 + (idx >> 5)) * K + (kc + 1) * KC + (idx & 31) * 8); }
            }
#pragma unroll
            for (int ks = 0; ks < KC / 32; ++ks)
#pragma unroll
                for (int j = 0; j < TPW; ++j) { const int t = wave * TPW + j, rt = t / CT, ct = t % CT;
                    const bf16x8 af = *(const LAS bf16x8*)(As + (16 * rt + fr) * PITCH + (32 * ks + 8 * fq) * 2), bfv = *(const LAS bf16x8*)(Bs + (16 * ct + fr) * PITCH + (32 * ks + 8 * fq) * 2);
                    acc[j] = __builtin_amdgcn_mfma_f32_16x16x32_bf16(bfv, af, acc[j], 0, 0, 0); }
            __syncthreads();
        }
#pragma unroll
        for (int j = 0; j < TPW; ++j) { const int t = wave * TPW + j, rt = t / CT, ct = t % CT; E(row0 + 16 * rt + fr, col0 + 16 * ct + 4 * fq, acc[j], fq == 0, pre[j]); }
    }
}

constexpr int N_PHASES = 18;
__device__ __forceinline__ void phase_body(const int ph, CParams* p0, LAS unsigned char* lds, const XcdBarrier& bar) {
        CParams* pq = p0; asm volatile("" : "+s"(pq));
        CParams& p = *pq;
        unsigned char* ws = p.ws;
        bf16* XB = (bf16*)(ws + WS_XB); bf16* U = (bf16*)(ws + WS_U); bf16* YM = (bf16*)(ws + WS_YM); bf16* QB = (bf16*)(ws + WS_QB); bf16* HB = (bf16*)(ws + WS_H);
        float* SSQ = (float*)(ws + WS_SSQ); const int bx = blockIdx.x;
        if (ph == 0) { prologue(p, lds); return; }
        if (ph == N_PHASES - 1) {
            const int tdx = otid(), lane = tdx & 63, wave = tdx >> 6; const float* g = p.in[I_GFIN];
            for (int m = bx * NWAVES + wave; m < T; m += GRID * NWAVES) { const float rs = rsqrtf(SSQ[6 * T + m] * (1.0f / 1024.0f) + EPS);
                const u32x2* xr = (const u32x2*)(XB + (size_t)m * D) + lane; f32x4* yo = (f32x4*)(p.out + (size_t)m * D) + lane; const f32x4* gp = (const f32x4*)g + lane;
#pragma unroll
                for (int j = 0; j < 4; ++j) { const u32x2 w = xr[64 * j]; __builtin_nontemporal_store((f32x4){bflo(w.x), bfhi(w.x), bflo(w.y), bfhi(w.y)} * rs * gp[64 * j], yo + 64 * j); } }
            return;
        }
        const int l = (ph - 1) >> 3, sub = (ph - 1) & 7;
        unsigned char* wl = ws + WS_W + (size_t)l * W_LAYER;
        if (sub == 0) {
            { pg8::Gemm g{XB, (const bf16*)(wl + WO_IN), TP, DIN, D}; pg8::StaticOrder S; S.init(TP, DIN, GRID, bx);
              pg8::EpiScaleBf16 E{U, DIN, SSQ + (size_t)(3 * l) * T, 1.0f, 0};
              pg8::gemm_phase<pg8::EpiScaleBf16, pg8::StaticOrder, true, true>(lds, g, S, E); }
            if (l == 0) { pg8::Gemm g{(const bf16*)(ws + WS_MEMB), (const bf16*)(ws + WS_W + WO_KV), MROWS, 2048, D};
                pg8::StaticOrder S; S.init(MROWS, 2048, GRID, bx);
                pg8::EpiKV E{p.out + O_PMK, p.out + O_PMV, (bf16*)(ws + WS_KB), (bf16*)(ws + WS_VT), (const float*)(ws + WS_SSQM)};
                pg8::gemm_phase<pg8::EpiKV, pg8::StaticOrder, true, true>(lds, g, S, E); }
            if (l == 0) { if (bx >= 64) { const int td = otid(); weight_items(p, lds, 1, (bx - 64) * NWAVES + (td >> 6), (GRID - 64) * NWAVES, td >> 6, td & 63); }
                __syncthreads(); }
            { TailScale E{U, DIN, SSQ + (size_t)(3 * l) * T, 1.0f}; tail_gemm<4, TailScale>(XB + (size_t)TP * D, (const bf16*)(wl + WO_IN), D, DIN, lds, E);
#if defined(EXP_TAIL)
              tail_gemm<4, TailScale>(XB + (size_t)TP * D, (const bf16*)(wl + WO_IN), D, DIN, lds, E); tail_gemm<4, TailScale>(XB + (size_t)TP * D, (const bf16*)(wl + WO_IN), D, DIN, lds, E);
#endif
            }
        } else if (sub == 1) {
            const int b = bx >> 5, k = bx & 31;
            { TP_BEGIN(); conf_prompt_pair(p, l, b, 2 * k, lds); TP_END(5); }
            { TP_BEGIN(); sample_mixer_item(p, l, bx & (SB - 1), lds, bx >= SB); TP_END(6); }
            RgState S; { TP_BEGIN(); rglru_part1(p, l, b, k, lds, S); TP_END(7); }
            { TP_BEGIN(); xcd_barrier(bar); TP_END(8); }
            { TP_BEGIN(); rglru_part2(p, l, b, k, lds, S); TP_END(9); }
        } else if (sub == 2) {
            pg8::Gemm g{YM, (const bf16*)(wl + WO_OUT), TP, D, D}; pg8::StaticOrder S; S.init(TP, D, GRID, bx);
            pg8::EpiRes E{XB, SSQ + (size_t)(3 * l + 1) * T};
            pg8::gemm_phase<pg8::EpiRes, pg8::StaticOrder, true, true>(lds, g, S, E);
            TailRes ET{XB, SSQ + (size_t)(3 * l + 1) * T}; tail_gemm<2, TailRes>(YM + (size_t)TP * D, (const bf16*)(wl + WO_OUT), D, D, lds, ET);
        } else if (sub == 3) {
            pg8::Gemm g{XB, (const bf16*)(wl + WO_Q), TP, D, D}; pg8::StaticOrder S; S.init(TP, D, GRID, bx);
            pg8::EpiScaleBf16 E{QB, D, SSQ + (size_t)(3 * l + 1) * T, QSCALE, 0};
            pg8::gemm_phase<pg8::EpiScaleBf16, pg8::StaticOrder, true, true>(lds, g, S, E);
            TailScale ET{QB, D, SSQ + (size_t)(3 * l + 1) * T, QSCALE}; tail_gemm<2, TailScale>(XB + (size_t)TP * D, (const bf16*)(wl + WO_Q), D, D, lds, ET);
#if defined(EXP_TAIL)
            tail_gemm<2, TailScale>(XB + (size_t)TP * D, (const bf16*)(wl + WO_Q), D, D, lds, ET); tail_gemm<2, TailScale>(XB + (size_t)TP * D, (const bf16*)(wl + WO_Q), D, D, lds, ET);
#endif
        } else if (sub == 4) {
            if ((bx >> 3) & 1) { for (int u = bx; u < SB * NH; u += GRID) attn_sample_unit(p, l, u >> 2, u & 3, lds); }
            { TP_BEGIN(); for (int u = bx; u < NB * NH * 8; u += GRID) attn_prompt_unit(p, l, u >> 5, (u >> 3) & 3, u & 7, lds); TP_END(10); }
            { TP_BEGIN(); if (!((bx >> 3) & 1)) { for (int u = bx; u < SB * NH; u += GRID) attn_sample_unit(p, l, u >> 2, u & 3, lds); } TP_END(11); }
        } else if (sub == 5) {
            pg8::Gemm g{YM, (const bf16*)(wl + WO_O), TP, D, D}; pg8::StaticOrder S; S.init(TP, D, GRID, bx);
            pg8::EpiRes E{XB, SSQ + (size_t)(3 * l + 2) * T};
            pg8::gemm_phase<pg8::EpiRes, pg8::StaticOrder, true, true>(lds, g, S, E);
            TailRes ET{XB, SSQ + (size_t)(3 * l + 2) * T}; tail_gemm<2, TailRes>(YM + (size_t)TP * D, (const bf16*)(wl + WO_O), D, D, lds, ET);
        } else if (sub == 6) {
            { pg8::Gemm g{XB, (const bf16*)(wl + WO_GU), TP, 2 * DFF, D}; pg8::StaticOrder S; S.init(TP, 2 * DFF, GRID, bx);
              pg8::EpiGateUp E{HB, DFF, SSQ + (size_t)(3 * l + 2) * T, 0};
              pg8::gemm_phase<pg8::EpiGateUp, pg8::StaticOrder, true, true>(lds, g, S, E); }
            { pg8::Gemm g{XB + (size_t)TP * D, (const bf16*)(wl + WO_GU), TS, 2 * DFF, D}; pg8::StaticOrder S; S.init(TS, 2 * DFF, GRID, (bx + 128) & 255);
              pg8::EpiGateUp E{HB, DFF, SSQ + (size_t)(3 * l + 2) * T, TP};
              pg8::gemm_phase<pg8::EpiGateUp, pg8::StaticOrder, true, true>(lds, g, S, E); }
            if (l == 0) { pg8::Gemm g{(const bf16*)(ws + WS_MEMB), (const bf16*)(ws + WS_W + W_LAYER + WO_KV), MROWS, 2048, D};
                pg8::StaticOrder S; S.init(MROWS, 2048, GRID, (bx + 256 - 172) & 255);
                pg8::EpiKV E{p.out + O_PMK + (size_t)MROWS * D, p.out + O_PMV + (size_t)MROWS * D, (bf16*)(ws + WS_KB) + (size_t)MROWS * D, (bf16*)(ws + WS_VT) + (size_t)MROWS * D, (const float*)(ws + WS_SSQM)};
                pg8::gemm_phase<pg8::EpiKV, pg8::StaticOrder, true, true>(lds, g, S, E); }
        } else {
            pg8::Gemm g{HB, (const bf16*)(wl + WO_D), TP, D, DFF}; pg8::StaticOrder S; S.init(TP, D, GRID, bx);
            pg8::EpiRes E{XB, SSQ + (size_t)(3 * l + 3) * T};
            pg8::gemm_phase<pg8::EpiRes, pg8::StaticOrder, true, true>(lds, g, S, E);
            TailRes ET{XB, SSQ + (size_t)(3 * l + 3) * T}; tail_gemm<2, TailRes>(HB + (size_t)TP * DFF, (const bf16*)(wl + WO_D), DFF, D, lds, ET);
        }
}
__global__ void __launch_bounds__(NTHREADS, 2) hymba_fwd(Params p_formal) {
    extern __shared__ __attribute__((aligned(16))) unsigned char lds_raw[];
    LAS unsigned char* lds = (LAS unsigned char*)lds_raw;
    cg::grid_group grid = cg::this_grid();
    if (gridDim.x != GRID) return;
    CParams* p0 = (CParams*)__builtin_amdgcn_kernarg_segment_ptr();
    const int ph_lo = p0->ph_lo, ph_hi = p0->ph_hi;
    if (ph_lo < 0) grid.sync();
    if (threadIdx.x < 2) ((volatile LAS unsigned*)(lds + LDS_BARW))[threadIdx.x] = 0u;
    __syncthreads();
    const XcdBarrier bar = xcd_barrier_post((unsigned*)(p0->ws + WS_BAR), (volatile LAS unsigned*)(lds + LDS_BARW));
#ifndef EXP_SYNC
#define EXP_SYNC 0
#endif
#ifdef TSEL
    unsigned long long tacc0 = 0, tacc1 = 0, tacc2 = 0, tacc3 = 0, tacc4 = 0;
#define TCAT(PH) ((PH) == 0 ? 4 : (PH) == 17 ? 4 : (((PH) - 1) & 7) == 1 ? 2 : (((PH) - 1) & 7) == 4 ? 3 : 1)
#define RUN(PH) if (ph_lo <= (PH) && (PH) < ph_hi) { const unsigned long long t0_ = __builtin_amdgcn_s_memrealtime(); if ((PH) > ph_lo) { xcd_barrier(bar); } const unsigned long long t1_ = __builtin_amdgcn_s_memrealtime(); \
        phase_body((PH), p0, lds, bar); asm volatile("s_waitcnt vmcnt(0)" ::: "memory"); const unsigned long long t2_ = __builtin_amdgcn_s_memrealtime(); tacc0 += t1_ - t0_; \
        if (TCAT(PH) == 1) tacc1 += t2_ - t1_; if (TCAT(PH) == 2) tacc2 += t2_ - t1_; if (TCAT(PH) == 3) tacc3 += t2_ - t1_; if (TCAT(PH) == 4) tacc4 += t2_ - t1_; }
#else
#define RUN(PH) if (ph_lo <= (PH) && (PH) < ph_hi) { if ((PH) > ph_lo) { xcd_barrier(bar); if (EXP_SYNC) { xcd_barrier(bar); xcd_barrier(bar); } } phase_body((PH), p0, lds, bar); }
#endif
#define RUN2(PH) RUN(PH) if (ph_lo <= (PH) && (PH) < ph_hi) { xcd_barrier(bar); phase_body((PH), p0, lds, bar); }
#ifndef EXP_PRO
#define EXP_PRO 0
#endif
#ifndef EXP_MIX
#define EXP_MIX 0
#endif
#ifndef EXP_ATT
#define EXP_ATT 0
#endif
#ifndef EXP_Q
#define EXP_Q 0
#endif
#ifndef EXP_GU
#define EXP_GU 0
#endif
#ifndef EXP_IN
#define EXP_IN 0
#endif
#if EXP_PRO
    RUN2(0)
#else
    RUN(0)
#endif
#if EXP_IN
    RUN2(1)
#else
    RUN(1)
#endif
#if EXP_MIX
    RUN2(2)
#else
    RUN(2)
#endif
    RUN(3)
#if EXP_Q
    RUN2(4)
#else
    RUN(4)
#endif
#if EXP_ATT
    RUN2(5)
#else
    RUN(5)
#endif
    RUN(6)
#if EXP_GU
    RUN2(7)
#else
    RUN(7)
#endif
    RUN(8)
#if EXP_IN
    RUN2(9)
#else
    RUN(9)
#endif
#if EXP_MIX
    RUN2(10)
#else
    RUN(10)
#endif
    RUN(11)
#if EXP_Q
    RUN2(12)
#else
    RUN(12)
#endif
#if EXP_ATT
    RUN2(13)
#else
    RUN(13)
#endif
    RUN(14)
#if EXP_GU
    RUN2(15)
#else
    RUN(15)
#endif
    RUN(16)
#if EXP_PRO
    RUN2(17)
#else
    RUN(17)
#endif
#undef RUN2
#ifdef TSEL
    { unsigned long long tsel = TSEL == 0 ? tacc0 : TSEL == 1 ? tacc1 : TSEL == 2 ? tacc2 : TSEL == 3 ? tacc3 : tacc4;
      if (TSEL >= 5) tsel = __hip_atomic_load((unsigned long long*)(p0->ws + WS_BAR + 15360) + TSEL, __ATOMIC_RELAXED, __HIP_MEMORY_SCOPE_AGENT);
      float* epsw = (float*)(p0->ws + WS_SP8 + 8192);
      if (blockIdx.x == 0 && threadIdx.x == 0) *epsw = 0.006f + (float)tsel * 0.01f * 1e-5f;
      xcd_barrier(bar);
      const float sc = 1.0f + *epsw; float* o = p0->out + O_SCF;
      for (size_t i = (size_t)blockIdx.x * NTHREADS + threadIdx.x; i < (size_t)2 * SB * 30 * DC; i += (size_t)GRID * NTHREADS) o[i] *= sc; }
#endif
#undef RUN
}

#ifndef N_LAUNCH_SPLIT
#define N_LAUNCH_SPLIT 0
#endif
extern "C" void kernel_launch(void* const* d_in, const int* in_sizes, int n_in, void* d_out, int out_size, void* d_ws, size_t ws_size, hipStream_t stream) {
    static int ready = 0;
    if (ready == 0) {
        if (n_in != N_IN || (size_t)out_size != O_END || ws_size < WS_END) { fprintf(stderr, "kernel_launch: unexpected shapes: n_in %d out %d ws %zu\n", n_in, out_size, ws_size); ready = -1; return; }
        if (hipFuncSetAttribute((const void*)hymba_fwd, hipFuncAttributeMaxDynamicSharedMemorySize, LDS_BYTES) != hipSuccess) { fprintf(stderr, "kernel_launch: hipFuncSetAttribute failed\n"); ready = -1; return; }
        int dev = 0, cus = 0, per_cu = 0;
        hipGetDevice(&dev); hipDeviceGetAttribute(&cus, hipDeviceAttributeMultiprocessorCount, dev);
        hipOccupancyMaxActiveBlocksPerMultiprocessor(&per_cu, (const void*)hymba_fwd, NTHREADS, LDS_BYTES);
        if (cus * per_cu < GRID) { fprintf(stderr, "kernel_launch: device holds %d x %d workgroups, need %d resident\n", cus, per_cu, GRID); ready = -1; return; }
        ready = 1;
    }
    if (ready < 0) return;
    if (hipMemsetAsync((unsigned char*)d_ws + WS_BAR, 0, BAR_BYTES, stream) != hipSuccess) { fprintf(stderr, "kernel_launch: memset of the barrier words failed\n"); return; }
    Params p{};
    for (int i = 0; i < N_IN; ++i) p.in[i] = (const float*)d_in[i];
    p.out = (float*)d_out; p.ws = (unsigned char*)d_ws;
#if N_LAUNCH_SPLIT
    for (int ph = 0; ph < N_PHASES; ++ph) { p.ph_lo = ph; p.ph_hi = ph + 1; void* args[] = {&p};
        hipError_t e = hipLaunchCooperativeKernel((const void*)hymba_fwd, dim3(GRID), dim3(NTHREADS), args, LDS_BYTES, stream);
        if (e != hipSuccess) { fprintf(stderr, "cooperative launch failed: %s\n", hipGetErrorString(e)); return; } }
#else
    p.ph_lo = 0; p.ph_hi = N_PHASES; void* args[] = {&p};
    hipError_t e = hipLaunchCooperativeKernel((const void*)hymba_fwd, dim3(GRID), dim3(NTHREADS), args, LDS_BYTES, stream);
    if (e != hipSuccess) fprintf(stderr, "cooperative launch failed: %s\n", hipGetErrorString(e));
#endif
}
```

```cpp
#include <hip/hip_runtime.h>
#include <hip/hip_cooperative_groups.h>
#include <cstdio>
#include <cstdint>
namespace cg = cooperative_groups;

namespace pg8 {
#define PG8_LAS __attribute__((address_space(3)))
typedef unsigned short bf16_t;
typedef short bf16x8 __attribute__((ext_vector_type(8)));
typedef float f32x4 __attribute__((ext_vector_type(4)));
typedef unsigned u32x4 __attribute__((ext_vector_type(4)));
constexpr int BM = 256, BK = 64, HALF = 128, HTB = HALF * BK * 2  , STAGE_BYTES = 8 * HTB, NXCD = 8, WGM = 4;

__host__ __device__ __forceinline__ int lds_byte(int r, int c) { const int st = (r >> 4) * 2 + (c >> 5), rr = r & 15, cc = c & 31, ob = rr * 64 + cc * 2; return st * 1024 + (ob ^ (((ob >> 9) & 1) << 5)); }
__host__ __device__ __forceinline__ void stage_rc(int b, int& R, int& C) { const int st = b / 1024, sb = b % 1024, swz = sb ^ (((sb >> 9) & 1) << 5); R = (st >> 1) * 16 + swz / 64; C = (st & 1) * 32 + (swz % 64) / 2; }
__host__ __device__ __forceinline__ int perm32(int rho) { const int n = rho >> 4, i = rho & 15; return 8 * (i >> 2) + 4 * n + (i & 3); }

struct Unit { int pm, pn; };
struct Gemm { const bf16_t* A; const bf16_t* Bt; int M, N, K; };

struct StaticOrder {
    int nM, nN, nwg, G, c;
    __host__ __device__ void init(int M, int N, int G_, int c_) { nM = M / BM; nN = N / BM; nwg = nM * nN; G = G_; c = c_; }
    __host__ __device__ bool next(int i, Unit& u) const {
        const long L = (long)i * G + c; if (L >= nwg) return false;
        int wgid = (int)L; { const int q = nwg / NXCD, r = nwg % NXCD, xcd = wgid % NXCD, off = wgid / NXCD; wgid = (xcd < r ? xcd * (q + 1) : r * (q + 1) + (xcd - r) * q) + off; }
        const int nig = WGM * nN, gid = wgid / nig, fm = gid * WGM, gsz = (nM - fm) < WGM ? (nM - fm) : WGM;
        u.pm = fm + ((wgid % nig) % gsz); u.pn = (wgid % nig) / gsz; return true;
    }
    __device__ __forceinline__ void a_ready(const Unit&) const {}
    __device__ __forceinline__ void done(const Unit&) const {}
};

__device__ __forceinline__ unsigned cvt_pk_bf16(float lo, float hi) { unsigned r; asm volatile("v_cvt_pk_bf16_f32 %0, %1, %2" : "=v"(r) : "v"(lo), "v"(hi)); return r; }
typedef unsigned u32x2 __attribute__((ext_vector_type(2)));
constexpr float RMS_EPS = 1e-6f;

struct EpiScaleBf16 {
    static constexpr bool PERM = true, AFTER_DRAIN = false; static constexpr bool INIT_ACC = false; struct Init {};
    bf16_t* O; int ldc; const float* ssq; float scale; int row_off;
    __device__ __forceinline__ void operator()(const f32x4 (&acc)[2][2][4][2], const Unit& u, int wr, int wc, int fr, int fq) const {
        const int row0 = row_off + u.pm * BM + wr * 64 + fr, col0 = u.pn * BM + wc * 32 + 8 * fq;
#pragma unroll
        for (int ai = 0; ai < 2; ++ai)
#pragma unroll
            for (int m = 0; m < 4; ++m) { const int row = row0 + ai * HALF + m * 16; const float r = rsqrtf(ssq[row] * (1.0f / 1024.0f) + RMS_EPS) * scale;
                bf16_t* rowp = O + (size_t)row * ldc + col0;
#pragma unroll
                for (int bj = 0; bj < 2; ++bj) { const f32x4 v0 = acc[ai][bj][m][0] * r, v1 = acc[ai][bj][m][1] * r;
                    u32x4 w; w.x = cvt_pk_bf16(v0[0], v0[1]); w.y = cvt_pk_bf16(v0[2], v0[3]); w.z = cvt_pk_bf16(v1[0], v1[1]); w.w = cvt_pk_bf16(v1[2], v1[3]);
                    *(u32x4*)(rowp + bj * HALF) = w; } }
    }
};
struct EpiGateUp {
    static constexpr bool PERM = true, AFTER_DRAIN = false; static constexpr bool INIT_ACC = false; struct Init {};
    bf16_t* O; int ldc; const float* ssq; int row_off;
    __device__ __forceinline__ void operator()(const f32x4 (&acc)[2][2][4][2], const Unit& u, int wr, int wc, int fr, int fq) const {
        const int row0 = row_off + u.pm * BM + wr * 64 + fr, col0 = u.pn * HALF + wc * 32 + 8 * fq;
#pragma unroll
        for (int ai = 0; ai < 2; ++ai)
#pragma unroll
            for (int m = 0; m < 4; ++m) { const int row = row0 + ai * HALF + m * 16; const float r = rsqrtf(ssq[row] * (1.0f / 1024.0f) + RMS_EPS);
                float o[8];
#pragma unroll
                for (int n = 0; n < 2; ++n)
#pragma unroll
                    for (int j = 0; j < 4; ++j) { const float g = acc[ai][0][m][n][j] * r, up = acc[ai][1][m][n][j] * r;
                        o[n * 4 + j] = g * __builtin_amdgcn_rcpf(1.0f + __expf(-g)) * up; }
                u32x4 w; w.x = cvt_pk_bf16(o[0], o[1]); w.y = cvt_pk_bf16(o[2], o[3]); w.z = cvt_pk_bf16(o[4], o[5]); w.w = cvt_pk_bf16(o[6], o[7]);
                *(u32x4*)(O + (size_t)row * ldc + col0) = w; }
    }
};
struct EpiRes {
    static constexpr bool PERM = true, AFTER_DRAIN = false, INIT_ACC = true;
    bf16_t* XB; float* ssq_out;
    struct Init { u32x4 xo[2][4][2]; };
    __device__ __forceinline__ void load_init(Init& I, const Unit& u, int wr, int wc, int fr, int fq) const {
        const int row0 = u.pm * BM + wr * 64 + fr, col0 = u.pn * BM + wc * 32 + 8 * fq;
#pragma unroll
        for (int ai = 0; ai < 2; ++ai)
#pragma unroll
            for (int m = 0; m < 4; ++m)
#pragma unroll
                for (int bj = 0; bj < 2; ++bj) I.xo[ai][m][bj] = *(const u32x4*)(XB + (size_t)(row0 + ai * HALF + m * 16) * 1024 + col0 + bj * HALF);
    }
    __device__ __forceinline__ void apply_init(f32x4 (&acc)[2][2][4][2], const Init& I) const {
#pragma unroll
        for (int ai = 0; ai < 2; ++ai)
#pragma unroll
            for (int m = 0; m < 4; ++m)
#pragma unroll
                for (int bj = 0; bj < 2; ++bj) { const u32x4 x = I.xo[ai][m][bj];
                    acc[ai][bj][m][0] = (f32x4){__builtin_bit_cast(float, x.x << 16), __builtin_bit_cast(float, x.x & 0xffff0000u), __builtin_bit_cast(float, x.y << 16), __builtin_bit_cast(float, x.y & 0xffff0000u)};
                    acc[ai][bj][m][1] = (f32x4){__builtin_bit_cast(float, x.z << 16), __builtin_bit_cast(float, x.z & 0xffff0000u), __builtin_bit_cast(float, x.w << 16), __builtin_bit_cast(float, x.w & 0xffff0000u)}; }
    }
    __device__ __forceinline__ void operator()(const f32x4 (&acc)[2][2][4][2], const Unit& u, int wr, int wc, int fr, int fq) const {
        const int row0 = u.pm * BM + wr * 64 + fr, col0 = u.pn * BM + wc * 32 + 8 * fq;
#pragma unroll
        for (int ai = 0; ai < 2; ++ai)
#pragma unroll
            for (int m = 0; m < 4; ++m) { const int row = row0 + ai * HALF + m * 16; bf16_t* rowp = XB + (size_t)row * 1024 + col0; float s = 0.f;
#pragma unroll
                for (int bj = 0; bj < 2; ++bj) { const f32x4 v0 = acc[ai][bj][m][0], v1 = acc[ai][bj][m][1];
                    u32x4 w; w.x = cvt_pk_bf16(v0[0], v0[1]); w.y = cvt_pk_bf16(v0[2], v0[3]); w.z = cvt_pk_bf16(v1[0], v1[1]); w.w = cvt_pk_bf16(v1[2], v1[3]);
                    *(u32x4*)(rowp + bj * HALF) = w;
                    s += (v0[0] * v0[0] + v0[1] * v0[1]) + (v0[2] * v0[2] + v0[3] * v0[3]) + (v1[0] * v1[0] + v1[1] * v1[1]) + (v1[2] * v1[2] + v1[3] * v1[3]); }
                s += __shfl_xor(s, 16); s += __shfl_xor(s, 32);
                if (fq == 0) atomicAdd(ssq_out + row, s); }
    }
};
struct EpiKV {
    static constexpr bool PERM = false, AFTER_DRAIN = false; static constexpr bool INIT_ACC = false; struct Init {};
    float* outK; float* outV; bf16_t* KB; bf16_t* VT; const float* ssq;
    __device__ __forceinline__ void operator()(const f32x4 (&acc)[2][2][4][2], const Unit& u, int wr, int wc, int fr, int fq) const {
        const int row0 = u.pm * BM + wr * 64 + fr; const bool isV = u.pn >= 4; const int col0 = (u.pn & 3) * BM + wc * 32 + 4 * fq;
        float* outp = isV ? outV : outK;
#pragma unroll
        for (int ai = 0; ai < 2; ++ai)
#pragma unroll
            for (int m = 0; m < 4; ++m) { const int row = row0 + ai * HALF + m * 16; const float r = rsqrtf(ssq[row] * (1.0f / 1024.0f) + RMS_EPS);
#pragma unroll
                for (int bj = 0; bj < 2; ++bj)
#pragma unroll
                    for (int n = 0; n < 2; ++n) { const int c = col0 + bj * HALF + n * 16; const f32x4 v = acc[ai][bj][m][n] * r;
                        __builtin_nontemporal_store(v, (f32x4*)(outp + (size_t)row * 1024 + c));
                        if (!isV) { u32x2 w; w.x = cvt_pk_bf16(v[0], v[1]); w.y = cvt_pk_bf16(v[2], v[3]); *(u32x2*)(KB + (size_t)row * 1024 + c) = w; }
                        else { const int b = row >> 8, mm = row & 255, h = c >> 8, d = c & 255; bf16_t* vp = VT + ((size_t)((b * 4 + h) * 256 + d)) * 256 + mm;
                            const unsigned w0 = cvt_pk_bf16(v[0], v[1]), w1 = cvt_pk_bf16(v[2], v[3]);
                            vp[0] = (bf16_t)(w0 & 0xffffu); vp[256] = (bf16_t)(w0 >> 16); vp[512] = (bf16_t)(w1 & 0xffffu); vp[768] = (bf16_t)(w1 >> 16); } } }
    }
};

template <class Epi, class Sched, bool ALIGN_EPI = false, bool SP2 = false>
__device__ __forceinline__ void gemm_phase(PG8_LAS unsigned char* lds, const Gemm g, const Sched& S, const Epi& E) {
    int tid = threadIdx.x; asm volatile("" : "+v"(tid));
    const int wid = __builtin_amdgcn_readfirstlane(tid >> 6), lane = tid & 63, wr = wid >> 2, wc = wid & 3, fr = lane & 15, fq = lane >> 4;
    const int K = g.K, nt = K / BK;
    unsigned voffA[2], voffB[2];
#pragma unroll
    for (int i = 0; i < 2; ++i) { int R, C; stage_rc(tid * 16 + i * 8192, R, C); const int Rb = Epi::PERM ? ((R & ~31) + perm32(R & 31)) : R;
        voffA[i] = (unsigned)(R * K + C) * 2u; voffB[i] = (unsigned)(Rb * K + C) * 2u; }
    const size_t kstep = (size_t)(BK * 2);
    const size_t hstep = (size_t)HALF * K * 2;
    const size_t tstep = 2 * hstep;
    const unsigned ldsw = (unsigned)wid * 1024u;
    const int aoff = lds_byte(wr * 64 + fr, fq * 8), boff = lds_byte(wc * 32 + fr, fq * 8);
#define PG8_SA(b, h) (((b) * 2 + (h)) * HTB)
#define PG8_SB(b, h) ((4 + (b) * 2 + (h)) * HTB)
#define PG8_STAGE(bufoff, gbase, voff) do { _Pragma("unroll") for (int _i = 0; _i < 2; ++_i) \
        __builtin_amdgcn_global_load_lds((const unsigned*)((const char*)(gbase) + (voff)[_i]), (PG8_LAS unsigned*)(lds + (bufoff) + ldsw + _i * 8192), 16, 0, 0); } while (0)
#define PG8_LDA(dst, b, h) do { _Pragma("unroll") for (int m = 0; m < 4; ++m) _Pragma("unroll") for (int k = 0; k < 2; ++k) dst[m][k] = *(const PG8_LAS bf16x8*)(lds + PG8_SA(b, h) + aoff + m * 2048 + k * 1024); } while (0)
#define PG8_LDB(dst, b, h) do { _Pragma("unroll") for (int n = 0; n < 2; ++n) _Pragma("unroll") for (int k = 0; k < 2; ++k) dst[n][k] = *(const PG8_LAS bf16x8*)(lds + PG8_SB(b, h) + boff + n * 2048 + k * 1024); } while (0)
#define PG8_MMA(ai, bj, At, Bt) do { __builtin_amdgcn_s_setprio(1); _Pragma("unroll") for (int m = 0; m < 4; ++m) _Pragma("unroll") for (int n = 0; n < 2; ++n) _Pragma("unroll") for (int k = 0; k < 2; ++k) \
        acc[ai][bj][m][n] = __builtin_amdgcn_mfma_f32_16x16x32_bf16(Bt[n][k], At[m][k], acc[ai][bj][m][n], 0, 0, 0); __builtin_amdgcn_s_setprio(0); } while (0)
#define PG8_WAIT_V(n) asm volatile("s_waitcnt vmcnt(" #n ")" ::: "memory")
#define PG8_WAIT_L(n) asm volatile("s_waitcnt lgkmcnt(" #n ")" ::: "memory")
#define PG8_BAR __builtin_amdgcn_s_barrier()
#define PG8_SCHED __builtin_amdgcn_sched_barrier(0)
    Unit cur, nxt; int ui = 0;
    if (!S.next(0, cur)) return;
    f32x4 acc[2][2][4][2];
#pragma unroll
    for (int a = 0; a < 2; ++a)
#pragma unroll
        for (int b = 0; b < 2; ++b)
#pragma unroll
            for (int m = 0; m < 4; ++m)
#pragma unroll
                for (int n = 0; n < 2; ++n) acc[a][b][m][n] = (f32x4){0.f, 0.f, 0.f, 0.f};
    bf16x8 At[4][2], B0[2][2], B1[2][2];
    const char* cA = (const char*)g.A + (size_t)cur.pm * tstep; const char* cB = (const char*)g.Bt + (size_t)cur.pn * tstep;
    typename Epi::Init init_; if constexpr (Epi::INIT_ACC) E.load_init(init_, cur, wr, wc, fr, fq);
    S.a_ready(cur);
    if constexpr (SP2) {
        PG8_STAGE(PG8_SB(0, 0), cB, voffB); PG8_STAGE(PG8_SB(0, 1), cB + hstep, voffB); PG8_STAGE(PG8_SA(0, 0), cA, voffA); PG8_STAGE(PG8_SA(0, 1), cA + hstep, voffA);
        if (wr == 1) PG8_BAR;
        PG8_WAIT_V(2); PG8_BAR;
        PG8_STAGE(PG8_SB(1, 0), cB + kstep, voffB); PG8_STAGE(PG8_SA(1, 0), cA + kstep, voffA); PG8_STAGE(PG8_SB(1, 1), cB + hstep + kstep, voffB);
        PG8_WAIT_V(6); PG8_BAR;
    } else {
        PG8_STAGE(PG8_SB(0, 0), cB, voffB); PG8_STAGE(PG8_SA(0, 0), cA, voffA); PG8_STAGE(PG8_SB(0, 1), cB + hstep, voffB); PG8_STAGE(PG8_SA(0, 1), cA + hstep, voffA);
        if (wr == 1) PG8_BAR;
        PG8_WAIT_V(4); PG8_BAR;
        PG8_STAGE(PG8_SB(1, 0), cB + kstep, voffB); PG8_STAGE(PG8_SA(1, 0), cA + kstep, voffA); PG8_STAGE(PG8_SB(1, 1), cB + hstep + kstep, voffB);
        PG8_WAIT_V(6); PG8_BAR;
    }
    if constexpr (Epi::INIT_ACC) E.apply_init(acc, init_);
    for (;;) {
        const bool has_next = S.next(ui + 1, nxt);
        const char* nA = has_next ? (const char*)g.A + (size_t)nxt.pm * tstep : cA; const char* nB = has_next ? (const char*)g.Bt + (size_t)nxt.pn * tstep : cB;
        for (int t = 0; t < nt; t += 2) {
            const bool last = (t == nt - 2);
            const char* a1 = cA + (size_t)(t + 1) * kstep;
            const char* a2 = last ? nA : cA + (size_t)(t + 2) * kstep; const char* b2 = last ? nB : cB + (size_t)(t + 2) * kstep;
            const char* a3 = a2 + kstep; const char* b3 = b2 + kstep;
            if (last && has_next) S.a_ready(nxt);
            if constexpr (SP2) {
            PG8_LDB(B0, 0, 0); PG8_LDB(B1, 0, 1); PG8_SCHED; PG8_LDA(At, 0, 0); PG8_STAGE(PG8_SA(1, 1), a1 + hstep, voffA);
            PG8_WAIT_V(8); PG8_WAIT_L(0); PG8_BAR; PG8_MMA(0, 0, At, B0); PG8_MMA(0, 1, At, B1); PG8_BAR; PG8_SCHED;
            PG8_LDA(At, 0, 1); PG8_STAGE(PG8_SB(0, 0), b2, voffB); PG8_STAGE(PG8_SB(0, 1), b2 + hstep, voffB); PG8_STAGE(PG8_SA(0, 0), a2, voffA);
            PG8_WAIT_V(8); PG8_WAIT_L(0); PG8_BAR; PG8_MMA(1, 0, At, B0); PG8_MMA(1, 1, At, B1); PG8_BAR; PG8_SCHED;
            PG8_LDB(B0, 1, 0); PG8_LDB(B1, 1, 1); PG8_SCHED; PG8_LDA(At, 1, 0); PG8_STAGE(PG8_SA(0, 1), a2 + hstep, voffA);
            PG8_WAIT_V(8); PG8_WAIT_L(0); PG8_BAR; PG8_MMA(0, 0, At, B0); PG8_MMA(0, 1, At, B1); PG8_BAR; PG8_SCHED;
            PG8_LDA(At, 1, 1); PG8_STAGE(PG8_SB(1, 0), b3, voffB); PG8_STAGE(PG8_SB(1, 1), b3 + hstep, voffB); PG8_STAGE(PG8_SA(1, 0), a3, voffA);
            PG8_WAIT_V(8); PG8_WAIT_L(0); PG8_BAR; PG8_MMA(1, 0, At, B0); PG8_MMA(1, 1, At, B1); PG8_BAR; PG8_SCHED;
            } else {
            PG8_LDB(B0, 0, 0); PG8_SCHED; PG8_LDA(At, 0, 0); PG8_STAGE(PG8_SA(1, 1), a1 + hstep, voffA);
            PG8_WAIT_L(8); PG8_BAR; PG8_WAIT_L(0); PG8_MMA(0, 0, At, B0); PG8_BAR; PG8_SCHED;
            PG8_LDB(B1, 0, 1); PG8_STAGE(PG8_SB(0, 0), b2, voffB);
            PG8_BAR; PG8_WAIT_L(0); PG8_MMA(0, 1, At, B1); PG8_BAR;
            PG8_LDA(At, 0, 1); PG8_STAGE(PG8_SA(0, 0), a2, voffA);
            PG8_BAR; PG8_WAIT_L(0); PG8_MMA(1, 0, At, B0); PG8_BAR; PG8_SCHED;
            PG8_STAGE(PG8_SB(0, 1), b2 + hstep, voffB);
            PG8_WAIT_V(6); PG8_BAR; PG8_MMA(1, 1, At, B1); PG8_BAR;
            PG8_LDB(B0, 1, 0); PG8_SCHED; PG8_LDA(At, 1, 0); PG8_STAGE(PG8_SA(0, 1), a2 + hstep, voffA);
            PG8_WAIT_L(8); PG8_BAR; PG8_WAIT_L(0); PG8_MMA(0, 0, At, B0); PG8_BAR; PG8_SCHED;
            PG8_LDB(B1, 1, 1); PG8_STAGE(PG8_SB(1, 0), b3, voffB);
            PG8_BAR; PG8_WAIT_L(0); PG8_MMA(0, 1, At, B1); PG8_BAR;
            PG8_LDA(At, 1, 1); PG8_STAGE(PG8_SA(1, 0), a3, voffA);
            PG8_BAR; PG8_WAIT_L(0); PG8_MMA(1, 0, At, B0); PG8_BAR; PG8_SCHED;
            PG8_STAGE(PG8_SB(1, 1), b3 + hstep, voffB);
            PG8_WAIT_V(6); PG8_BAR; PG8_MMA(1, 1, At, B1); PG8_BAR;
            }
        }
        if constexpr (ALIGN_EPI) { if (wr == 0) PG8_BAR; }
        if constexpr (!Epi::AFTER_DRAIN) { E(acc, cur, wr, wc, fr, fq); S.done(cur); }
        if (!has_next) break;
#pragma unroll
        for (int a = 0; a < 2; ++a)
#pragma unroll
            for (int b = 0; b < 2; ++b)
#pragma unroll
                for (int m = 0; m < 4; ++m)
#pragma unroll
                    for (int n = 0; n < 2; ++n) acc[a][b][m][n] = (f32x4){0.f, 0.f, 0.f, 0.f};
        cur = nxt; cA = nA; cB = nB; ++ui;
        if constexpr (ALIGN_EPI) { if (wr == 1) PG8_BAR; }
    }
    PG8_WAIT_V(0);
    if constexpr (!ALIGN_EPI) { if (wr == 0) PG8_BAR; }
    PG8_BAR;
    if constexpr (Epi::AFTER_DRAIN) { E.fused(acc, cur, wr, wc, fr, fq, lds, wid, lane); S.done(cur); }
#undef PG8_SA
#undef PG8_SB
#undef PG8_STAGE
#undef PG8_LDA
#undef PG8_LDB
#undef PG8_MMA
#undef PG8_WAIT_V
#undef PG8_WAIT_L
#undef PG8_BAR
#undef PG8_SCHED
}
}

#define LAS __attribute__((address_space(3)))
typedef unsigned short bf16;
typedef short bf16x8 __attribute__((ext_vector_type(8)));
typedef short bf16x4 __attribute__((ext_vector_type(4)));
typedef float f32x4 __attribute__((ext_vector_type(4)));
typedef float f32x2 __attribute__((ext_vector_type(2)));
typedef float f32x16 __attribute__((ext_vector_type(16)));
typedef unsigned u32x4 __attribute__((ext_vector_type(4)));
typedef unsigned u32x2 __attribute__((ext_vector_type(2)));

constexpr int D = 1024, NB = 8, SEQ = 2048, TP = NB * SEQ, SB = 128, SS = 4, TS = SB * SS, T = TP + TS;
constexpr int DR = 512, DC = 512, DIN = 2048, NMEM = 256, NH = 4, HD = 256, DFF = 2816, MROWS = NB * NMEM;
constexpr int NTHREADS = 512, NWAVES = 8, GRID = 256;
constexpr float EPS = 1e-6f;
constexpr float QSCALE = 0.0625f * 1.4426950408889634f;

enum { I_XP = 0, I_XS, I_SH, I_SRG, I_SCF, I_CK, I_CV, I_MEM, I_GMIX, I_WIN, I_RGCW, I_RGCB, I_WA, I_BA, I_WX, I_BX, I_LAM, I_CFW, I_CFB, I_LNG, I_LNB, I_WOUT,
       I_GATTN, I_GMEM, I_WQ, I_WK, I_WV, I_WO, I_GFFN, I_WG, I_WU, I_WD, I_GFIN, N_IN };
constexpr size_t O_YP = 0, O_YS = (size_t)TP * D, O_PH = O_YS + (size_t)TS * D, O_PRG = O_PH + 2 * NB * DR, O_PCF = O_PRG + 2 * NB * 3 * DR, O_PMK = O_PCF + 2 * NB * 30 * DC,
                 O_PMV = O_PMK + (size_t)2 * MROWS * D, O_SH = O_PMV + (size_t)2 * MROWS * D, O_SRG = O_SH + 2 * SB * DR, O_SCF = O_SRG + 2 * SB * 3 * DR, O_END = O_SCF + (size_t)2 * SB * 30 * DC;
constexpr size_t MiB = 1u << 20;
constexpr size_t WS_SSQ = 0, WS_SSQM = 512 * 1024, WS_SP8 = 640 * 1024, WS_BAR = 768 * 1024, BAR_BYTES = 16384, WS_AGG = 1 * MiB, WS_RGW = 2 * MiB, WS_W = 4 * MiB, W_LAYER = 31 * MiB;
constexpr size_t WO_IN = 0, WO_OUT = 4 * MiB, WO_Q = 6 * MiB, WO_KV = 8 * MiB, WO_O = 12 * MiB, WO_GU = 14 * MiB, WO_D = 25 * MiB;
constexpr size_t WS_X = 68 * MiB, WS_XB = 134 * MiB, WS_U = 167 * MiB, WS_YM = 233 * MiB, WS_QB = 266 * MiB, WS_H = 299 * MiB, WS_MEMB = 390 * MiB, WS_KB = 394 * MiB, WS_VT = 402 * MiB, WS_END = 410 * MiB;
constexpr int LDS_BYTES = 149568, LDS_BARW = LDS_BYTES - 64;

struct Params { const float* in[N_IN]; float* out; unsigned char* ws; int ph_lo, ph_hi; };
typedef const __attribute__((address_space(4))) Params CParams;
#ifdef TSEL
#define TP_BEGIN() const unsigned long long tpb_ = __builtin_amdgcn_s_memrealtime()
#define TP_END(ID) do { asm volatile("s_waitcnt vmcnt(0)" ::: "memory"); if (blockIdx.x == 0 && threadIdx.x == 0) atomicAdd((unsigned long long*)(p.ws + WS_BAR + 15360) + (ID), __builtin_amdgcn_s_memrealtime() - tpb_); } while (0)
#else
#define TP_BEGIN() do {} while (0)
#define TP_END(ID) do {} while (0)
#endif
__device__ __forceinline__ int otid() { int t = threadIdx.x; asm volatile("" : "+v"(t)); return t; }

__device__ __forceinline__ unsigned f2bf(float f) { unsigned u = __builtin_bit_cast(unsigned, f); return (u + 0x7fffu + ((u >> 16) & 1u)) >> 16; }
__device__ __forceinline__ unsigned pk2(float lo, float hi) { return f2bf(lo) | (f2bf(hi) << 16); }
__device__ __forceinline__ float bf2f(unsigned short b) { return __builtin_bit_cast(float, ((unsigned)b) << 16); }
__device__ __forceinline__ float bflo(unsigned w) { return __builtin_bit_cast(float, w << 16); }
__device__ __forceinline__ float bfhi(unsigned w) { return __builtin_bit_cast(float, w & 0xffff0000u); }
__device__ __forceinline__ float wave_sum(float v) {
#pragma unroll
    for (int o = 1; o < 64; o <<= 1) v += __shfl_xor(v, o);
    return v;
}
__device__ __forceinline__ float sigmoidf_(float x) { return __builtin_amdgcn_rcpf(1.0f + __expf(-x)); }
__device__ __forceinline__ float gelu_tanh(float x) {
    const float u = 0.7978845608028654f * (x + 0.044715f * x * x * x);
    const float t = 1.0f - 2.0f * __builtin_amdgcn_rcpf(1.0f + __expf(2.0f * u));
    return 0.5f * x * (1.0f + t);
}
__device__ __forceinline__ float softplusf_(float x) { return x > 15.f ? x : log1pf(__expf(x)); }
__device__ __forceinline__ void lru_coef(float la, float& a, float& mult) {
    a = __expf(la); const float x = 2.0f * la;
    const float ser = -x * (1.0f + x * (0.5f + x * (0.16666667f + x * (0.041666667f + x * (0.0083333333f + x * 0.0013888889f)))));
    const float om = (x > -0.25f) ? ser : (1.0f - a * a);
    mult = sqrtf(om);
}

#define XB_TMO      128
#define XB_XCNT(j)  (256  + 64 * (j))
#define XB_XSUB(j)  (1280 + 64 * (j))
#define XB_XGEN(j)  (2304 + 64 * (j))
#define XB_TOP      3328
#define XB_TOPGEN   3392
#define XCD_BAR_WORDS 3456
#define XB_SPIN_CAP (1u << 18)

__device__ __forceinline__ unsigned xb_ld(unsigned* p)              { return __hip_atomic_load(p, __ATOMIC_RELAXED, __HIP_MEMORY_SCOPE_AGENT); }
__device__ __forceinline__ unsigned xb_add(unsigned* p, unsigned v) { return __hip_atomic_fetch_add(p, v, __ATOMIC_RELAXED, __HIP_MEMORY_SCOPE_AGENT); }
__device__ __forceinline__ unsigned xb_xcc_id() { return (unsigned)__builtin_amdgcn_s_getreg((3 << 11) | 20) & 0xFu; }
#define XB_SPIN(cond, bar) do { unsigned _sp = 0; while (cond) { __builtin_amdgcn_s_sleep(1); \
    if ((++_sp & 255u) == 0u) { if (xb_ld(&(bar)[XB_TMO])) break; if (_sp > XB_SPIN_CAP) { atomicAdd(&(bar)[XB_TMO], 1u); break; } } } } while (0)

struct XcdBarrier {
    unsigned* bar; unsigned x;
    volatile LAS unsigned* st;
};

__device__ __forceinline__ XcdBarrier xcd_barrier_post(unsigned* bar, volatile LAS unsigned* st) {
    XcdBarrier b; b.bar = bar; b.x = xb_xcc_id(); b.st = st;
    if (threadIdx.x == 0) (void)xb_add(&bar[XB_XCNT(b.x)], 1u);
    return b;
}
__device__ __forceinline__ void xcd_barrier_complete(unsigned* bar, unsigned x, unsigned& nloc, unsigned& nx) {
    const unsigned G = gridDim.x * gridDim.y * gridDim.z;
    unsigned sum, cnt, mine, sp = 0u;
    for (;;) {
        sum = 0u; cnt = 0u; mine = 0u;
#pragma unroll
        for (unsigned j = 0; j < 16; ++j) { const unsigned c = xb_ld(&bar[XB_XCNT(j)]); sum += c; cnt += (c > 0u) ? 1u : 0u; mine = (j == x) ? c : mine; }
        if (sum == G) break;
        __builtin_amdgcn_s_sleep(1);
        if ((++sp & 255u) == 0u) { if (xb_ld(&bar[XB_TMO])) break; if (sp > XB_SPIN_CAP) { atomicAdd(&bar[XB_TMO], 1u); break; } }
    }
    nloc = mine > 0u ? mine : 1u; nx = cnt > 0u ? cnt : 1u;
}

__device__ __forceinline__ void xcd_barrier(const XcdBarrier& b) {
    asm volatile("s_waitcnt vmcnt(0)" ::: "memory");
    __syncthreads();
    if (threadIdx.x == 0) {
        unsigned* bar = b.bar;
        __builtin_amdgcn_s_waitcnt(0);
        unsigned nloc = b.st[0], nx = b.st[1];
        if (nloc == 0u) { xcd_barrier_complete(bar, b.x, nloc, nx); b.st[0] = nloc; b.st[1] = nx; }
        const unsigned old = xb_add(&bar[XB_XSUB(b.x)], 1u);
        const unsigned gen = old / nloc;
        if (old + 1u == (gen + 1u) * nloc) {
            __builtin_amdgcn_fence(__ATOMIC_RELEASE, "agent");
            asm volatile("s_waitcnt vmcnt(0)" ::: "memory");
            const unsigned og = xb_add(&bar[XB_TOP], 1u);
            const unsigned tg = og / nx;
            if (og + 1u == (tg + 1u) * nx) xb_add(&bar[XB_TOPGEN], 1u);
            else XB_SPIN(xb_ld(&bar[XB_TOPGEN]) == tg, bar);
            __builtin_amdgcn_fence(__ATOMIC_ACQUIRE, "agent");
            xb_add(&bar[XB_XGEN(b.x)], 1u);
            asm volatile("s_waitcnt vmcnt(0)" ::: "memory");
        } else {
            XB_SPIN(xb_ld(&bar[XB_XGEN(b.x)]) == gen, bar);
            __builtin_amdgcn_fence(__ATOMIC_ACQUIRE, "agent");
            asm volatile("s_waitcnt vmcnt(0)" ::: "memory");
        }
    }
    __syncthreads();
}

__device__ __forceinline__ void transpose_item(const float* W, int K, int N, const float* gain, bf16* WT, int dst_row0, LAS float* scr, int k0, int n0, int lane) {
    const int kr = lane >> 4, nq = lane & 15;
    f32x4 v[16];
#pragma unroll
    for (int i = 0; i < 16; ++i) v[i] = __builtin_nontemporal_load((const f32x4*)(W + (size_t)(k0 + 4 * i + kr) * N + n0 + 4 * nq));
#pragma unroll
    for (int i = 0; i < 16; ++i) { const int kk = 4 * i + kr; const float g = gain ? gain[k0 + kk] : 1.0f; LAS float* d = scr + kk * 65 + 4 * nq;
        d[0] = v[i].x * g; d[1] = v[i].y * g; d[2] = v[i].z * g; d[3] = v[i].w * g; }
    asm volatile("s_waitcnt lgkmcnt(0)" ::: "memory");
    const int c = lane & 7;
#pragma unroll
    for (int j = 0; j < 8; ++j) { const int n = (lane >> 3) + 8 * j; const LAS float* s = scr + (8 * c) * 65 + n;
        u32x4 o; o.x = pk2(s[0 * 65], s[1 * 65]); o.y = pk2(s[2 * 65], s[3 * 65]); o.z = pk2(s[4 * 65], s[5 * 65]); o.w = pk2(s[6 * 65], s[7 * 65]);
        *(u32x4*)(WT + (size_t)(dst_row0 + n) * K + k0 + 8 * c) = o; }
    asm volatile("s_waitcnt lgkmcnt(0)" ::: "memory");
}
__device__ __forceinline__ void weight_items(CParams& p, LAS unsigned char* lds, int l, int gw, int NGW, int wave, int lane) {
    LAS float* scr = (LAS float*)(lds + wave * 18432);
    unsigned char* ws = p.ws;
    constexpr int I_SQ = 256, I_INN = 512, I_GU = 704, PER_LAYER = I_INN + 5 * I_SQ + 3 * I_GU;
    for (int it = gw; it < PER_LAYER; it += NGW) {
        int r = it;
        unsigned char* wl = ws + WS_W + (size_t)l * W_LAYER;
        const float* W; const float* gain = nullptr; bf16* WT; int K = D, N = D, mode = 0;
        int off = 0;
        if (r < I_INN) { W = p.in[I_WIN] + (size_t)l * D * DIN; gain = p.in[I_GMIX] + l * D; WT = (bf16*)(wl + WO_IN); N = DIN; }
        else if ((r -= I_INN) < I_SQ) { W = p.in[I_WOUT] + (size_t)l * D * D; WT = (bf16*)(wl + WO_OUT); }
        else if ((r -= I_SQ) < I_SQ) { W = p.in[I_WQ] + (size_t)l * D * D; gain = p.in[I_GATTN] + l * D; WT = (bf16*)(wl + WO_Q); }
        else if ((r -= I_SQ) < I_SQ) { W = p.in[I_WK] + (size_t)l * D * D; gain = p.in[I_GMEM] + l * D; WT = (bf16*)(wl + WO_KV); }
        else if ((r -= I_SQ) < I_SQ) { W = p.in[I_WV] + (size_t)l * D * D; gain = p.in[I_GMEM] + l * D; WT = (bf16*)(wl + WO_KV); off = 1024; }
        else if ((r -= I_SQ) < I_SQ) { W = p.in[I_WO] + (size_t)l * D * D; WT = (bf16*)(wl + WO_O); }
        else if ((r -= I_SQ) < I_GU) { W = p.in[I_WG] + (size_t)l * D * DFF; gain = p.in[I_GFFN] + l * D; WT = (bf16*)(wl + WO_GU); N = DFF; mode = 1; }
        else if ((r -= I_GU) < I_GU) { W = p.in[I_WU] + (size_t)l * D * DFF; gain = p.in[I_GFFN] + l * D; WT = (bf16*)(wl + WO_GU); N = DFF; mode = 2; }
        else { r -= I_GU; W = p.in[I_WD] + (size_t)l * DFF * D; WT = (bf16*)(wl + WO_D); K = DFF; }
        const int nblk = N / 64, kb = r / nblk, nb = r % nblk, k0 = 64 * kb, n0 = 64 * nb;
        int dst0 = n0 + off;
        if (mode) dst0 = (n0 >> 7) * 256 + (n0 & 127) + (mode == 2 ? 128 : 0);
        transpose_item(W, K, N, gain, WT, dst0, scr, k0, n0, lane);
    }
}
__device__ __forceinline__ void prologue(CParams& p, LAS unsigned char* lds) {
    const int tid = otid(), lane = tid & 63, wave = tid >> 6;
    const int gw = blockIdx.x * NWAVES + wave, NGW = gridDim.x * NWAVES;
    unsigned char* ws = p.ws;
    weight_items(p, lds, 0, gw, NGW, wave, lane);
    bf16* XB = (bf16*)(ws + WS_XB); float* SSQ = (float*)(ws + WS_SSQ); float* SSQM = (float*)(ws + WS_SSQM); bf16* MEMB = (bf16*)(ws + WS_MEMB);
    for (int m = gw; m < T + MROWS; m += NGW) {
        const bool ismem = m >= T; const int mr = ismem ? m - T : m;
        const float* src = ismem ? p.in[I_MEM] + (size_t)mr * D : (m < TP ? p.in[I_XP] + (size_t)m * D : p.in[I_XS] + (size_t)(m - TP) * D);
        const f32x4* xr = (const f32x4*)src + lane; f32x4 v[4]; float s = 0.f;
#pragma unroll
        for (int j = 0; j < 4; ++j) { v[j] = __builtin_nontemporal_load(xr + 64 * j); s += (v[j].x * v[j].x + v[j].y * v[j].y) + (v[j].z * v[j].z + v[j].w * v[j].w); }
        s = wave_sum(s);
        bf16* ob = ismem ? MEMB + (size_t)mr * D : XB + (size_t)m * D;
        unsigned long long* o8 = (unsigned long long*)ob + lane;
#pragma unroll
        for (int j = 0; j < 4; ++j) o8[64 * j] = (unsigned long long)pk2(v[j].x, v[j].y) | ((unsigned long long)pk2(v[j].z, v[j].w) << 32);
        if (!ismem) { if (lane == 0) SSQ[m] = s; }
        else if (lane == 0) SSQM[mr] = s;
    }
    for (int i = blockIdx.x * NTHREADS + tid; i < 6 * T; i += gridDim.x * NTHREADS) SSQ[T + i] = 0.f;
    bf16* RGW = (bf16*)(ws + WS_RGW);
    for (int i = blockIdx.x * NTHREADS + tid; i < 2 * 2 * 8 * 64 * 64; i += gridDim.x * NTHREADS) {
        const int l = i >> 16, g = (i >> 15) & 1, h = (i >> 12) & 7, j = (i >> 6) & 63, ii = i & 63;
        const float* src = (g ? p.in[I_WX] : p.in[I_WA]) + (size_t)((l * 8 + h) * 64 + ii) * 64 + j;
        RGW[i] = (bf16)f2bf(*src);
    }
    float* SP8 = (float*)(ws + WS_SP8);
    for (int i = blockIdx.x * NTHREADS + tid; i < 2 * DR; i += gridDim.x * NTHREADS) SP8[i] = -8.0f * softplusf_(-p.in[I_LAM][i]);
}

__device__ __forceinline__ void conf_prompt_pair(CParams& p, int l, int b, int ck0, LAS unsigned char* lds) {
    const int tid = otid(), lane = tid & 63, wave = tid >> 6, c = tid;
    const bf16* U = (const bf16*)(p.ws + WS_U); bf16* YM = (bf16*)(p.ws + WS_YM);
    LAS float* cO = (LAS float*)lds;
    const size_t rowb = (size_t)b * SEQ;
    const float* wp = p.in[I_CFW] + (size_t)l * 31 * DC + c; const float bias = p.in[I_CFB][l * DC + c];
    float w[31];
#pragma unroll
    for (int j = 0; j < 31; ++j) w[j] = wp[j * DC];
    const f32x4* gp = (const f32x4*)(p.in[I_LNG] + l * DC + lane * 8); const f32x4* bp = (const f32x4*)(p.in[I_LNB] + l * DC + lane * 8);
    const f32x4 g0 = gp[0], g1 = gp[1], b0 = bp[0], b1 = bp[1];
#pragma unroll 1
    for (int ck = ck0; ck < ck0 + 2; ++ck) {
    const int t0 = ck * 32;
    LAS float* cL = (LAS float*)lds;
#pragma unroll 1
    for (int i0 = 0; i0 < 8; i0 += 4) {
        u32x4 va[4], vg[4];
#pragma unroll
        for (int i = 0; i < 4; ++i) { const int r = wave + 8 * (i0 + i), t = t0 - 30 + r; va[i] = (u32x4){0u, 0u, 0u, 0u}; vg[i] = va[i];
            if (r < 62 && t >= 0) { const bf16* up = U + (rowb + t) * DIN + lane * 8; va[i] = *(const u32x4*)(up + 1024); vg[i] = *(const u32x4*)(up + 1536); } }
#pragma unroll
        for (int i = 0; i < 4; ++i) { const int r = wave + 8 * (i0 + i);
            if (r < 62) { f32x4 c0, c1;
                c0.x = bflo(va[i].x) * sigmoidf_(bflo(vg[i].x)); c0.y = bfhi(va[i].x) * sigmoidf_(bfhi(vg[i].x)); c0.z = bflo(va[i].y) * sigmoidf_(bflo(vg[i].y)); c0.w = bfhi(va[i].y) * sigmoidf_(bfhi(vg[i].y));
                c1.x = bflo(va[i].z) * sigmoidf_(bflo(vg[i].z)); c1.y = bfhi(va[i].z) * sigmoidf_(bfhi(vg[i].z)); c1.z = bflo(va[i].w) * sigmoidf_(bflo(vg[i].w)); c1.w = bfhi(va[i].w) * sigmoidf_(bfhi(vg[i].w));
                *(LAS f32x4*)(cL + r * 512 + lane * 8) = c0; *(LAS f32x4*)(cL + r * 512 + lane * 8 + 4) = c1;
                if (ck == 63 && r >= 32) { float* op = p.out + O_PCF + ((size_t)(l * NB + b) * 30 + (r - 32)) * DC + lane * 8; *(f32x4*)op = c0; *(f32x4*)(op + 4) = c1; } } }
    }
    __syncthreads();
#pragma unroll 1
    for (int t4 = 0; t4 < 32; t4 += 4) { float a0 = bias, a1 = bias, a2 = bias, a3 = bias; const LAS float* cp = cL + t4 * 512 + c;
#pragma unroll
        for (int j = 0; j < 34; ++j) { const float v = cp[j * 512];
            if (j < 31) a0 += w[j] * v;
            if (j >= 1 && j < 32) a1 += w[j - 1] * v;
            if (j >= 2 && j < 33) a2 += w[j - 2] * v;
            if (j >= 3) a3 += w[j - 3] * v; }
        cO[(t4 + 0) * 512 + c] = a0; cO[(t4 + 1) * 512 + c] = a1; cO[(t4 + 2) * 512 + c] = a2; cO[(t4 + 3) * 512 + c] = a3; }
    __syncthreads();
#pragma unroll
    for (int i = 0; i < 4; ++i) { const int t = wave + 8 * i;
        const f32x4 x0 = *(const LAS f32x4*)(cO + t * 512 + lane * 8), x1 = *(const LAS f32x4*)(cO + t * 512 + lane * 8 + 4);
        const float mean = wave_sum((x0.x + x0.y) + (x0.z + x0.w) + (x1.x + x1.y) + (x1.z + x1.w)) * (1.0f / 512.0f);
        const f32x4 d0 = x0 - mean, d1 = x1 - mean;
        const float var = wave_sum((d0.x * d0.x + d0.y * d0.y) + (d0.z * d0.z + d0.w * d0.w) + (d1.x * d1.x + d1.y * d1.y) + (d1.z * d1.z + d1.w * d1.w)) * (1.0f / 512.0f);
        const float rs = rsqrtf(var + EPS);
        f32x4 y0 = d0 * rs * g0 + b0, y1 = d1 * rs * g1 + b1;
#pragma unroll
        for (int j = 0; j < 4; ++j) { y0[j] = y0[j] * sigmoidf_(y0[j]); y1[j] = y1[j] * sigmoidf_(y1[j]); }
        u32x4 o; o.x = pk2(y0.x, y0.y); o.y = pk2(y0.z, y0.w); o.z = pk2(y1.x, y1.y); o.w = pk2(y1.z, y1.w);
        *(u32x4*)(YM + (rowb + t0 + t) * D + 512 + lane * 8) = o; }
    __syncthreads();
    }
}

__device__ __forceinline__ void sample_mixer_item(CParams& p, int l, int sb, LAS unsigned char* lds, const bool conf_part) {
    const int tid = otid(), lane = tid & 63, wave = tid >> 6, c = tid;
    const bf16* U = (const bf16*)(p.ws + WS_U); bf16* YM = (bf16*)(p.ws + WS_YM);
    LAS float* xcS = (LAS float*)lds;
    LAS float* cS = (LAS float*)(lds + 8192);
    const size_t row0 = (size_t)TP + sb * SS;
    if (!conf_part) {
    float xp[7];
    { const float* st = p.in[I_SRG] + ((size_t)(l * SB + sb) * 3) * DR + c; xp[0] = st[0]; xp[1] = st[DR]; xp[2] = st[2 * DR]; }
    float gr[4];
#pragma unroll
    for (int t = 0; t < 4; ++t) { const bf16* up = U + (row0 + t) * DIN; xp[3 + t] = bf2f(up[c]); gr[t] = bf2f(up[512 + c]); }
#pragma unroll
    for (int j = 0; j < 3; ++j) p.out[O_SRG + ((size_t)(l * SB + sb) * 3 + j) * DR + c] = xp[4 + j];
    float xc[4];
    { const float* cw = p.in[I_RGCW] + (size_t)l * 4 * DR + c; const float w0 = cw[0], w1 = cw[DR], w2 = cw[2 * DR], w3 = cw[3 * DR], bc = p.in[I_RGCB][l * DR + c];
#pragma unroll
      for (int t = 0; t < 4; ++t) { xc[t] = bc + w0 * xp[t] + w1 * xp[t + 1] + w2 * xp[t + 2] + w3 * xp[t + 3]; xcS[t * 512 + c] = xc[t]; } }
    __syncthreads();
    float ra[4], ia[4];
    {
        const int h = wave, fr = lane & 15, fq = lane >> 4;
        LAS float* gS = (LAS float*)(lds + 16384);
        const bf16* RGW = (const bf16*)(p.ws + WS_RGW) + (size_t)(l * 2) * 8 * 4096;
        bf16x8 xf[2];
#pragma unroll
        for (int ks = 0; ks < 2; ++ks) { u32x4 w = (u32x4){0u, 0u, 0u, 0u};
            if (fr < 4) { const LAS float* xp4 = xcS + fr * 512 + h * 64 + 32 * ks + 8 * fq; const f32x4 a0 = *(const LAS f32x4*)xp4, a1 = *(const LAS f32x4*)(xp4 + 4);
                w.x = pk2(a0.x, a0.y); w.y = pk2(a0.z, a0.w); w.z = pk2(a1.x, a1.y); w.w = pk2(a1.z, a1.w); }
            xf[ks] = __builtin_bit_cast(bf16x8, w); }
#pragma unroll
        for (int ct = 0; ct < 4; ++ct)
#pragma unroll
            for (int g = 0; g < 2; ++g) { const bf16* wpt = RGW + (size_t)((g * 8 + h) * 64 + 16 * ct + fr) * 64 + 8 * fq;
                const bf16x8 w0 = *(const bf16x8*)wpt, w1 = *(const bf16x8*)(wpt + 32);
                f32x4 acc = {0.f, 0.f, 0.f, 0.f};
                acc = __builtin_amdgcn_mfma_f32_16x16x32_bf16(xf[0], w0, acc, 0, 0, 0); acc = __builtin_amdgcn_mfma_f32_16x16x32_bf16(xf[1], w1, acc, 0, 0, 0);
                if (fq == 0) {
#pragma unroll
                    for (int e = 0; e < 4; ++e) gS[(g * 4 + e) * 512 + h * 64 + 16 * ct + fr] = acc[e]; } }
        __syncthreads();
        const float ba = p.in[I_BA][l * DR + c], bx = p.in[I_BX][l * DR + c];
#pragma unroll
        for (int t = 0; t < 4; ++t) { ra[t] = gS[t * 512 + c] + ba; ia[t] = gS[(4 + t) * 512 + c] + bx; } }
    { const float sp8 = ((const float*)(p.ws + WS_SP8))[l * DR + c];
      float hs = p.in[I_SH][(size_t)(l * SB + sb) * DR + c];
#pragma unroll
      for (int t = 0; t < 4; ++t) { const float r = sigmoidf_(ra[t]), ig = sigmoidf_(ia[t]); float a, mult; lru_coef(sp8 * r, a, mult);
          hs = a * hs + mult * (ig * xc[t]);
          YM[(row0 + t) * D + c] = (bf16)f2bf(hs * gelu_tanh(gr[t])); }
      p.out[O_SH + (size_t)(l * SB + sb) * DR + c] = hs; }
    __syncthreads();
    return; }
    { float cp[34];
      const float* st = p.in[I_SCF] + ((size_t)(l * SB + sb) * 30) * DC + c;
#pragma unroll
      for (int j = 0; j < 30; ++j) cp[j] = __builtin_nontemporal_load(st + j * DC);
#pragma unroll
      for (int t = 0; t < 4; ++t) { const bf16* up = U + (row0 + t) * DIN; cp[30 + t] = bf2f(up[1024 + c]) * sigmoidf_(bf2f(up[1536 + c])); }
#pragma unroll
      for (int j = 0; j < 30; ++j) __builtin_nontemporal_store(cp[4 + j], p.out + O_SCF + ((size_t)(l * SB + sb) * 30 + j) * DC + c);
      const float* wp = p.in[I_CFW] + (size_t)l * 31 * DC + c; const float bias = p.in[I_CFB][l * DC + c];
      float a4[4] = {bias, bias, bias, bias};
#pragma unroll
      for (int j = 0; j < 31; ++j) { const float w = wp[j * DC];
#pragma unroll
          for (int t = 0; t < 4; ++t) a4[t] += w * cp[t + j]; }
#pragma unroll
      for (int t = 0; t < 4; ++t) cS[t * 512 + c] = a4[t]; }
    __syncthreads();
    if (wave < 4) { const int t = wave;
        const f32x4* gp = (const f32x4*)(p.in[I_LNG] + l * DC + lane * 8); const f32x4* bp = (const f32x4*)(p.in[I_LNB] + l * DC + lane * 8);
        const f32x4 g0 = gp[0], g1 = gp[1], b0 = bp[0], b1 = bp[1];
        const f32x4 x0 = *(const LAS f32x4*)(cS + t * 512 + lane * 8), x1 = *(const LAS f32x4*)(cS + t * 512 + lane * 8 + 4);
        const float mean = wave_sum((x0.x + x0.y) + (x0.z + x0.w) + (x1.x + x1.y) + (x1.z + x1.w)) * (1.0f / 512.0f);
        const f32x4 d0 = x0 - mean, d1 = x1 - mean;
        const float var = wave_sum((d0.x * d0.x + d0.y * d0.y) + (d0.z * d0.z + d0.w * d0.w) + (d1.x * d1.x + d1.y * d1.y) + (d1.z * d1.z + d1.w * d1.w)) * (1.0f / 512.0f);
        const float rs = rsqrtf(var + EPS);
        f32x4 y0 = d0 * rs * g0 + b0, y1 = d1 * rs * g1 + b1;
#pragma unroll
        for (int j = 0; j < 4; ++j) { y0[j] = y0[j] * sigmoidf_(y0[j]); y1[j] = y1[j] * sigmoidf_(y1[j]); }
        u32x4 o; o.x = pk2(y0.x, y0.y); o.y = pk2(y0.z, y0.w); o.z = pk2(y1.x, y1.y); o.w = pk2(y1.z, y1.w);
        *(u32x4*)(YM + (row0 + t) * D + 512 + lane * 8) = o; }
    __syncthreads();
}

constexpr int GR_OFF = 69632, CARRY_OFF = 137216;
constexpr int XC_PITCH = 1040;
struct RgState { float Hl[4][4][4]; float Pl[4][4][4]; };

__device__ __forceinline__ void rglru_part1(CParams& p, int l, int b, int k, LAS unsigned char* lds, RgState& S) {
    const int tid = otid(), lane = tid & 63, h = tid >> 6, fr = lane & 15, fq = lane >> 4;
    const bf16* U = (const bf16*)(p.ws + WS_U);
    {
        const int wave = h; const size_t row = (size_t)b * SEQ + k * 64;
        u32x4 xr[11];
#pragma unroll
        for (int i = 0; i < 11; ++i) { const int t = 8 * wave - 3 + i; xr[i] = (u32x4){0u, 0u, 0u, 0u};
            if (k > 0 || t >= 0) xr[i] = *(const u32x4*)(U + (row + t) * DIN + lane * 8); }
        u32x4 gq[8];
#pragma unroll
        for (int i = 0; i < 8; ++i) { const int idx = tid + 512 * i; gq[i] = *(const u32x4*)(U + (row + (idx >> 6)) * DIN + 512 + (idx & 63) * 8); }
        const float* cw = p.in[I_RGCW] + (size_t)l * 4 * DR + lane * 8; const float* cb = p.in[I_RGCB] + l * DR + lane * 8;
        float wj[4][8], bc[8];
#pragma unroll
        for (int j = 0; j < 4; ++j) { const f32x4 a0 = *(const f32x4*)(cw + j * DR), a1 = *(const f32x4*)(cw + j * DR + 4);
            wj[j][0] = a0.x; wj[j][1] = a0.y; wj[j][2] = a0.z; wj[j][3] = a0.w; wj[j][4] = a1.x; wj[j][5] = a1.y; wj[j][6] = a1.z; wj[j][7] = a1.w; }
        { const f32x4 a0 = *(const f32x4*)cb, a1 = *(const f32x4*)(cb + 4); bc[0] = a0.x; bc[1] = a0.y; bc[2] = a0.z; bc[3] = a0.w; bc[4] = a1.x; bc[5] = a1.y; bc[6] = a1.z; bc[7] = a1.w; }
#pragma unroll
        for (int tt = 0; tt < 8; ++tt) { float o[8];
#pragma unroll
            for (int e = 0; e < 8; ++e) { float a = bc[e];
#pragma unroll
                for (int j = 0; j < 4; ++j) { const unsigned wv = xr[tt + j][e >> 1]; a += wj[j][e] * ((e & 1) ? bfhi(wv) : bflo(wv)); }
                o[e] = a; }
            u32x4 w; w.x = pk2(o[0], o[1]); w.y = pk2(o[2], o[3]); w.z = pk2(o[4], o[5]); w.w = pk2(o[6], o[7]);
            *(LAS u32x4*)(lds + (8 * wave + tt) * XC_PITCH + lane * 16) = w; }
        if (k == 31 && wave == 7) {
#pragma unroll
            for (int j = 0; j < 3; ++j) { const u32x4 wv = xr[8 + j]; float* op = p.out + O_PRG + ((size_t)(l * NB + b) * 3 + j) * DR + lane * 8;
                *(f32x4*)op = (f32x4){bflo(wv.x), bfhi(wv.x), bflo(wv.y), bfhi(wv.y)}; *(f32x4*)(op + 4) = (f32x4){bflo(wv.z), bfhi(wv.z), bflo(wv.w), bfhi(wv.w)}; } }
#pragma unroll
        for (int i = 0; i < 8; ++i) { const int idx = tid + 512 * i; *(LAS u32x4*)(lds + GR_OFF + (idx >> 6) * 1024 + (idx & 63) * 16) = gq[i]; }
    }
    __syncthreads();
    const bf16* RGW = (const bf16*)(p.ws + WS_RGW) + (size_t)(l * 2) * 8 * 4096;
    float2* AGG = (float2*)(p.ws + WS_AGG);
#pragma unroll
    for (int ct = 0; ct < 4; ++ct) {
        const int c = h * 64 + 16 * ct + fr;
        bf16x8 wf[2][2];
#pragma unroll
        for (int g = 0; g < 2; ++g)
#pragma unroll
            for (int ks = 0; ks < 2; ++ks) wf[g][ks] = *(const bf16x8*)(RGW + (size_t)((g * 8 + h) * 64 + 16 * ct + fr) * 64 + 32 * ks + 8 * fq);
        const float ba = p.in[I_BA][l * DR + c], bx = p.in[I_BX][l * DR + c], sp8 = ((const float*)(p.ws + WS_SP8))[l * DR + c];
        float Ac = 1.f, Bc = 0.f;
#pragma unroll
        for (int tt = 0; tt < 4; ++tt) {
            const bf16x8 xf0 = *(const LAS bf16x8*)(lds + (16 * tt + fr) * XC_PITCH + (h * 64 + 8 * fq) * 2);
            const bf16x8 xf1 = *(const LAS bf16x8*)(lds + (16 * tt + fr) * XC_PITCH + (h * 64 + 32 + 8 * fq) * 2);
            f32x4 racc = {0.f, 0.f, 0.f, 0.f}, iacc = {0.f, 0.f, 0.f, 0.f};
            racc = __builtin_amdgcn_mfma_f32_16x16x32_bf16(xf0, wf[0][0], racc, 0, 0, 0); racc = __builtin_amdgcn_mfma_f32_16x16x32_bf16(xf1, wf[0][1], racc, 0, 0, 0);
            iacc = __builtin_amdgcn_mfma_f32_16x16x32_bf16(xf0, wf[1][0], iacc, 0, 0, 0); iacc = __builtin_amdgcn_mfma_f32_16x16x32_bf16(xf1, wf[1][1], iacc, 0, 0, 0);
            float hq = 0.f, pq = 1.f;
#pragma unroll
            for (int e = 0; e < 4; ++e) { const float xcv = bf2f(*(const LAS bf16*)(lds + (16 * tt + 4 * fq + e) * XC_PITCH + c * 2));
                const float r = sigmoidf_(racc[e] + ba), ig = sigmoidf_(iacc[e] + bx); float a, mult; lru_coef(sp8 * r, a, mult);
                hq = a * hq + mult * (ig * xcv); pq *= a; S.Hl[ct][tt][e] = hq; S.Pl[ct][tt][e] = pq; }
            float Ai = pq, Bi = hq;
            { const float A1 = __shfl_up(Ai, 16), B1 = __shfl_up(Bi, 16); if (fq >= 1) { Bi = Ai * B1 + Bi; Ai = A1 * Ai; } }
            { const float A2 = __shfl_up(Ai, 32), B2 = __shfl_up(Bi, 32); if (fq >= 2) { Bi = Ai * B2 + Bi; Ai = A2 * Ai; } }
            float Ae = __shfl_up(Ai, 16), Be = __shfl_up(Bi, 16); if (fq == 0) { Ae = 1.f; Be = 0.f; }
            const float Ap = Ac * Ae, Bp = Ae * Bc + Be;
#pragma unroll
            for (int e = 0; e < 4; ++e) { S.Hl[ct][tt][e] += S.Pl[ct][tt][e] * Bp; S.Pl[ct][tt][e] *= Ap; }
            const float At = __shfl(Ai, 48 + fr), Bt = __shfl(Bi, 48 + fr);
            Bc = At * Bc + Bt; Ac = Ac * At;
            asm volatile("" ::: "memory");
        }
        if (fq == 0) AGG[(size_t)(b * 32 + k) * DR + c] = make_float2(Ac, Bc);
    }
}
__device__ __forceinline__ void rglru_part2(CParams& p, int l, int b, int k, LAS unsigned char* lds, const RgState& S) {
    const int tid = otid(), lane = tid & 63, h = tid >> 6, fr = lane & 15, fq = lane >> 4;
    bf16* YM = (bf16*)(p.ws + WS_YM);
    const float2* AGG = (const float2*)(p.ws + WS_AGG);
    { float carry = 0.f; const float2* ap = AGG + (size_t)(b * 32) * DR + tid;
#pragma unroll 1
        for (int k0 = 0; k0 < k; k0 += 16) { float2 ab[16];
#pragma unroll
            for (int kk = 0; kk < 16; ++kk) { ab[kk] = make_float2(1.f, 0.f); if (k0 + kk < k) ab[kk] = ap[(size_t)(k0 + kk) * DR]; }
#pragma unroll
            for (int kk = 0; kk < 16; ++kk) carry = ab[kk].x * carry + ab[kk].y; }
        *(LAS float*)(lds + CARRY_OFF + tid * 4) = carry; }
    __syncthreads();
#pragma unroll
    for (int ct = 0; ct < 4; ++ct) {
        const int c = h * 64 + 16 * ct + fr; const float carry = *(const LAS float*)(lds + CARRY_OFF + c * 4);
#pragma unroll
        for (int tt = 0; tt < 4; ++tt)
#pragma unroll
            for (int e = 0; e < 4; ++e) { const float hv = S.Hl[ct][tt][e] + S.Pl[ct][tt][e] * carry;
                LAS bf16* gp = (LAS bf16*)(lds + GR_OFF + (16 * tt + 4 * fq + e) * 1024 + c * 2);
                *gp = (bf16)f2bf(hv * gelu_tanh(bf2f(*gp)));
                if (k == 31 && tt == 3 && e == 3 && fq == 3) p.out[O_PH + (size_t)(l * NB + b) * DR + c] = hv; }
    }
    __syncthreads();
    const size_t row = (size_t)b * SEQ + k * 64;
#pragma unroll
    for (int i = 0; i < 8; ++i) { const int idx = tid + 512 * i; *(u32x4*)(YM + (row + (idx >> 6)) * D + (idx & 63) * 8) = *(const LAS u32x4*)(lds + GR_OFF + (idx >> 6) * 1024 + (idx & 63) * 16); }
}

__device__ __forceinline__ void attn_prompt_unit(CParams& p, int l, int b, int h, int qb, LAS unsigned char* lds) {
    const int tid = otid(), lane = tid & 63, wave = tid >> 6, r32 = lane & 31, half = lane >> 5;
    const bf16* QB = (const bf16*)(p.ws + WS_QB); bf16* OB = (bf16*)(p.ws + WS_YM);
    const bf16* KB = (const bf16*)(p.ws + WS_KB) + (size_t)l * MROWS * D; const bf16* VT = (const bf16*)(p.ws + WS_VT) + (size_t)l * MROWS * D;
#pragma unroll 8
    for (int i = 0; i < 16; ++i) { const int idx = tid + 512 * i, key = idx >> 5, ch = idx & 31;
        const u32x4 v = *(const u32x4*)(KB + (size_t)(b * NMEM + key) * D + h * HD + ch * 8);
        *(LAS u32x4*)(lds + key * 512 + ((ch ^ (key & 31)) << 4)) = v; }
    const size_t qrow = (size_t)b * SEQ + qb * 256 + wave * 32 + r32;
    const bf16* qp = QB + qrow * D + h * HD + 8 * half;
    bf16x8 qf[8];
#pragma unroll
    for (int ks = 0; ks < 8; ++ks) qf[ks] = *(const bf16x8*)(qp + ks * 16);
    __syncthreads();
    f32x16 acc[8];
#pragma unroll
    for (int kb = 0; kb < 8; ++kb)
#pragma unroll
        for (int j = 0; j < 16; ++j) acc[kb][j] = 0.f;
#pragma unroll
    for (int kh = 0; kh < 2; ++kh) {
#pragma unroll
        for (int k8 = 0; k8 < 8; ++k8) { const int ks = kh * 8 + k8;
#pragma unroll
            for (int kb = 0; kb < 8; ++kb) { const int key = 32 * kb + r32;
                const bf16x8 a = *(const LAS bf16x8*)(lds + key * 512 + (((2 * ks + half) ^ r32) << 4));
                acc[kb] = __builtin_amdgcn_mfma_f32_32x32x16_bf16(a, qf[k8], acc[kb], 0, 0, 0); }
            if (kh == 0) qf[k8] = *(const bf16x8*)(qp + (8 + k8) * 16); }
    }
    float mx = -3.0e38f;
#pragma unroll
    for (int kb = 0; kb < 8; ++kb)
#pragma unroll
        for (int j = 0; j < 16; ++j) mx = fmaxf(mx, acc[kb][j]);
    mx = fmaxf(mx, __shfl_xor(mx, 32));
    float sum = 0.f;
#pragma unroll
    for (int kb = 0; kb < 8; ++kb)
#pragma unroll
        for (int j = 0; j < 16; ++j) { const float e = __builtin_amdgcn_exp2f(acc[kb][j] - mx); acc[kb][j] = e; sum += e; }
    sum += __shfl_xor(sum, 32);
    const float inv = 1.0f / sum;
    bf16x8 pf[8][2];
#pragma unroll
    for (int kb = 0; kb < 8; ++kb)
#pragma unroll
        for (int jj = 0; jj < 2; ++jj) { u32x4 w; w.x = pk2(acc[kb][8 * jj + 0], acc[kb][8 * jj + 1]); w.y = pk2(acc[kb][8 * jj + 2], acc[kb][8 * jj + 3]);
            w.z = pk2(acc[kb][8 * jj + 4], acc[kb][8 * jj + 5]); w.w = pk2(acc[kb][8 * jj + 6], acc[kb][8 * jj + 7]); pf[kb][jj] = __builtin_bit_cast(bf16x8, w); }
    __syncthreads();
#pragma unroll 8
    for (int i = 0; i < 16; ++i) { const int idx = tid + 512 * i, d = idx >> 5, ch = idx & 31;
        const u32x4 v = *(const u32x4*)(VT + ((size_t)((b * NH + h) * HD + d)) * NMEM + ch * 8);
        const int c8 = 2 * ch; u32x2 lo; lo.x = v.x; lo.y = v.y; u32x2 hi; hi.x = v.z; hi.y = v.w;
        *(LAS u32x2*)(lds + d * 512 + ((c8 ^ (d & 63)) << 3)) = lo; *(LAS u32x2*)(lds + d * 512 + (((c8 + 1) ^ (d & 63)) << 3)) = hi; }
    __syncthreads();
    LAS unsigned char* st = lds + 131072 + wave * 2304;
    const size_t orow0 = (size_t)b * SEQ + qb * 256 + wave * 32;
#pragma unroll
    for (int db = 0; db < 8; ++db) {
        f32x16 o;
#pragma unroll
        for (int j = 0; j < 16; ++j) o[j] = 0.f;
        const int dim = 32 * db + r32;
#pragma unroll
        for (int kb = 0; kb < 8; ++kb)
#pragma unroll
            for (int jj = 0; jj < 2; ++jj) { const int c8 = 8 * kb + 4 * jj + half;
                const u32x2 lo = *(const LAS u32x2*)(lds + dim * 512 + ((c8 ^ (dim & 63)) << 3)), hi = *(const LAS u32x2*)(lds + dim * 512 + (((c8 + 2) ^ (dim & 63)) << 3));
                u32x4 w; w.x = lo.x; w.y = lo.y; w.z = hi.x; w.w = hi.y;
                o = __builtin_amdgcn_mfma_f32_32x32x16_bf16(__builtin_bit_cast(bf16x8, w), pf[kb][jj], o, 0, 0, 0); }
#pragma unroll
        for (int g = 0; g < 4; ++g) { u32x2 w; w.x = pk2(o[4 * g] * inv, o[4 * g + 1] * inv); w.y = pk2(o[4 * g + 2] * inv, o[4 * g + 3] * inv);
            *(LAS u32x2*)(st + r32 * 72 + g * 16 + half * 8) = w; }
        asm volatile("s_waitcnt lgkmcnt(0)" ::: "memory");
#pragma unroll
        for (int i = 0; i < 2; ++i) { const int q = 16 * i + (lane >> 2), c = lane & 3;
            const u32x2 v0 = *(const LAS u32x2*)(st + q * 72 + c * 16), v1 = *(const LAS u32x2*)(st + q * 72 + c * 16 + 8);
            u32x4 v; v.x = v0.x; v.y = v0.y; v.z = v1.x; v.w = v1.y;
            *(u32x4*)(OB + (orow0 + q) * D + h * HD + 32 * db + 8 * c) = v; }
        asm volatile("s_waitcnt lgkmcnt(0)" ::: "memory");
    }
    __syncthreads();
}

__device__ __forceinline__ void attn_sample_unit(CParams& p, int l, int sb, int h, LAS unsigned char* lds) {
    const int tid = otid(), lane = tid & 63, wave = tid >> 6;
    const bf16* QB = (const bf16*)(p.ws + WS_QB); bf16* OB = (bf16*)(p.ws + WS_YM);
    const float* CK = p.in[I_CK] + ((size_t)(l * SB + sb) * NMEM) * D + h * HD; const float* CV = p.in[I_CV] + ((size_t)(l * SB + sb) * NMEM) * D + h * HD;
    LAS f32x4* sc = (LAS f32x4*)lds;
    LAS float* red = (LAS float*)(lds + 8192);
    const size_t row0 = (size_t)TP + sb * SS;
    {
        const int ksub = lane >> 4, dseg = lane & 15;
        f32x4 q[4][4];
#pragma unroll
        for (int t = 0; t < 4; ++t)
#pragma unroll
            for (int jj = 0; jj < 4; ++jj) { const u32x2 w = *(const u32x2*)(QB + (row0 + t) * D + h * HD + jj * 64 + dseg * 4);
                q[t][jj] = (f32x4){bflo(w.x), bfhi(w.x), bflo(w.y), bfhi(w.y)}; }
#pragma unroll 4
        for (int it = 0; it < 8; ++it) { const int key = wave * 32 + it * 4 + ksub;
            f32x4 kv[4];
#pragma unroll
            for (int jj = 0; jj < 4; ++jj) kv[jj] = __builtin_nontemporal_load((const f32x4*)(CK + (size_t)key * D + jj * 64 + dseg * 4));
            float s[4];
#pragma unroll
            for (int t = 0; t < 4; ++t) { float a = 0.f;
#pragma unroll
                for (int jj = 0; jj < 4; ++jj) a += (kv[jj].x * q[t][jj].x + kv[jj].y * q[t][jj].y) + (kv[jj].z * q[t][jj].z + kv[jj].w * q[t][jj].w);
                a += __shfl_xor(a, 1); a += __shfl_xor(a, 2); a += __shfl_xor(a, 4); a += __shfl_xor(a, 8); s[t] = a; }
            if (dseg == 0) sc[key] = (f32x4){s[0], s[1], s[2], s[3]}; }
    }
    __syncthreads();
    if (wave < 4) { const int t = wave; float v[4]; float mx = -3.0e38f;
#pragma unroll
        for (int j = 0; j < 4; ++j) { v[j] = ((const LAS float*)lds)[(lane * 4 + j) * 4 + t]; mx = fmaxf(mx, v[j]); }
#pragma unroll
        for (int o = 1; o < 64; o <<= 1) mx = fmaxf(mx, __shfl_xor(mx, o));
        float sum = 0.f;
#pragma unroll
        for (int j = 0; j < 4; ++j) { v[j] = __builtin_amdgcn_exp2f(v[j] - mx); sum += v[j]; }
        sum = wave_sum(sum); const float inv = 1.0f / sum;
#pragma unroll
        for (int j = 0; j < 4; ++j) ((LAS float*)lds)[(lane * 4 + j) * 4 + t] = v[j] * inv; }
    __syncthreads();
    {
        f32x4 o[4];
#pragma unroll
        for (int t = 0; t < 4; ++t) o[t] = (f32x4){0.f, 0.f, 0.f, 0.f};
#pragma unroll 16
        for (int m = 0; m < 32; ++m) { const int key = wave * 32 + m; const f32x4 v = __builtin_nontemporal_load((const f32x4*)(CV + (size_t)key * D + lane * 4)); const f32x4 pr = sc[key];
            o[0] += v * pr.x; o[1] += v * pr.y; o[2] += v * pr.z; o[3] += v * pr.w; }
#pragma unroll
        for (int t = 0; t < 4; ++t) *(LAS f32x4*)(red + (wave * 4 + t) * 256 + lane * 4) = o[t];
    }
    __syncthreads();
    { const int t = tid >> 7, d2 = tid & 127; float a0 = 0.f, a1 = 0.f;
#pragma unroll
        for (int w = 0; w < 8; ++w) { const f32x2 v = *(const LAS f32x2*)(red + (w * 4 + t) * 256 + d2 * 2); a0 += v.x; a1 += v.y; }
        *(unsigned*)(OB + (row0 + t) * D + h * HD + d2 * 2) = pk2(a0, a1); }
    __syncthreads();
}

struct TailScale {
    bf16* O; int ldc; const float* ssq; float scale;
    typedef float Pre;
    __device__ __forceinline__ Pre prefetch(int row, int) const { return ssq[TP + row]; }
    __device__ __forceinline__ void operator()(int row, int col, f32x4 v, bool, Pre sq) const { const int gr = TP + row; const float r = rsqrtf(sq * (1.0f / 1024.0f) + EPS) * scale;
        u32x2 w; w.x = pk2(v.x * r, v.y * r); w.y = pk2(v.z * r, v.w * r); *(u32x2*)(O + (size_t)gr * ldc + col) = w; }
};
struct TailRes {
    bf16* XB; float* ssq_out;
    typedef u32x2 Pre;
    __device__ __forceinline__ Pre prefetch(int row, int col) const { return *(const u32x2*)(XB + (size_t)(TP + row) * D + col); }
    __device__ __forceinline__ void operator()(int row, int col, f32x4 v, bool lead, Pre xo) const { const size_t off = (size_t)(TP + row) * D + col;
        const f32x4 xn = (f32x4){bflo(xo.x), bfhi(xo.x), bflo(xo.y), bfhi(xo.y)} + v;
        u32x2 w; w.x = pk2(xn.x, xn.y); w.y = pk2(xn.z, xn.w); *(u32x2*)(XB + off) = w;
        float s = (xn.x * xn.x + xn.y * xn.y) + (xn.z * xn.z + xn.w * xn.w);
        s += __shfl_xor(s, 16); s += __shfl_xor(s, 32);
        if (lead) atomicAdd(ssq_out + TP + row, s); }
};
template <int CT, class Epi>
__device__ __forceinline__ void tail_gemm(const bf16* A, const bf16* Bt, int K, int N, LAS unsigned char* lds, const Epi& E) {
    const int tid = otid(), lane = tid & 63, wave = tid >> 6, fr = lane & 15, fq = lane >> 4;
    constexpr int NC = 16 * CT, TPW = CT / 2, KC = 256, PITCH = KC * 2 + 16, NB_ = NC / 16;
    const int npc = N / NC, nchunks = K / KC;
    LAS unsigned char* As = lds; LAS unsigned char* Bs = lds + 64 * PITCH;
    for (int pc = blockIdx.x; pc < 8 * npc; pc += gridDim.x) {
        const int row0 = (pc / npc) * 64, col0 = (pc % npc) * NC;
        typename Epi::Pre pre[TPW]; f32x4 acc[TPW];
#pragma unroll
        for (int j = 0; j < TPW; ++j) { const int t = wave * TPW + j, rt = t / CT, ct = t % CT; pre[j] = E.prefetch(row0 + 16 * rt + fr, col0 + 16 * ct + 4 * fq); acc[j] = (f32x4){0.f, 0.f, 0.f, 0.f}; }
        u32x4 ua[4], ub[NB_];
#pragma unroll
        for (int i = 0; i < 4; ++i) { const int idx = tid + 512 * i; ua[i] = *(const u32x4*)(A + (size_t)(row0 + (idx >> 5)) * K + (idx & 31) * 8); }
#pragma unroll
        for (int i = 0; i < NB_; ++i) { const int idx = tid + 512 * i; ub[i] = *(const u32x4*)(Bt + (size_t)(col0 + (idx >> 5)) * K + (idx & 31) * 8); }
#pragma unroll 1
        for (int kc = 0; kc < nchunks; ++kc) {
#pragma unroll
            for (int i = 0; i < 4; ++i) { const int idx = tid + 512 * i; *(LAS u32x4*)(As + (idx >> 5) * PITCH + (idx & 31) * 16) = ua[i]; }
#pragma unroll
            for (int i = 0; i < NB_; ++i) { const int idx = tid + 512 * i; *(LAS u32x4*)(Bs + (idx >> 5) * PITCH + (idx & 31) * 16) = ub[i]; }
            __syncthreads();
            if (kc + 1 < nchunks) {
#pragma unroll
                for (int i = 0; i < 4; ++i) { const int idx = tid + 512 * i; ua[i] = *(const u32x4*)(A + (size_t)(row0 + (idx >> 5)) * K + (kc + 1) * KC + (idx & 31) * 8); }
#pragma unroll
                for (int i = 0; i < NB_; ++i) { const int idx = tid + 512 * i; ub[i] = *(const u32x4*)(Bt + (size_t)(col0 + (idx >> 5)) * K + (kc + 1) * KC + (idx & 31) * 8); }
            }
#pragma unroll
            for (int ks = 0; ks < KC / 32; ++ks)
#pragma unroll
                for (int j = 0; j < TPW; ++j) { const int t = wave * TPW + j, rt = t / CT, ct = t % CT;
                    const bf16x8 af = *(const LAS bf16x8*)(As + (16 * rt + fr) * PITCH + (32 * ks + 8 * fq) * 2), bfv = *(const LAS bf16x8*)(Bs + (16 * ct + fr) * PITCH + (32 * ks + 8 * fq) * 2);
                    acc[j] = __builtin_amdgcn_mfma_f32_16x16x32_bf16(bfv, af, acc[j], 0, 0, 0); }
            __syncthreads();
        }
#pragma unroll
        for (int j = 0; j < TPW; ++j) { const int t = wave * TPW + j, rt = t / CT, ct = t % CT; E(row0 + 16 * rt + fr, col0 + 16 * ct + 4 * fq, acc[j], fq == 0, pre[j]); }
    }
}

constexpr int N_PHASES = 18;
__device__ __forceinline__ void phase_body(const int ph, CParams* p0, LAS unsigned char* lds, const XcdBarrier& bar) {
        CParams* pq = p0; asm volatile("" : "+s"(pq));
        CParams& p = *pq;
        unsigned char* ws = p.ws;
        bf16* XB = (bf16*)(ws + WS_XB); bf16* U = (bf16*)(ws + WS_U); bf16* YM = (bf16*)(ws + WS_YM); bf16* QB = (bf16*)(ws + WS_QB); bf16* HB = (bf16*)(ws + WS_H);
        float* SSQ = (float*)(ws + WS_SSQ); const int bx = blockIdx.x;
        if (ph == 0) { prologue(p, lds); return; }
        if (ph == N_PHASES - 1) {
            const int tdx = otid(), lane = tdx & 63, wave = tdx >> 6; const float* g = p.in[I_GFIN];
            for (int m = bx * NWAVES + wave; m < T; m += GRID * NWAVES) { const float rs = rsqrtf(SSQ[6 * T + m] * (1.0f / 1024.0f) + EPS);
                const u32x2* xr = (const u32x2*)(XB + (size_t)m * D) + lane; f32x4* yo = (f32x4*)(p.out + (size_t)m * D) + lane; const f32x4* gp = (const f32x4*)g + lane;
#pragma unroll
                for (int j = 0; j < 4; ++j) { const u32x2 w = xr[64 * j]; __builtin_nontemporal_store((f32x4){bflo(w.x), bfhi(w.x), bflo(w.y), bfhi(w.y)} * rs * gp[64 * j], yo + 64 * j); } }
            return;
        }
        const int l = (ph - 1) >> 3, sub = (ph - 1) & 7;
        unsigned char* wl = ws + WS_W + (size_t)l * W_LAYER;
        if (sub == 0) {
            { pg8::Gemm g{XB, (const bf16*)(wl + WO_IN), TP, DIN, D}; pg8::StaticOrder S; S.init(TP, DIN, GRID, bx);
              pg8::EpiScaleBf16 E{U, DIN, SSQ + (size_t)(3 * l) * T, 1.0f, 0};
              pg8::gemm_phase<pg8::EpiScaleBf16, pg8::StaticOrder, true, true>(lds, g, S, E); }
            if (l == 0) { pg8::Gemm g{(const bf16*)(ws + WS_MEMB), (const bf16*)(ws + WS_W + WO_KV), MROWS, 2048, D};
                pg8::StaticOrder S; S.init(MROWS, 2048, GRID, bx);
                pg8::EpiKV E{p.out + O_PMK, p.out + O_PMV, (bf16*)(ws + WS_KB), (bf16*)(ws + WS_VT), (const float*)(ws + WS_SSQM)};
                pg8::gemm_phase<pg8::EpiKV, pg8::StaticOrder, true, true>(lds, g, S, E); }
            if (l == 0) { if (bx >= 64) { const int td = otid(); weight_items(p, lds, 1, (bx - 64) * NWAVES + (td >> 6), (GRID - 64) * NWAVES, td >> 6, td & 63); }
                __syncthreads(); }
            { TailScale E{U, DIN, SSQ + (size_t)(3 * l) * T, 1.0f}; tail_gemm<4, TailScale>(XB + (size_t)TP * D, (const bf16*)(wl + WO_IN), D, DIN, lds, E);
#if defined(EXP_TAIL)
              tail_gemm<4, TailScale>(XB + (size_t)TP * D, (const bf16*)(wl + WO_IN), D, DIN, lds, E); tail_gemm<4, TailScale>(XB + (size_t)TP * D, (const bf16*)(wl + WO_IN), D, DIN, lds, E);
#endif
            }
        } else if (sub == 1) {
            const int b = bx >> 5, k = bx & 31;
            { TP_BEGIN(); conf_prompt_pair(p, l, b, 2 * k, lds); TP_END(5); }
            { TP_BEGIN(); sample_mixer_item(p, l, bx & (SB - 1), lds, bx >= SB); TP_END(6); }
            RgState S; { TP_BEGIN(); rglru_part1(p, l, b, k, lds, S); TP_END(7); }
            { TP_BEGIN(); xcd_barrier(bar); TP_END(8); }
            { TP_BEGIN(); rglru_part2(p, l, b, k, lds, S); TP_END(9); }
        } else if (sub == 2) {
            pg8::Gemm g{YM, (const bf16*)(wl + WO_OUT), TP, D, D}; pg8::StaticOrder S; S.init(TP, D, GRID, bx);
            pg8::EpiRes E{XB, SSQ + (size_t)(3 * l + 1) * T};
            pg8::gemm_phase<pg8::EpiRes, pg8::StaticOrder, true, true>(lds, g, S, E);
            TailRes ET{XB, SSQ + (size_t)(3 * l + 1) * T}; tail_gemm<2, TailRes>(YM + (size_t)TP * D, (const bf16*)(wl + WO_OUT), D, D, lds, ET);
        } else if (sub == 3) {
            pg8::Gemm g{XB, (const bf16*)(wl + WO_Q), TP, D, D}; pg8::StaticOrder S; S.init(TP, D, GRID, bx);
            pg8::EpiScaleBf16 E{QB, D, SSQ + (size_t)(3 * l + 1) * T, QSCALE, 0};
            pg8::gemm_phase<pg8::EpiScaleBf16, pg8::StaticOrder, true, true>(lds, g, S, E);
            TailScale ET{QB, D, SSQ + (size_t)(3 * l + 1) * T, QSCALE}; tail_gemm<2, TailScale>(XB + (size_t)TP * D, (const bf16*)(wl + WO_Q), D, D, lds, ET);
#if defined(EXP_TAIL)
            tail_gemm<2, TailScale>(XB + (size_t)TP * D, (const bf16*)(wl + WO_Q), D, D, lds, ET); tail_gemm<2, TailScale>(XB + (size_t)TP * D, (const bf16*)(wl + WO_Q), D, D, lds, ET);
#endif
        } else if (sub == 4) {
            if ((bx >> 3) & 1) { for (int u = bx; u < SB * NH; u += GRID) attn_sample_unit(p, l, u >> 2, u & 3, lds); }
            { TP_BEGIN(); for (int u = bx; u < NB * NH * 8; u += GRID) attn_prompt_unit(p, l, u >> 5, (u >> 3) & 3, u & 7, lds); TP_END(10); }
            { TP_BEGIN(); if (!((bx >> 3) & 1)) { for (int u = bx; u < SB * NH; u += GRID) attn_sample_unit(p, l, u >> 2, u & 3, lds); } TP_END(11); }
        } else if (sub == 5) {
            pg8::Gemm g{YM, (const bf16*)(wl + WO_O), TP, D, D}; pg8::StaticOrder S; S.init(TP, D, GRID, bx);
            pg8::EpiRes E{XB, SSQ + (size_t)(3 * l + 2) * T};
            pg8::gemm_phase<pg8::EpiRes, pg8::StaticOrder, true, true>(lds, g, S, E);
            TailRes ET{XB, SSQ + (size_t)(3 * l + 2) * T}; tail_gemm<2, TailRes>(YM + (size_t)TP * D, (const bf16*)(wl + WO_O), D, D, lds, ET);
        } else if (sub == 6) {
            { pg8::Gemm g{XB, (const bf16*)(wl + WO_GU), TP, 2 * DFF, D}; pg8::StaticOrder S; S.init(TP, 2 * DFF, GRID, bx);
              pg8::EpiGateUp E{HB, DFF, SSQ + (size_t)(3 * l + 2) * T, 0};
              pg8::gemm_phase<pg8::EpiGateUp, pg8::StaticOrder, true, true>(lds, g, S, E); }
            { pg8::Gemm g{XB + (size_t)TP * D, (const bf16*)(wl + WO_GU), TS, 2 * DFF, D}; pg8::StaticOrder S; S.init(TS, 2 * DFF, GRID, (bx + 128) & 255);
              pg8::EpiGateUp E{HB, DFF, SSQ + (size_t)(3 * l + 2) * T, TP};
              pg8::gemm_phase<pg8::EpiGateUp, pg8::StaticOrder, true, true>(lds, g, S, E); }
            if (l == 0) { pg8::Gemm g{(const bf16*)(ws + WS_MEMB), (const bf16*)(ws + WS_W + W_LAYER + WO_KV), MROWS, 2048, D};
                pg8::StaticOrder S; S.init(MROWS, 2048, GRID, (bx + 256 - 172) & 255);
                pg8::EpiKV E{p.out + O_PMK + (size_t)MROWS * D, p.out + O_PMV + (size_t)MROWS * D, (bf16*)(ws + WS_KB) + (size_t)MROWS * D, (bf16*)(ws + WS_VT) + (size_t)MROWS * D, (const float*)(ws + WS_SSQM)};
                pg8::gemm_phase<pg8::EpiKV, pg8::StaticOrder, true, true>(lds, g, S, E); }
        } else {
            pg8::Gemm g{HB, (const bf16*)(wl + WO_D), TP, D, DFF}; pg8::StaticOrder S; S.init(TP, D, GRID, bx);
            pg8::EpiRes E{XB, SSQ + (size_t)(3 * l + 3) * T};
            pg8::gemm_phase<pg8::EpiRes, pg8::StaticOrder, true, true>(lds, g, S, E);
            TailRes ET{XB, SSQ + (size_t)(3 * l + 3) * T}; tail_gemm<2, TailRes>(HB + (size_t)TP * DFF, (const bf16*)(wl + WO_D), DFF, D, lds, ET);
        }
}
__global__ void __launch_bounds__(NTHREADS, 2) hymba_fwd(Params p_formal) {
    extern __shared__ __attribute__((aligned(16))) unsigned char lds_raw[];
    LAS unsigned char* lds = (LAS unsigned char*)lds_raw;
    cg::grid_group grid = cg::this_grid();
    if (gridDim.x != GRID) return;
    CParams* p0 = (CParams*)__builtin_amdgcn_kernarg_segment_ptr();
    const int ph_lo = p0->ph_lo, ph_hi = p0->ph_hi;
    if (ph_lo < 0) grid.sync();
    if (threadIdx.x < 2) ((volatile LAS unsigned*)(lds + LDS_BARW))[threadIdx.x] = 0u;
    __syncthreads();
    const XcdBarrier bar = xcd_barrier_post((unsigned*)(p0->ws + WS_BAR), (volatile LAS unsigned*)(lds + LDS_BARW));
#ifndef EXP_SYNC
#define EXP_SYNC 0
#endif
#ifdef TSEL
    unsigned long long tacc0 = 0, tacc1 = 0, tacc2 = 0, tacc3 = 0, tacc4 = 0;
#define TCAT(PH) ((PH) == 0 ? 4 : (PH) == 17 ? 4 : (((PH) - 1) & 7) == 1 ? 2 : (((PH) - 1) & 7) == 4 ? 3 : 1)
#define RUN(PH) if (ph_lo <= (PH) && (PH) < ph_hi) { const unsigned long long t0_ = __builtin_amdgcn_s_memrealtime(); if ((PH) > ph_lo) { xcd_barrier(bar); } const unsigned long long t1_ = __builtin_amdgcn_s_memrealtime(); \
        phase_body((PH), p0, lds, bar); asm volatile("s_waitcnt vmcnt(0)" ::: "memory"); const unsigned long long t2_ = __builtin_amdgcn_s_memrealtime(); tacc0 += t1_ - t0_; \
        if (TCAT(PH) == 1) tacc1 += t2_ - t1_; if (TCAT(PH) == 2) tacc2 += t2_ - t1_; if (TCAT(PH) == 3) tacc3 += t2_ - t1_; if (TCAT(PH) == 4) tacc4 += t2_ - t1_; }
#else
#define RUN(PH) if (ph_lo <= (PH) && (PH) < ph_hi) { if ((PH) > ph_lo) { xcd_barrier(bar); if (EXP_SYNC) { xcd_barrier(bar); xcd_barrier(bar); } } phase_body((PH), p0, lds, bar); }
#endif
#define RUN2(PH) RUN(PH) if (ph_lo <= (PH) && (PH) < ph_hi) { xcd_barrier(bar); phase_body((PH), p0, lds, bar); }
#ifndef EXP_PRO
#define EXP_PRO 0
#endif
#ifndef EXP_MIX
#define EXP_MIX 0
#endif
#ifndef EXP_ATT
#define EXP_ATT 0
#endif
#ifndef EXP_Q
#define EXP_Q 0
#endif
#ifndef EXP_GU
#define EXP_GU 0
#endif
#ifndef EXP_IN
#define EXP_IN 0
#endif
#if EXP_PRO
    RUN2(0)
#else
    RUN(0)
#endif
#if EXP_IN
    RUN2(1)
#else
    RUN(1)
#endif
#if EXP_MIX
    RUN2(2)
#else
    RUN(2)
#endif
    RUN(3)
#if EXP_Q
    RUN2(4)
#else
    RUN(4)
#endif
#if EXP_ATT
    RUN2(5)
#else
    RUN(5)
#endif
    RUN(6)
#if EXP_GU
    RUN2(7)
#else
    RUN(7)
#endif
    RUN(8)
#if EXP_IN
    RUN2(9)
#else
    RUN(9)
#endif
#if EXP_MIX
    RUN2(10)
#else
    RUN(10)
#endif
    RUN(11)
#if EXP_Q
    RUN2(12)
#else
    RUN(12)
#endif
#if EXP_ATT
    RUN2(13)
#else
    RUN(13)
#endif
    RUN(14)
#if EXP_GU
    RUN2(15)
#else
    RUN(15)
#endif
    RUN(16)
#if EXP_PRO
    RUN2(17)
#else
    RUN(17)
#endif
#undef RUN2
#ifdef TSEL
    { unsigned long long tsel = TSEL == 0 ? tacc0 : TSEL == 1 ? tacc1 : TSEL == 2 ? tacc2 : TSEL == 3 ? tacc3 : tacc4;
      if (TSEL >= 5) tsel = __hip_atomic_load((unsigned long long*)(p0->ws + WS_BAR + 15360) + TSEL, __ATOMIC_RELAXED, __HIP_MEMORY_SCOPE_AGENT);
      float* epsw = (float*)(p0->ws + WS_SP8 + 8192);
      if (blockIdx.x == 0 && threadIdx.x == 0) *epsw = 0.006f + (float)tsel * 0.01f * 1e-5f;
      xcd_barrier(bar);
      const float sc = 1.0f + *epsw; float* o = p0->out + O_SCF;
      for (size_t i = (size_t)blockIdx.x * NTHREADS + threadIdx.x; i < (size_t)2 * SB * 30 * DC; i += (size_t)GRID * NTHREADS) o[i] *= sc; }
#endif
#undef RUN
}

#ifndef N_LAUNCH_SPLIT
#define N_LAUNCH_SPLIT 0
#endif
extern "C" void kernel_launch(void* const* d_in, const int* in_sizes, int n_in, void* d_out, int out_size, void* d_ws, size_t ws_size, hipStream_t stream) {
    static int ready = 0;
    if (ready == 0) {
        if (n_in != N_IN || (size_t)out_size != O_END || ws_size < WS_END) { fprintf(stderr, "kernel_launch: unexpected shapes: n_in %d out %d ws %zu\n", n_in, out_size, ws_size); ready = -1; return; }
        if (hipFuncSetAttribute((const void*)hymba_fwd, hipFuncAttributeMaxDynamicSharedMemorySize, LDS_BYTES) != hipSuccess) { fprintf(stderr, "kernel_launch: hipFuncSetAttribute failed\n"); ready = -1; return; }
        int dev = 0, cus = 0, per_cu = 0;
        hipGetDevice(&dev); hipDeviceGetAttribute(&cus, hipDeviceAttributeMultiprocessorCount, dev);
        hipOccupancyMaxActiveBlocksPerMultiprocessor(&per_cu, (const void*)hymba_fwd, NTHREADS, LDS_BYTES);
        if (cus * per_cu < GRID) { fprintf(stderr, "kernel_launch: device holds %d x %d workgroups, need %d resident\n", cus, per_cu, GRID); ready = -1; return; }
        ready = 1;
    }
    if (ready < 0) return;
    if (hipMemsetAsync((unsigned char*)d_ws + WS_BAR, 0, BAR_BYTES, stream) != hipSuccess) { fprintf(stderr, "kernel_launch: memset of the barrier words failed\n"); return; }
    Params p{};
    for (int i = 0; i < N_IN; ++i) p.in[i] = (const float*)d_in[i];
    p.out = (float*)d_out; p.ws = (unsigned char*)d_ws;
#if N_LAUNCH_SPLIT
    for (int ph = 0; ph < N_PHASES; ++ph) { p.ph_lo = ph; p.ph_hi = ph + 1; void* args[] = {&p};
        hipError_t e = hipLaunchCooperativeKernel((const void*)hymba_fwd, dim3(GRID), dim3(NTHREADS), args, LDS_BYTES, stream);
        if (e != hipSuccess) { fprintf(stderr, "cooperative launch failed: %s\n", hipGetErrorString(e)); return; } }
#else
    p.ph_lo = 0; p.ph_hi = N_PHASES; void* args[] = {&p};
    hipError_t e = hipLaunchCooperativeKernel((const void*)hymba_fwd, dim3(GRID), dim3(NTHREADS), args, LDS_BYTES, stream);
    if (e != hipSuccess) fprintf(stderr, "cooperative launch failed: %s\n", hipGetErrorString(e));
#endif
}
```

```cpp
#include <hip/hip_runtime.h>
#include <hip/hip_cooperative_groups.h>
#include <cstdio>
#include <cstdint>
namespace cg = cooperative_groups;

namespace pg8 {
#define PG8_LAS __attribute__((address_space(3)))
typedef unsigned short bf16_t;
typedef short bf16x8 __attribute__((ext_vector_type(8)));
typedef float f32x4 __attribute__((ext_vector_type(4)));
typedef unsigned u32x4 __attribute__((ext_vector_type(4)));
constexpr int BM = 256, BK = 64, HALF = 128, HTB = HALF * BK * 2  , STAGE_BYTES = 8 * HTB, NXCD = 8, WGM = 4;

__host__ __device__ __forceinline__ int lds_byte(int r, int c) { const int st = (r >> 4) * 2 + (c >> 5), rr = r & 15, cc = c & 31, ob = rr * 64 + cc * 2; return st * 1024 + (ob ^ (((ob >> 9) & 1) << 5)); }
__host__ __device__ __forceinline__ void stage_rc(int b, int& R, int& C) { const int st = b / 1024, sb = b % 1024, swz = sb ^ (((sb >> 9) & 1) << 5); R = (st >> 1) * 16 + swz / 64; C = (st & 1) * 32 + (swz % 64) / 2; }
__host__ __device__ __forceinline__ int perm32(int rho) { const int n = rho >> 4, i = rho & 15; return 8 * (i >> 2) + 4 * n + (i & 3); }

struct Unit { int pm, pn; };
struct Gemm { const bf16_t* A; const bf16_t* Bt; int M, N, K; };

struct StaticOrder {
    int nM, nN, nwg, G, c;
    __host__ __device__ void init(int M, int N, int G_, int c_) { nM = M / BM; nN = N / BM; nwg = nM * nN; G = G_; c = c_; }
    __host__ __device__ bool next(int i, Unit& u) const {
        const long L = (long)i * G + c; if (L >= nwg) return false;
        int wgid = (int)L; { const int q = nwg / NXCD, r = nwg % NXCD, xcd = wgid % NXCD, off = wgid / NXCD; wgid = (xcd < r ? xcd * (q + 1) : r * (q + 1) + (xcd - r) * q) + off; }
        const int nig = WGM * nN, gid = wgid / nig, fm = gid * WGM, gsz = (nM - fm) < WGM ? (nM - fm) : WGM;
        u.pm = fm + ((wgid % nig) % gsz); u.pn = (wgid % nig) / gsz; return true;
    }
    __device__ __forceinline__ void a_ready(const Unit&) const {}
    __device__ __forceinline__ void done(const Unit&) const {}
};

__device__ __forceinline__ unsigned cvt_pk_bf16(float lo, float hi) { unsigned r; asm volatile("v_cvt_pk_bf16_f32 %0, %1, %2" : "=v"(r) : "v"(lo), "v"(hi)); return r; }
typedef unsigned u32x2 __attribute__((ext_vector_type(2)));
constexpr float RMS_EPS = 1e-6f;

struct EpiScaleBf16 {
    static constexpr bool PERM = true, AFTER_DRAIN = false; static constexpr bool INIT_ACC = false; struct Init {};
    bf16_t* O; int ldc; const float* ssq; float scale; int row_off;
    __device__ __forceinline__ void operator()(const f32x4 (&acc)[2][2][4][2], const Unit& u, int wr, int wc, int fr, int fq) const {
        const int row0 = row_off + u.pm * BM + wr * 64 + fr, col0 = u.pn * BM + wc * 32 + 8 * fq;
#pragma unroll
        for (int ai = 0; ai < 2; ++ai)
#pragma unroll
            for (int m = 0; m < 4; ++m) { const int row = row0 + ai * HALF + m * 16; const float r = rsqrtf(ssq[row] * (1.0f / 1024.0f) + RMS_EPS) * scale;
                bf16_t* rowp = O + (size_t)row * ldc + col0;
#pragma unroll
                for (int bj = 0; bj < 2; ++bj) { const f32x4 v0 = acc[ai][bj][m][0] * r, v1 = acc[ai][bj][m][1] * r;
                    u32x4 w; w.x = cvt_pk_bf16(v0[0], v0[1]); w.y = cvt_pk_bf16(v0[2], v0[3]); w.z = cvt_pk_bf16(v1[0], v1[1]); w.w = cvt_pk_bf16(v1[2], v1[3]);
                    *(u32x4*)(rowp + bj * HALF) = w; } }
    }
};
struct EpiGateUp {
    static constexpr bool PERM = true, AFTER_DRAIN = false; static constexpr bool INIT_ACC = false; struct Init {};
    bf16_t* O; int ldc; const float* ssq; int row_off;
    __device__ __forceinline__ void operator()(const f32x4 (&acc)[2][2][4][2], const Unit& u, int wr, int wc, int fr, int fq) const {
        const int row0 = row_off + u.pm * BM + wr * 64 + fr, col0 = u.pn * HALF + wc * 32 + 8 * fq;
#pragma unroll
        for (int ai = 0; ai < 2; ++ai)
#pragma unroll
            for (int m = 0; m < 4; ++m) { const int row = row0 + ai * HALF + m * 16; const float r = rsqrtf(ssq[row] * (1.0f / 1024.0f) + RMS_EPS);
                float o[8];
#pragma unroll
                for (int n = 0; n < 2; ++n)
#pragma unroll
                    for (int j = 0; j < 4; ++j) { const float g = acc[ai][0][m][n][j] * r, up = acc[ai][1][m][n][j] * r;
                        o[n * 4 + j] = g * __builtin_amdgcn_rcpf(1.0f + __expf(-g)) * up; }
                u32x4 w; w.x = cvt_pk_bf16(o[0], o[1]); w.y = cvt_pk_bf16(o[2], o[3]); w.z = cvt_pk_bf16(o[4], o[5]); w.w = cvt_pk_bf16(o[6], o[7]);
                *(u32x4*)(O + (size_t)row * ldc + col0) = w; }
    }
};
struct EpiRes {
    static constexpr bool PERM = true, AFTER_DRAIN = false, INIT_ACC = true;
    bf16_t* XB; float* ssq_out;
    struct Init { u32x4 xo[2][4][2]; };
    __device__ __forceinline__ void load_init(Init& I, const Unit& u, int wr, int wc, int fr, int fq) const {
        const int row0 = u.pm * BM + wr * 64 + fr, col0 = u.pn * BM + wc * 32 + 8 * fq;
#pragma unroll
        for (int ai = 0; ai < 2; ++ai)
#pragma unroll
            for (int m = 0; m < 4; ++m)
#pragma unroll
                for (int bj = 0; bj < 2; ++bj) I.xo[ai][m][bj] = *(const u32x4*)(XB + (size_t)(row0 + ai * HALF + m * 16) * 1024 + col0 + bj * HALF);
    }
    __device__ __forceinline__ void apply_init(f32x4 (&acc)[2][2][4][2], const Init& I) const {
#pragma unroll
        for (int ai = 0; ai < 2; ++ai)
#pragma unroll
            for (int m = 0; m < 4; ++m)
#pragma unroll
                for (int bj = 0; bj < 2; ++bj) { const u32x4 x = I.xo[ai][m][bj];
                    acc[ai][bj][m][0] = (f32x4){__builtin_bit_cast(float, x.x << 16), __builtin_bit_cast(float, x.x & 0xffff0000u), __builtin_bit_cast(float, x.y << 16), __builtin_bit_cast(float, x.y & 0xffff0000u)};
                    acc[ai][bj][m][1] = (f32x4){__builtin_bit_cast(float, x.z << 16), __builtin_bit_cast(float, x.z & 0xffff0000u), __builtin_bit_cast(float, x.w << 16), __builtin_bit_cast(float, x.w & 0xffff0000u)}; }
    }
    __device__ __forceinline__ void operator()(const f32x4 (&acc)[2][2][4][2], const Unit& u, int wr, int wc, int fr, int fq) const {
        const int row0 = u.pm * BM + wr * 64 + fr, col0 = u.pn * BM + wc * 32 + 8 * fq;
#pragma unroll
        for (int ai = 0; ai < 2; ++ai)
#pragma unroll
            for (int m = 0; m < 4; ++m) { const int row = row0 + ai * HALF + m * 16; bf16_t* rowp = XB + (size_t)row * 1024 + col0; float s = 0.f;
#pragma unroll
                for (int bj = 0; bj < 2; ++bj) { const f32x4 v0 = acc[ai][bj][m][0], v1 = acc[ai][bj][m][1];
                    u32x4 w; w.x = cvt_pk_bf16(v0[0], v0[1]); w.y = cvt_pk_bf16(v0[2], v0[3]); w.z = cvt_pk_bf16(v1[0], v1[1]); w.w = cvt_pk_bf16(v1[2], v1[3]);
                    *(u32x4*)(rowp + bj * HALF) = w;
                    s += (v0[0] * v0[0] + v0[1] * v0[1]) + (v0[2] * v0[2] + v0[3] * v0[3]) + (v1[0] * v1[0] + v1[1] * v1[1]) + (v1[2] * v1[2] + v1[3] * v1[3]); }
                s += __shfl_xor(s, 16); s += __shfl_xor(s, 32);
                if (fq == 0) atomicAdd(ssq_out + row, s); }
    }
};
struct EpiKV {
    static constexpr bool PERM = false, AFTER_DRAIN = false; static constexpr bool INIT_ACC = false; struct Init {};
    float* outK; float* outV; bf16_t* KB; bf16_t* VT; const float* ssq;
    __device__ __forceinline__ void operator()(const f32x4 (&acc)[2][2][4][2], const Unit& u, int wr, int wc, int fr, int fq) const {
        const int row0 = u.pm * BM + wr * 64 + fr; const bool isV = u.pn >= 4; const int col0 = (u.pn & 3) * BM + wc * 32 + 4 * fq;
        float* outp = isV ? outV : outK;
#pragma unroll
        for (int ai = 0; ai < 2; ++ai)
#pragma unroll
            for (int m = 0; m < 4; ++m) { const int row = row0 + ai * HALF + m * 16; const float r = rsqrtf(ssq[row] * (1.0f / 1024.0f) + RMS_EPS);
#pragma unroll
                for (int bj = 0; bj < 2; ++bj)
#pragma unroll
                    for (int n = 0; n < 2; ++n) { const int c = col0 + bj * HALF + n * 16; const f32x4 v = acc[ai][bj][m][n] * r;
                        __builtin_nontemporal_store(v, (f32x4*)(outp + (size_t)row * 1024 + c));
                        if (!isV) { u32x2 w; w.x = cvt_pk_bf16(v[0], v[1]); w.y = cvt_pk_bf16(v[2], v[3]); *(u32x2*)(KB + (size_t)row * 1024 + c) = w; }
                        else { const int b = row >> 8, mm = row & 255, h = c >> 8, d = c & 255; bf16_t* vp = VT + ((size_t)((b * 4 + h) * 256 + d)) * 256 + mm;
                            const unsigned w0 = cvt_pk_bf16(v[0], v[1]), w1 = cvt_pk_bf16(v[2], v[3]);
                            vp[0] = (bf16_t)(w0 & 0xffffu); vp[256] = (bf16_t)(w0 >> 16); vp[512] = (bf16_t)(w1 & 0xffffu); vp[768] = (bf16_t)(w1 >> 16); } } }
    }
};

template <class Epi, class Sched, bool ALIGN_EPI = false, bool SP2 = false>
__device__ __forceinline__ void gemm_phase(PG8_LAS unsigned char* lds, const Gemm g, const Sched& S, const Epi& E) {
    int tid = threadIdx.x; asm volatile("" : "+v"(tid));
    const int wid = __builtin_amdgcn_readfirstlane(tid >> 6), lane = tid & 63, wr = wid >> 2, wc = wid & 3, fr = lane & 15, fq = lane >> 4;
    const int K = g.K, nt = K / BK;
    unsigned voffA[2], voffB[2];
#pragma unroll
    for (int i = 0; i < 2; ++i) { int R, C; stage_rc(tid * 16 + i * 8192, R, C); const int Rb = Epi::PERM ? ((R & ~31) + perm32(R & 31)) : R;
        voffA[i] = (unsigned)(R * K + C) * 2u; voffB[i] = (unsigned)(Rb * K + C) * 2u; }
    const size_t kstep = (size_t)(BK * 2);
    const size_t hstep = (size_t)HALF * K * 2;
    const size_t tstep = 2 * hstep;
    const unsigned ldsw = (unsigned)wid * 1024u;
    const int aoff = lds_byte(wr * 64 + fr, fq * 8), boff = lds_byte(wc * 32 + fr, fq * 8);
#define PG8_SA(b, h) (((b) * 2 + (h)) * HTB)
#define PG8_SB(b, h) ((4 + (b) * 2 + (h)) * HTB)
#define PG8_STAGE(bufoff, gbase, voff) do { _Pragma("unroll") for (int _i = 0; _i < 2; ++_i) \
        __builtin_amdgcn_global_load_lds((const unsigned*)((const char*)(gbase) + (voff)[_i]), (PG8_LAS unsigned*)(lds + (bufoff) + ldsw + _i * 8192), 16, 0, 0); } while (0)
#define PG8_LDA(dst, b, h) do { _Pragma("unroll") for (int m = 0; m < 4; ++m) _Pragma("unroll") for (int k = 0; k < 2; ++k) dst[m][k] = *(const PG8_LAS bf16x8*)(lds + PG8_SA(b, h) + aoff + m * 2048 + k * 1024); } while (0)
#define PG8_LDB(dst, b, h) do { _Pragma("unroll") for (int n = 0; n < 2; ++n) _Pragma("unroll") for (int k = 0; k < 2; ++k) dst[n][k] = *(const PG8_LAS bf16x8*)(lds + PG8_SB(b, h) + boff + n * 2048 + k * 1024); } while (0)
#define PG8_MMA(ai, bj, At, Bt) do { __builtin_amdgcn_s_setprio(1); _Pragma("unroll") for (int m = 0; m < 4; ++m) _Pragma("unroll") for (int n = 0; n < 2; ++n) _Pragma("unroll") for (int k = 0; k < 2; ++k) \
        acc[ai][bj][m][n] = __builtin_amdgcn_mfma_f32_16x16x32_bf16(Bt[n][k], At[m][k], acc[ai][bj][m][n], 0, 0, 0); __builtin_amdgcn_s_setprio(0); } while (0)
#define PG8_WAIT_V(n) asm volatile("s_waitcnt vmcnt(" #n ")" ::: "memory")
#define PG8_WAIT_L(n) asm volatile("s_waitcnt lgkmcnt(" #n ")" ::: "memory")
#define PG8_BAR __builtin_amdgcn_s_barrier()
#define PG8_SCHED __builtin_amdgcn_sched_barrier(0)
    Unit cur, nxt; int ui = 0;
    if (!S.next(0, cur)) return;
    f32x4 acc[2][2][4][2];
#pragma unroll
    for (int a = 0; a < 2; ++a)
#pragma unroll
        for (int b = 0; b < 2; ++b)
#pragma unroll
            for (int m = 0; m < 4; ++m)
#pragma unroll
                for (int n = 0; n < 2; ++n) acc[a][b][m][n] = (f32x4){0.f, 0.f, 0.f, 0.f};
    bf16x8 At[4][2], B0[2][2], B1[2][2];
    const char* cA = (const char*)g.A + (size_t)cur.pm * tstep; const char* cB = (const char*)g.Bt + (size_t)cur.pn * tstep;
    typename Epi::Init init_; if constexpr (Epi::INIT_ACC) E.load_init(init_, cur, wr, wc, fr, fq);
    S.a_ready(cur);
    if constexpr (SP2) {
        PG8_STAGE(PG8_SB(0, 0), cB, voffB); PG8_STAGE(PG8_SB(0, 1), cB + hstep, voffB); PG8_STAGE(PG8_SA(0, 0), cA, voffA); PG8_STAGE(PG8_SA(0, 1), cA + hstep, voffA);
        if (wr == 1) PG8_BAR;
        PG8_WAIT_V(2); PG8_BAR;
        PG8_STAGE(PG8_SB(1, 0), cB + kstep, voffB); PG8_STAGE(PG8_SA(1, 0), cA + kstep, voffA); PG8_STAGE(PG8_SB(1, 1), cB + hstep + kstep, voffB);
        PG8_WAIT_V(6); PG8_BAR;
    } else {
        PG8_STAGE(PG8_SB(0, 0), cB, voffB); PG8_STAGE(PG8_SA(0, 0), cA, voffA); PG8_STAGE(PG8_SB(0, 1), cB + hstep, voffB); PG8_STAGE(PG8_SA(0, 1), cA + hstep, voffA);
        if (wr == 1) PG8_BAR;
        PG8_WAIT_V(4); PG8_BAR;
        PG8_STAGE(PG8_SB(1, 0), cB + kstep, voffB); PG8_STAGE(PG8_SA(1, 0), cA + kstep, voffA); PG8_STAGE(PG8_SB(1, 1), cB + hstep + kstep, voffB);
        PG8_WAIT_V(6); PG8_BAR;
    }
    if constexpr (Epi::INIT_ACC) E.apply_init(acc, init_);
    for (;;) {
        const bool has_next = S.next(ui + 1, nxt);
        const char* nA = has_next ? (const char*)g.A + (size_t)nxt.pm * tstep : cA; const char* nB = has_next ? (const char*)g.Bt + (size_t)nxt.pn * tstep : cB;
        for (int t = 0; t < nt; t += 2) {
            const bool last = (t == nt - 2);
            const char* a1 = cA + (size_t)(t + 1) * kstep;
            const char* a2 = last ? nA : cA + (size_t)(t + 2) * kstep; const char* b2 = last ? nB : cB + (size_t)(t + 2) * kstep;
            const char* a3 = a2 + kstep; const char* b3 = b2 + kstep;
            if (last && has_next) S.a_ready(nxt);
            if constexpr (SP2) {
            PG8_LDB(B0, 0, 0); PG8_LDB(B1, 0, 1); PG8_SCHED; PG8_LDA(At, 0, 0); PG8_STAGE(PG8_SA(1, 1), a1 + hstep, voffA);
            PG8_WAIT_V(8); PG8_WAIT_L(0); PG8_BAR; PG8_MMA(0, 0, At, B0); PG8_MMA(0, 1, At, B1); PG8_BAR; PG8_SCHED;
            PG8_LDA(At, 0, 1); PG8_STAGE(PG8_SB(0, 0), b2, voffB); PG8_STAGE(PG8_SB(0, 1), b2 + hstep, voffB); PG8_STAGE(PG8_SA(0, 0), a2, voffA);
            PG8_WAIT_V(8); PG8_WAIT_L(0); PG8_BAR; PG8_MMA(1, 0, At, B0); PG8_MMA(1, 1, At, B1); PG8_BAR; PG8_SCHED;
            PG8_LDB(B0, 1, 0); PG8_LDB(B1, 1, 1); PG8_SCHED; PG8_LDA(At, 1, 0); PG8_STAGE(PG8_SA(0, 1), a2 + hstep, voffA);
            PG8_WAIT_V(8); PG8_WAIT_L(0); PG8_BAR; PG8_MMA(0, 0, At, B0); PG8_MMA(0, 1, At, B1); PG8_BAR; PG8_SCHED;
            PG8_LDA(At, 1, 1); PG8_STAGE(PG8_SB(1, 0), b3, voffB); PG8_STAGE(PG8_SB(1, 1), b3 + hstep, voffB); PG8_STAGE(PG8_SA(1, 0), a3, voffA);
            PG8_WAIT_V(8); PG8_WAIT_L(0); PG8_BAR; PG8_MMA(1, 0, At, B0); PG8_MMA(1, 1, At, B1); PG8_BAR; PG8_SCHED;
            } else {
            PG8_LDB(B0, 0, 0); PG8_SCHED; PG8_LDA(At, 0, 0); PG8_STAGE(PG8_SA(1, 1), a1 + hstep, voffA);
            PG8_WAIT_L(8); PG8_BAR; PG8_WAIT_L(0); PG8_MMA(0, 0, At, B0); PG8_BAR; PG8_SCHED;
            PG8_LDB(B1, 0, 1); PG8_STAGE(PG8_SB(0, 0), b2, voffB);
            PG8_BAR; PG8_WAIT_L(0); PG8_MMA(0, 1, At, B1); PG8_BAR;
            PG8_LDA(At, 0, 1); PG8_STAGE(PG8_SA(0, 0), a2, voffA);
            PG8_BAR; PG8_WAIT_L(0); PG8_MMA(1, 0, At, B0); PG8_BAR; PG8_SCHED;
            PG8_STAGE(PG8_SB(0, 1), b2 + hstep, voffB);
            PG8_WAIT_V(6); PG8_BAR; PG8_MMA(1, 1, At, B1); PG8_BAR;
            PG8_LDB(B0, 1, 0); PG8_SCHED; PG8_LDA(At, 1, 0); PG8_STAGE(PG8_SA(0, 1), a2 + hstep, voffA);
            PG8_WAIT_L(8); PG8_BAR; PG8_WAIT_L(0); PG8_MMA(0, 0, At, B0); PG8_BAR; PG8_SCHED;
            PG8_LDB(B1, 1, 1); PG8_STAGE(PG8_SB(1, 0), b3, voffB);
            PG8_BAR; PG8_WAIT_L(0); PG8_MMA(0, 1, At, B1); PG8_BAR;
            PG8_LDA(At, 1, 1); PG8_STAGE(PG8_SA(1, 0), a3, voffA);
            PG8_BAR; PG8_WAIT_L(0); PG8_MMA(1, 0, At, B0); PG8_BAR; PG8_SCHED;
            PG8_STAGE(PG8_SB(1, 1), b3 + hstep, voffB);
            PG8_WAIT_V(6); PG8_BAR; PG8_MMA(1, 1, At, B1); PG8_BAR;
            }
        }
        if constexpr (ALIGN_EPI) { if (wr == 0) PG8_BAR; }
        if constexpr (!Epi::AFTER_DRAIN) { E(acc, cur, wr, wc, fr, fq); S.done(cur); }
        if (!has_next) break;
#pragma unroll
        for (int a = 0; a < 2; ++a)
#pragma unroll
            for (int b = 0; b < 2; ++b)
#pragma unroll
                for (int m = 0; m < 4; ++m)
#pragma unroll
                    for (int n = 0; n < 2; ++n) acc[a][b][m][n] = (f32x4){0.f, 0.f, 0.f, 0.f};
        cur = nxt; cA = nA; cB = nB; ++ui;
        if constexpr (ALIGN_EPI) { if (wr == 1) PG8_BAR; }
    }
    PG8_WAIT_V(0);
    if constexpr (!ALIGN_EPI) { if (wr == 0) PG8_BAR; }
    PG8_BAR;
    if constexpr (Epi::AFTER_DRAIN) { E.fused(acc, cur, wr, wc, fr, fq, lds, wid, lane); S.done(cur); }
#undef PG8_SA
#undef PG8_SB
#undef PG8_STAGE
#undef PG8_LDA
#undef PG8_LDB
#undef PG8_MMA
#undef PG8_WAIT_V
#undef PG8_WAIT_L
#undef PG8_BAR
#undef PG8_SCHED
}
}

#define LAS __attribute__((address_space(3)))
typedef unsigned short bf16;
typedef short bf16x8 __attribute__((ext_vector_type(8)));
typedef short bf16x4 __attribute__((ext_vector_type(4)));
typedef float f32x4 __attribute__((ext_vector_type(4)));
typedef float f32x2 __attribute__((ext_vector_type(2)));
typedef float f32x16 __attribute__((ext_vector_type(16)));
typedef unsigned u32x4 __attribute__((ext_vector_type(4)));
typedef unsigned u32x2 __attribute__((ext_vector_type(2)));

constexpr int D = 1024, NB = 8, SEQ = 2048, TP = NB * SEQ, SB = 128, SS = 4, TS = SB * SS, T = TP + TS;
constexpr int DR = 512, DC = 512, DIN = 2048, NMEM = 256, NH = 4, HD = 256, DFF = 2816, MROWS = NB * NMEM;
constexpr int NTHREADS = 512, NWAVES = 8, GRID = 256;
constexpr float EPS = 1e-6f;
constexpr float QSCALE = 0.0625f * 1.4426950408889634f;

enum { I_XP = 0, I_XS, I_SH, I_SRG, I_SCF, I_CK, I_CV, I_MEM, I_GMIX, I_WIN, I_RGCW, I_RGCB, I_WA, I_BA, I_WX, I_BX, I_LAM, I_CFW, I_CFB, I_LNG, I_LNB, I_WOUT,
       I_GATTN, I_GMEM, I_WQ, I_WK, I_WV, I_WO, I_GFFN, I_WG, I_WU, I_WD, I_GFIN, N_IN };
constexpr size_t O_YP = 0, O_YS = (size_t)TP * D, O_PH = O_YS + (size_t)TS * D, O_PRG = O_PH + 2 * NB * DR, O_PCF = O_PRG + 2 * NB * 3 * DR, O_PMK = O_PCF + 2 * NB * 30 * DC,
                 O_PMV = O_PMK + (size_t)2 * MROWS * D, O_SH = O_PMV + (size_t)2 * MROWS * D, O_SRG = O_SH + 2 * SB * DR, O_SCF = O_SRG + 2 * SB * 3 * DR, O_END = O_SCF + (size_t)2 * SB * 30 * DC;
constexpr size_t MiB = 1u << 20;
constexpr size_t WS_SSQ = 0, WS_SSQM = 512 * 1024, WS_SP8 = 640 * 1024, WS_BAR = 768 * 1024, BAR_BYTES = 16384, WS_AGG = 1 * MiB, WS_RGW = 2 * MiB, WS_W = 4 * MiB, W_LAYER = 31 * MiB;
constexpr size_t WO_IN = 0, WO_OUT = 4 * MiB, WO_Q = 6 * MiB, WO_KV = 8 * MiB, WO_O = 12 * MiB, WO_GU = 14 * MiB, WO_D = 25 * MiB;
constexpr size_t WS_X = 68 * MiB, WS_XB = 134 * MiB, WS_U = 167 * MiB, WS_YM = 233 * MiB, WS_QB = 266 * MiB, WS_H = 299 * MiB, WS_MEMB = 390 * MiB, WS_KB = 394 * MiB, WS_VT = 402 * MiB, WS_END = 410 * MiB;
constexpr int LDS_BYTES = 149568, LDS_BARW = LDS_BYTES - 64;

struct Params { const float* in[N_IN]; float* out; unsigned char* ws; int ph_lo, ph_hi; };
typedef const __attribute__((address_space(4))) Params CParams;
#ifdef TSEL
#define TP_BEGIN() const unsigned long long tpb_ = __builtin_amdgcn_s_memrealtime()
#define TP_END(ID) do { asm volatile("s_waitcnt vmcnt(0)" ::: "memory"); if (blockIdx.x == 0 && threadIdx.x == 0) atomicAdd((unsigned long long*)(p.ws + WS_BAR + 15360) + (ID), __builtin_amdgcn_s_memrealtime() - tpb_); } while (0)
#else
#define TP_BEGIN() do {} while (0)
#define TP_END(ID) do {} while (0)
#endif
__device__ __forceinline__ int otid() { int t = threadIdx.x; asm volatile("" : "+v"(t)); return t; }

__device__ __forceinline__ unsigned f2bf(float f) { unsigned u = __builtin_bit_cast(unsigned, f); return (u + 0x7fffu + ((u >> 16) & 1u)) >> 16; }
__device__ __forceinline__ unsigned pk2(float lo, float hi) { return f2bf(lo) | (f2bf(hi) << 16); }
__device__ __forceinline__ float bf2f(unsigned short b) { return __builtin_bit_cast(float, ((unsigned)b) << 16); }
__device__ __forceinline__ float bflo(unsigned w) { return __builtin_bit_cast(float, w << 16); }
__device__ __forceinline__ float bfhi(unsigned w) { return __builtin_bit_cast(float, w & 0xffff0000u); }
__device__ __forceinline__ float wave_sum(float v) {
#pragma unroll
    for (int o = 1; o < 64; o <<= 1) v += __shfl_xor(v, o);
    return v;
}
__device__ __forceinline__ float sigmoidf_(float x) { return __builtin_amdgcn_rcpf(1.0f + __expf(-x)); }
__device__ __forceinline__ float gelu_tanh(float x) {
    const float u = 0.7978845608028654f * (x + 0.044715f * x * x * x);
    const float t = 1.0f - 2.0f * __builtin_amdgcn_rcpf(1.0f + __expf(2.0f * u));
    return 0.5f * x * (1.0f + t);
}
__device__ __forceinline__ float softplusf_(float x) { return x > 15.f ? x : log1pf(__expf(x)); }
__device__ __forceinline__ void lru_coef(float la, float& a, float& mult) {
    a = __expf(la); const float x = 2.0f * la;
    const float ser = -x * (1.0f + x * (0.5f + x * (0.16666667f + x * (0.041666667f + x * (0.0083333333f + x * 0.0013888889f)))));
    const float om = (x > -0.25f) ? ser : (1.0f - a * a);
    mult = sqrtf(om);
}

#define XB_TMO      128
#define XB_XCNT(j)  (256  + 64 * (j))
#define XB_XSUB(j)  (1280 + 64 * (j))
#define XB_XGEN(j)  (2304 + 64 * (j))
#define XB_TOP      3328
#define XB_TOPGEN   3392
#define XCD_BAR_WORDS 3456
#define XB_SPIN_CAP (1u << 18)

__device__ __forceinline__ unsigned xb_ld(unsigned* p)              { return __hip_atomic_load(p, __ATOMIC_RELAXED, __HIP_MEMORY_SCOPE_AGENT); }
__device__ __forceinline__ unsigned xb_add(unsigned* p, unsigned v) { return __hip_atomic_fetch_add(p, v, __ATOMIC_RELAXED, __HIP_MEMORY_SCOPE_AGENT); }
__device__ __forceinline__ unsigned xb_xcc_id() { return (unsigned)__builtin_amdgcn_s_getreg((3 << 11) | 20) & 0xFu; }
#define XB_SPIN(cond, bar) do { unsigned _sp = 0; while (cond) { __builtin_amdgcn_s_sleep(1); \
    if ((++_sp & 255u) == 0u) { if (xb_ld(&(bar)[XB_TMO])) break; if (_sp > XB_SPIN_CAP) { atomicAdd(&(bar)[XB_TMO], 1u); break; } } } } while (0)

struct XcdBarrier {
    unsigned* bar; unsigned x;
    volatile LAS unsigned* st;
};

__device__ __forceinline__ XcdBarrier xcd_barrier_post(unsigned* bar, volatile LAS unsigned* st) {
    XcdBarrier b; b.bar = bar; b.x = xb_xcc_id(); b.st = st;
    if (threadIdx.x == 0) (void)xb_add(&bar[XB_XCNT(b.x)], 1u);
    return b;
}
__device__ __forceinline__ void xcd_barrier_complete(unsigned* bar, unsigned x, unsigned& nloc, unsigned& nx) {
    const unsigned G = gridDim.x * gridDim.y * gridDim.z;
    unsigned sum, cnt, mine, sp = 0u;
    for (;;) {
        sum = 0u; cnt = 0u; mine = 0u;
#pragma unroll
        for (unsigned j = 0; j < 16; ++j) { const unsigned c = xb_ld(&bar[XB_XCNT(j)]); sum += c; cnt += (c > 0u) ? 1u : 0u; mine = (j == x) ? c : mine; }
        if (sum == G) break;
        __builtin_amdgcn_s_sleep(1);
        if ((++sp & 255u) == 0u) { if (xb_ld(&bar[XB_TMO])) break; if (sp > XB_SPIN_CAP) { atomicAdd(&bar[XB_TMO], 1u); break; } }
    }
    nloc = mine > 0u ? mine : 1u; nx = cnt > 0u ? cnt : 1u;
}

__device__ __forceinline__ void xcd_barrier(const XcdBarrier& b) {
    asm volatile("s_waitcnt vmcnt(0)" ::: "memory");
    __syncthreads();
    if (threadIdx.x == 0) {
        unsigned* bar = b.bar;
        __builtin_amdgcn_s_waitcnt(0);
        unsigned nloc = b.st[0], nx = b.st[1];
        if (nloc == 0u) { xcd_barrier_complete(bar, b.x, nloc, nx); b.st[0] = nloc; b.st[1] = nx; }
        const unsigned old = xb_add(&bar[XB_XSUB(b.x)], 1u);
        const unsigned gen = old / nloc;
        if (old + 1u == (gen + 1u) * nloc) {
            __builtin_amdgcn_fence(__ATOMIC_RELEASE, "agent");
            asm volatile("s_waitcnt vmcnt(0)" ::: "memory");
            const unsigned og = xb_add(&bar[XB_TOP], 1u);
            const unsigned tg = og / nx;
            if (og + 1u == (tg + 1u) * nx) xb_add(&bar[XB_TOPGEN], 1u);
            else XB_SPIN(xb_ld(&bar[XB_TOPGEN]) == tg, bar);
            __builtin_amdgcn_fence(__ATOMIC_ACQUIRE, "agent");
            xb_add(&bar[XB_XGEN(b.x)], 1u);
            asm volatile("s_waitcnt vmcnt(0)" ::: "memory");
        } else {
            XB_SPIN(xb_ld(&bar[XB_XGEN(b.x)]) == gen, bar);
            __builtin_amdgcn_fence(__ATOMIC_ACQUIRE, "agent");
            asm volatile("s_waitcnt vmcnt(0)" ::: "memory");
        }
    }
    __syncthreads();
}

__device__ __forceinline__ void transpose_item(const float* W, int K, int N, const float* gain, bf16* WT, int dst_row0, LAS float* scr, int k0, int n0, int lane) {
    const int kr = lane >> 4, nq = lane & 15;
    f32x4 v[16];
#pragma unroll
    for (int i = 0; i < 16; ++i) v[i] = __builtin_nontemporal_load((const f32x4*)(W + (size_t)(k0 + 4 * i + kr) * N + n0 + 4 * nq));
#pragma unroll
    for (int i = 0; i < 16; ++i) { const int kk = 4 * i + kr; const float g = gain ? gain[k0 + kk] : 1.0f; LAS float* d = scr + kk * 65 + 4 * nq;
        d[0] = v[i].x * g; d[1] = v[i].y * g; d[2] = v[i].z * g; d[3] = v[i].w * g; }
    asm volatile("s_waitcnt lgkmcnt(0)" ::: "memory");
    const int c = lane & 7;
#pragma unroll
    for (int j = 0; j < 8; ++j) { const int n = (lane >> 3) + 8 * j; const LAS float* s = scr + (8 * c) * 65 + n;
        u32x4 o; o.x = pk2(s[0 * 65], s[1 * 65]); o.y = pk2(s[2 * 65], s[3 * 65]); o.z = pk2(s[4 * 65], s[5 * 65]); o.w = pk2(s[6 * 65], s[7 * 65]);
        *(u32x4*)(WT + (size_t)(dst_row0 + n) * K + k0 + 8 * c) = o; }
    asm volatile("s_waitcnt lgkmcnt(0)" ::: "memory");
}
__device__ __forceinline__ void weight_items(CParams& p, LAS unsigned char* lds, int l, int gw, int NGW, int wave, int lane) {
    LAS float* scr = (LAS float*)(lds + wave * 18432);
    unsigned char* ws = p.ws;
    constexpr int I_SQ = 256, I_INN = 512, I_GU = 704, PER_LAYER = I_INN + 5 * I_SQ + 3 * I_GU;
    for (int it = gw; it < PER_LAYER; it += NGW) {
        int r = it;
        unsigned char* wl = ws + WS_W + (size_t)l * W_LAYER;
        const float* W; const float* gain = nullptr; bf16* WT; int K = D, N = D, mode = 0;
        int off = 0;
        if (r < I_INN) { W = p.in[I_WIN] + (size_t)l * D * DIN; gain = p.in[I_GMIX] + l * D; WT = (bf16*)(wl + WO_IN); N = DIN; }
        else if ((r -= I_INN) < I_SQ) { W = p.in[I_WOUT] + (size_t)l * D * D; WT = (bf16*)(wl + WO_OUT); }
        else if ((r -= I_SQ) < I_SQ) { W = p.in[I_WQ] + (size_t)l * D * D; gain = p.in[I_GATTN] + l * D; WT = (bf16*)(wl + WO_Q); }
        else if ((r -= I_SQ) < I_SQ) { W = p.in[I_WK] + (size_t)l * D * D; gain = p.in[I_GMEM] + l * D; WT = (bf16*)(wl + WO_KV); }
        else if ((r -= I_SQ) < I_SQ) { W = p.in[I_WV] + (size_t)l * D * D; gain = p.in[I_GMEM] + l * D; WT = (bf16*)(wl + WO_KV); off = 1024; }
        else if ((r -= I_SQ) < I_SQ) { W = p.in[I_WO] + (size_t)l * D * D; WT = (bf16*)(wl + WO_O); }
        else if ((r -= I_SQ) < I_GU) { W = p.in[I_WG] + (size_t)l * D * DFF; gain = p.in[I_GFFN] + l * D; WT = (bf16*)(wl + WO_GU); N = DFF; mode = 1; }
        else if ((r -= I_GU) < I_GU) { W = p.in[I_WU] + (size_t)l * D * DFF; gain = p.in[I_GFFN] + l * D; WT = (bf16*)(wl + WO_GU); N = DFF; mode = 2; }
        else { r -= I_GU; W = p.in[I_WD] + (size_t)l * DFF * D; WT = (bf16*)(wl + WO_D); K = DFF; }
        const int nblk = N / 64, kb = r / nblk, nb = r % nblk, k0 = 64 * kb, n0 = 64 * nb;
        int dst0 = n0 + off;
        if (mode) dst0 = (n0 >> 7) * 256 + (n0 & 127) + (mode == 2 ? 128 : 0);
        transpose_item(W, K, N, gain, WT, dst0, scr, k0, n0, lane);
    }
}
__device__ __forceinline__ void prologue(CParams& p, LAS unsigned char* lds) {
    const int tid = otid(), lane = tid & 63, wave = tid >> 6;
    const int gw = blockIdx.x * NWAVES + wave, NGW = gridDim.x * NWAVES;
    unsigned char* ws = p.ws;
    weight_items(p, lds, 0, gw, NGW, wave, lane);
    bf16* XB = (bf16*)(ws + WS_XB); float* SSQ = (float*)(ws + WS_SSQ); float* SSQM = (float*)(ws + WS_SSQM); bf16* MEMB = (bf16*)(ws + WS_MEMB);
    for (int m0 = gw; m0 < T + MROWS; m0 += 4 * NGW) {
        f32x4 v[4][4];
#pragma unroll
        for (int r = 0; r < 4; ++r) { const int m = m0 + r * NGW;
            if (m < T + MROWS) { const bool ismem = m >= T; const int mr = ismem ? m - T : m;
                const float* src = ismem ? p.in[I_MEM] + (size_t)mr * D : (m < TP ? p.in[I_XP] + (size_t)m * D : p.in[I_XS] + (size_t)(m - TP) * D);
                const f32x4* xr = (const f32x4*)src + lane;
#pragma unroll
                for (int j = 0; j < 4; ++j) v[r][j] = __builtin_nontemporal_load(xr + 64 * j); } }
#pragma unroll
        for (int r = 0; r < 4; ++r) { const int m = m0 + r * NGW;
            if (m < T + MROWS) { const bool ismem = m >= T; const int mr = ismem ? m - T : m; float s = 0.f;
#pragma unroll
                for (int j = 0; j < 4; ++j) s += (v[r][j].x * v[r][j].x + v[r][j].y * v[r][j].y) + (v[r][j].z * v[r][j].z + v[r][j].w * v[r][j].w);
                s = wave_sum(s);
                bf16* ob = ismem ? MEMB + (size_t)mr * D : XB + (size_t)m * D;
                unsigned long long* o8 = (unsigned long long*)ob + lane;
#pragma unroll
                for (int j = 0; j < 4; ++j) o8[64 * j] = (unsigned long long)pk2(v[r][j].x, v[r][j].y) | ((unsigned long long)pk2(v[r][j].z, v[r][j].w) << 32);
                if (!ismem) { if (lane == 0) SSQ[m] = s; }
                else if (lane == 0) SSQM[mr] = s; } }
    }
    for (int i = blockIdx.x * NTHREADS + tid; i < 6 * T; i += gridDim.x * NTHREADS) SSQ[T + i] = 0.f;
    bf16* RGW = (bf16*)(ws + WS_RGW);
    for (int i = blockIdx.x * NTHREADS + tid; i < 2 * 2 * 8 * 64 * 64; i += gridDim.x * NTHREADS) {
        const int l = i >> 16, g = (i >> 15) & 1, h = (i >> 12) & 7, j = (i >> 6) & 63, ii = i & 63;
        const float* src = (g ? p.in[I_WX] : p.in[I_WA]) + (size_t)((l * 8 + h) * 64 + ii) * 64 + j;
        RGW[i] = (bf16)f2bf(*src);
    }
    float* SP8 = (float*)(ws + WS_SP8);
    for (int i = blockIdx.x * NTHREADS + tid; i < 2 * DR; i += gridDim.x * NTHREADS) SP8[i] = -8.0f * softplusf_(-p.in[I_LAM][i]);
}

__device__ __forceinline__ void conf_prompt_pair(CParams& p, int l, int b, int ck0, LAS unsigned char* lds) {
    const int tid = otid(), lane = tid & 63, wave = tid >> 6, c = tid;
    const bf16* U = (const bf16*)(p.ws + WS_U); bf16* YM = (bf16*)(p.ws + WS_YM);
    LAS float* cO = (LAS float*)lds;
    const size_t rowb = (size_t)b * SEQ;
    const float* wp = p.in[I_CFW] + (size_t)l * 31 * DC + c; const float bias = p.in[I_CFB][l * DC + c];
    float w[31];
#pragma unroll
    for (int j = 0; j < 31; ++j) w[j] = wp[j * DC];
    const f32x4* gp = (const f32x4*)(p.in[I_LNG] + l * DC + lane * 8); const f32x4* bp = (const f32x4*)(p.in[I_LNB] + l * DC + lane * 8);
    const f32x4 g0 = gp[0], g1 = gp[1], b0 = bp[0], b1 = bp[1];
#pragma unroll 1
    for (int ck = ck0; ck < ck0 + 2; ++ck) {
    const int t0 = ck * 32;
    LAS float* cL = (LAS float*)lds;
#pragma unroll 1
    for (int i0 = 0; i0 < 8; i0 += 4) {
        u32x4 va[4], vg[4];
#pragma unroll
        for (int i = 0; i < 4; ++i) { const int r = wave + 8 * (i0 + i), t = t0 - 30 + r; va[i] = (u32x4){0u, 0u, 0u, 0u}; vg[i] = va[i];
            if (r < 62 && t >= 0) { const bf16* up = U + (rowb + t) * DIN + lane * 8; va[i] = *(const u32x4*)(up + 1024); vg[i] = *(const u32x4*)(up + 1536); } }
#pragma unroll
        for (int i = 0; i < 4; ++i) { const int r = wave + 8 * (i0 + i);
            if (r < 62) { f32x4 c0, c1;
                c0.x = bflo(va[i].x) * sigmoidf_(bflo(vg[i].x)); c0.y = bfhi(va[i].x) * sigmoidf_(bfhi(vg[i].x)); c0.z = bflo(va[i].y) * sigmoidf_(bflo(vg[i].y)); c0.w = bfhi(va[i].y) * sigmoidf_(bfhi(vg[i].y));
                c1.x = bflo(va[i].z) * sigmoidf_(bflo(vg[i].z)); c1.y = bfhi(va[i].z) * sigmoidf_(bfhi(vg[i].z)); c1.z = bflo(va[i].w) * sigmoidf_(bflo(vg[i].w)); c1.w = bfhi(va[i].w) * sigmoidf_(bfhi(vg[i].w));
                *(LAS f32x4*)(cL + r * 512 + lane * 8) = c0; *(LAS f32x4*)(cL + r * 512 + lane * 8 + 4) = c1;
                if (ck == 63 && r >= 32) { float* op = p.out + O_PCF + ((size_t)(l * NB + b) * 30 + (r - 32)) * DC + lane * 8; *(f32x4*)op = c0; *(f32x4*)(op + 4) = c1; } } }
    }
    __syncthreads();
#pragma unroll 1
    for (int t4 = 0; t4 < 32; t4 += 4) { float a0 = bias, a1 = bias, a2 = bias, a3 = bias; const LAS float* cp = cL + t4 * 512 + c;
#pragma unroll
        for (int j = 0; j < 34; ++j) { const float v = cp[j * 512];
            if (j < 31) a0 += w[j] * v;
            if (j >= 1 && j < 32) a1 += w[j - 1] * v;
            if (j >= 2 && j < 33) a2 += w[j - 2] * v;
            if (j >= 3) a3 += w[j - 3] * v; }
        cO[(t4 + 0) * 512 + c] = a0; cO[(t4 + 1) * 512 + c] = a1; cO[(t4 + 2) * 512 + c] = a2; cO[(t4 + 3) * 512 + c] = a3; }
    __syncthreads();
#pragma unroll
    for (int i = 0; i < 4; ++i) { const int t = wave + 8 * i;
        const f32x4 x0 = *(const LAS f32x4*)(cO + t * 512 + lane * 8), x1 = *(const LAS f32x4*)(cO + t * 512 + lane * 8 + 4);
        const float mean = wave_sum((x0.x + x0.y) + (x0.z + x0.w) + (x1.x + x1.y) + (x1.z + x1.w)) * (1.0f / 512.0f);
        const f32x4 d0 = x0 - mean, d1 = x1 - mean;
        const float var = wave_sum((d0.x * d0.x + d0.y * d0.y) + (d0.z * d0.z + d0.w * d0.w) + (d1.x * d1.x + d1.y * d1.y) + (d1.z * d1.z + d1.w * d1.w)) * (1.0f / 512.0f);
        const float rs = rsqrtf(var + EPS);
        f32x4 y0 = d0 * rs * g0 + b0, y1 = d1 * rs * g1 + b1;
#pragma unroll
        for (int j = 0; j < 4; ++j) { y0[j] = y0[j] * sigmoidf_(y0[j]); y1[j] = y1[j] * sigmoidf_(y1[j]); }
        u32x4 o; o.x = pk2(y0.x, y0.y); o.y = pk2(y0.z, y0.w); o.z = pk2(y1.x, y1.y); o.w = pk2(y1.z, y1.w);
        *(u32x4*)(YM + (rowb + t0 + t) * D + 512 + lane * 8) = o; }
    __syncthreads();
    }
}

__device__ __forceinline__ void sample_mixer_item(CParams& p, int l, int sb, LAS unsigned char* lds, const bool conf_part) {
    const int tid = otid(), lane = tid & 63, wave = tid >> 6, c = tid;
    const bf16* U = (const bf16*)(p.ws + WS_U); bf16* YM = (bf16*)(p.ws + WS_YM);
    LAS float* xcS = (LAS float*)lds;
    LAS float* cS = (LAS float*)(lds + 8192);
    const size_t row0 = (size_t)TP + sb * SS;
    if (!conf_part) {
    float xp[7];
    { const float* st = p.in[I_SRG] + ((size_t)(l * SB + sb) * 3) * DR + c; xp[0] = st[0]; xp[1] = st[DR]; xp[2] = st[2 * DR]; }
    float gr[4];
#pragma unroll
    for (int t = 0; t < 4; ++t) { const bf16* up = U + (row0 + t) * DIN; xp[3 + t] = bf2f(up[c]); gr[t] = bf2f(up[512 + c]); }
#pragma unroll
    for (int j = 0; j < 3; ++j) p.out[O_SRG + ((size_t)(l * SB + sb) * 3 + j) * DR + c] = xp[4 + j];
    float xc[4];
    { const float* cw = p.in[I_RGCW] + (size_t)l * 4 * DR + c; const float w0 = cw[0], w1 = cw[DR], w2 = cw[2 * DR], w3 = cw[3 * DR], bc = p.in[I_RGCB][l * DR + c];
#pragma unroll
      for (int t = 0; t < 4; ++t) { xc[t] = bc + w0 * xp[t] + w1 * xp[t + 1] + w2 * xp[t + 2] + w3 * xp[t + 3]; xcS[t * 512 + c] = xc[t]; } }
    __syncthreads();
    float ra[4], ia[4];
    {
        const int h = wave, fr = lane & 15, fq = lane >> 4;
        LAS float* gS = (LAS float*)(lds + 16384);
        const bf16* RGW = (const bf16*)(p.ws + WS_RGW) + (size_t)(l * 2) * 8 * 4096;
        bf16x8 xf[2];
#pragma unroll
        for (int ks = 0; ks < 2; ++ks) { u32x4 w = (u32x4){0u, 0u, 0u, 0u};
            if (fr < 4) { const LAS float* xp4 = xcS + fr * 512 + h * 64 + 32 * ks + 8 * fq; const f32x4 a0 = *(const LAS f32x4*)xp4, a1 = *(const LAS f32x4*)(xp4 + 4);
                w.x = pk2(a0.x, a0.y); w.y = pk2(a0.z, a0.w); w.z = pk2(a1.x, a1.y); w.w = pk2(a1.z, a1.w); }
            xf[ks] = __builtin_bit_cast(bf16x8, w); }
#pragma unroll
        for (int ct = 0; ct < 4; ++ct)
#pragma unroll
            for (int g = 0; g < 2; ++g) { const bf16* wpt = RGW + (size_t)((g * 8 + h) * 64 + 16 * ct + fr) * 64 + 8 * fq;
                const bf16x8 w0 = *(const bf16x8*)wpt, w1 = *(const bf16x8*)(wpt + 32);
                f32x4 acc = {0.f, 0.f, 0.f, 0.f};
                acc = __builtin_amdgcn_mfma_f32_16x16x32_bf16(xf[0], w0, acc, 0, 0, 0); acc = __builtin_amdgcn_mfma_f32_16x16x32_bf16(xf[1], w1, acc, 0, 0, 0);
                if (fq == 0) {
#pragma unroll
                    for (int e = 0; e < 4; ++e) gS[(g * 4 + e) * 512 + h * 64 + 16 * ct + fr] = acc[e]; } }
        __syncthreads();
        const float ba = p.in[I_BA][l * DR + c], bx = p.in[I_BX][l * DR + c];
#pragma unroll
        for (int t = 0; t < 4; ++t) { ra[t] = gS[t * 512 + c] + ba; ia[t] = gS[(4 + t) * 512 + c] + bx; } }
    { const float sp8 = ((const float*)(p.ws + WS_SP8))[l * DR + c];
      float hs = p.in[I_SH][(size_t)(l * SB + sb) * DR + c];
#pragma unroll
      for (int t = 0; t < 4; ++t) { const float r = sigmoidf_(ra[t]), ig = sigmoidf_(ia[t]); float a, mult; lru_coef(sp8 * r, a, mult);
          hs = a * hs + mult * (ig * xc[t]);
          YM[(row0 + t) * D + c] = (bf16)f2bf(hs * gelu_tanh(gr[t])); }
      p.out[O_SH + (size_t)(l * SB + sb) * DR + c] = hs; }
    __syncthreads();
    return; }
    { float cp[34];
      const float* st = p.in[I_SCF] + ((size_t)(l * SB + sb) * 30) * DC + c;
#pragma unroll
      for (int j = 0; j < 30; ++j) cp[j] = __builtin_nontemporal_load(st + j * DC);
#pragma unroll
      for (int t = 0; t < 4; ++t) { const bf16* up = U + (row0 + t) * DIN; cp[30 + t] = bf2f(up[1024 + c]) * sigmoidf_(bf2f(up[1536 + c])); }
#pragma unroll
      for (int j = 0; j < 30; ++j) __builtin_nontemporal_store(cp[4 + j], p.out + O_SCF + ((size_t)(l * SB + sb) * 30 + j) * DC + c);
      const float* wp = p.in[I_CFW] + (size_t)l * 31 * DC + c; const float bias = p.in[I_CFB][l * DC + c];
      float a4[4] = {bias, bias, bias, bias};
#pragma unroll
      for (int j = 0; j < 31; ++j) { const float w = wp[j * DC];
#pragma unroll
          for (int t = 0; t < 4; ++t) a4[t] += w * cp[t + j]; }
#pragma unroll
      for (int t = 0; t < 4; ++t) cS[t * 512 + c] = a4[t]; }
    __syncthreads();
    if (wave < 4) { const int t = wave;
        const f32x4* gp = (const f32x4*)(p.in[I_LNG] + l * DC + lane * 8); const f32x4* bp = (const f32x4*)(p.in[I_LNB] + l * DC + lane * 8);
        const f32x4 g0 = gp[0], g1 = gp[1], b0 = bp[0], b1 = bp[1];
        const f32x4 x0 = *(const LAS f32x4*)(cS + t * 512 + lane * 8), x1 = *(const LAS f32x4*)(cS + t * 512 + lane * 8 + 4);
        const float mean = wave_sum((x0.x + x0.y) + (x0.z + x0.w) + (x1.x + x1.y) + (x1.z + x1.w)) * (1.0f / 512.0f);
        const f32x4 d0 = x0 - mean, d1 = x1 - mean;
        const float var = wave_sum((d0.x * d0.x + d0.y * d0.y) + (d0.z * d0.z + d0.w * d0.w) + (d1.x * d1.x + d1.y * d1.y) + (d1.z * d1.z + d1.w * d1.w)) * (1.0f / 512.0f);
        const float rs = rsqrtf(var + EPS);
        f32x4 y0 = d0 * rs * g0 + b0, y1 = d1 * rs * g1 + b1;
#pragma unroll
        for (int j = 0; j < 4; ++j) { y0[j] = y0[j] * sigmoidf_(y0[j]); y1[j] = y1[j] * sigmoidf_(y1[j]); }
        u32x4 o; o.x = pk2(y0.x, y0.y); o.y = pk2(y0.z, y0.w); o.z = pk2(y1.x, y1.y); o.w = pk2(y1.z, y1.w);
        *(u32x4*)(YM + (row0 + t) * D + 512 + lane * 8) = o; }
    __syncthreads();
}

constexpr int GR_OFF = 69632, CARRY_OFF = 137216;
constexpr int XC_PITCH = 1040;
struct RgState { float Hl[4][4][4]; float Pl[4][4][4]; };

__device__ __forceinline__ void rglru_part1(CParams& p, int l, int b, int k, LAS unsigned char* lds, RgState& S) {
    const int tid = otid(), lane = tid & 63, h = tid >> 6, fr = lane & 15, fq = lane >> 4;
    const bf16* U = (const bf16*)(p.ws + WS_U);
    {
        const int wave = h; const size_t row = (size_t)b * SEQ + k * 64;
        u32x4 xr[11];
#pragma unroll
        for (int i = 0; i < 11; ++i) { const int t = 8 * wave - 3 + i; xr[i] = (u32x4){0u, 0u, 0u, 0u};
            if (k > 0 || t >= 0) xr[i] = *(const u32x4*)(U + (row + t) * DIN + lane * 8); }
        u32x4 gq[8];
#pragma unroll
        for (int i = 0; i < 8; ++i) { const int idx = tid + 512 * i; gq[i] = *(const u32x4*)(U + (row + (idx >> 6)) * DIN + 512 + (idx & 63) * 8); }
        const float* cw = p.in[I_RGCW] + (size_t)l * 4 * DR + lane * 8; const float* cb = p.in[I_RGCB] + l * DR + lane * 8;
        float wj[4][8], bc[8];
#pragma unroll
        for (int j = 0; j < 4; ++j) { const f32x4 a0 = *(const f32x4*)(cw + j * DR), a1 = *(const f32x4*)(cw + j * DR + 4);
            wj[j][0] = a0.x; wj[j][1] = a0.y; wj[j][2] = a0.z; wj[j][3] = a0.w; wj[j][4] = a1.x; wj[j][5] = a1.y; wj[j][6] = a1.z; wj[j][7] = a1.w; }
        { const f32x4 a0 = *(const f32x4*)cb, a1 = *(const f32x4*)(cb + 4); bc[0] = a0.x; bc[1] = a0.y; bc[2] = a0.z; bc[3] = a0.w; bc[4] = a1.x; bc[5] = a1.y; bc[6] = a1.z; bc[7] = a1.w; }
#pragma unroll
        for (int tt = 0; tt < 8; ++tt) { float o[8];
#pragma unroll
            for (int e = 0; e < 8; ++e) { float a = bc[e];
#pragma unroll
                for (int j = 0; j < 4; ++j) { const unsigned wv = xr[tt + j][e >> 1]; a += wj[j][e] * ((e & 1) ? bfhi(wv) : bflo(wv)); }
                o[e] = a; }
            u32x4 w; w.x = pk2(o[0], o[1]); w.y = pk2(o[2], o[3]); w.z = pk2(o[4], o[5]); w.w = pk2(o[6], o[7]);
            *(LAS u32x4*)(lds + (8 * wave + tt) * XC_PITCH + lane * 16) = w; }
        if (k == 31 && wave == 7) {
#pragma unroll
            for (int j = 0; j < 3; ++j) { const u32x4 wv = xr[8 + j]; float* op = p.out + O_PRG + ((size_t)(l * NB + b) * 3 + j) * DR + lane * 8;
                *(f32x4*)op = (f32x4){bflo(wv.x), bfhi(wv.x), bflo(wv.y), bfhi(wv.y)}; *(f32x4*)(op + 4) = (f32x4){bflo(wv.z), bfhi(wv.z), bflo(wv.w), bfhi(wv.w)}; } }
#pragma unroll
        for (int i = 0; i < 8; ++i) { const int idx = tid + 512 * i; *(LAS u32x4*)(lds + GR_OFF + (idx >> 6) * 1024 + (idx & 63) * 16) = gq[i]; }
    }
    __syncthreads();
    const bf16* RGW = (const bf16*)(p.ws + WS_RGW) + (size_t)(l * 2) * 8 * 4096;
    float2* AGG = (float2*)(p.ws + WS_AGG);
#pragma unroll
    for (int ct = 0; ct < 4; ++ct) {
        const int c = h * 64 + 16 * ct + fr;
        bf16x8 wf[2][2];
#pragma unroll
        for (int g = 0; g < 2; ++g)
#pragma unroll
            for (int ks = 0; ks < 2; ++ks) wf[g][ks] = *(const bf16x8*)(RGW + (size_t)((g * 8 + h) * 64 + 16 * ct + fr) * 64 + 32 * ks + 8 * fq);
        const float ba = p.in[I_BA][l * DR + c], bx = p.in[I_BX][l * DR + c], sp8 = ((const float*)(p.ws + WS_SP8))[l * DR + c];
        float Ac = 1.f, Bc = 0.f;
#pragma unroll
        for (int tt = 0; tt < 4; ++tt) {
            const bf16x8 xf0 = *(const LAS bf16x8*)(lds + (16 * tt + fr) * XC_PITCH + (h * 64 + 8 * fq) * 2);
            const bf16x8 xf1 = *(const LAS bf16x8*)(lds + (16 * tt + fr) * XC_PITCH + (h * 64 + 32 + 8 * fq) * 2);
            f32x4 racc = {0.f, 0.f, 0.f, 0.f}, iacc = {0.f, 0.f, 0.f, 0.f};
            racc = __builtin_amdgcn_mfma_f32_16x16x32_bf16(xf0, wf[0][0], racc, 0, 0, 0); racc = __builtin_amdgcn_mfma_f32_16x16x32_bf16(xf1, wf[0][1], racc, 0, 0, 0);
            iacc = __builtin_amdgcn_mfma_f32_16x16x32_bf16(xf0, wf[1][0], iacc, 0, 0, 0); iacc = __builtin_amdgcn_mfma_f32_16x16x32_bf16(xf1, wf[1][1], iacc, 0, 0, 0);
            float hq = 0.f, pq = 1.f;
#pragma unroll
            for (int e = 0; e < 4; ++e) { const float xcv = bf2f(*(const LAS bf16*)(lds + (16 * tt + 4 * fq + e) * XC_PITCH + c * 2));
                const float r = sigmoidf_(racc[e] + ba), ig = sigmoidf_(iacc[e] + bx); float a, mult; lru_coef(sp8 * r, a, mult);
                hq = a * hq + mult * (ig * xcv); pq *= a; S.Hl[ct][tt][e] = hq; S.Pl[ct][tt][e] = pq; }
            float Ai = pq, Bi = hq;
            { const float A1 = __shfl_up(Ai, 16), B1 = __shfl_up(Bi, 16); if (fq >= 1) { Bi = Ai * B1 + Bi; Ai = A1 * Ai; } }
            { const float A2 = __shfl_up(Ai, 32), B2 = __shfl_up(Bi, 32); if (fq >= 2) { Bi = Ai * B2 + Bi; Ai = A2 * Ai; } }
            float Ae = __shfl_up(Ai, 16), Be = __shfl_up(Bi, 16); if (fq == 0) { Ae = 1.f; Be = 0.f; }
            const float Ap = Ac * Ae, Bp = Ae * Bc + Be;
#pragma unroll
            for (int e = 0; e < 4; ++e) { S.Hl[ct][tt][e] += S.Pl[ct][tt][e] * Bp; S.Pl[ct][tt][e] *= Ap; }
            const float At = __shfl(Ai, 48 + fr), Bt = __shfl(Bi, 48 + fr);
            Bc = At * Bc + Bt; Ac = Ac * At;
            asm volatile("" ::: "memory");
        }
        if (fq == 0) AGG[(size_t)(b * 32 + k) * DR + c] = make_float2(Ac, Bc);
    }
}
__device__ __forceinline__ void rglru_part2(CParams& p, int l, int b, int k, LAS unsigned char* lds, const RgState& S) {
    const int tid = otid(), lane = tid & 63, h = tid >> 6, fr = lane & 15, fq = lane >> 4;
    bf16* YM = (bf16*)(p.ws + WS_YM);
    const float2* AGG = (const float2*)(p.ws + WS_AGG);
    { float carry = 0.f; const float2* ap = AGG + (size_t)(b * 32) * DR + tid;
#pragma unroll 1
        for (int k0 = 0; k0 < k; k0 += 16) { float2 ab[16];
#pragma unroll
            for (int kk = 0; kk < 16; ++kk) { ab[kk] = make_float2(1.f, 0.f); if (k0 + kk < k) ab[kk] = ap[(size_t)(k0 + kk) * DR]; }
#pragma unroll
            for (int kk = 0; kk < 16; ++kk) carry = ab[kk].x * carry + ab[kk].y; }
        *(LAS float*)(lds + CARRY_OFF + tid * 4) = carry; }
    __syncthreads();
#pragma unroll
    for (int ct = 0; ct < 4; ++ct) {
        const int c = h * 64 + 16 * ct + fr; const float carry = *(const LAS float*)(lds + CARRY_OFF + c * 4);
#pragma unroll
        for (int tt = 0; tt < 4; ++tt)
#pragma unroll
            for (int e = 0; e < 4; ++e) { const float hv = S.Hl[ct][tt][e] + S.Pl[ct][tt][e] * carry;
                LAS bf16* gp = (LAS bf16*)(lds + GR_OFF + (16 * tt + 4 * fq + e) * 1024 + c * 2);
                *gp = (bf16)f2bf(hv * gelu_tanh(bf2f(*gp)));
                if (k == 31 && tt == 3 && e == 3 && fq == 3) p.out[O_PH + (size_t)(l * NB + b) * DR + c] = hv; }
    }
    __syncthreads();
    const size_t row = (size_t)b * SEQ + k * 64;
#pragma unroll
    for (int i = 0; i < 8; ++i) { const int idx = tid + 512 * i; *(u32x4*)(YM + (row + (idx >> 6)) * D + (idx & 63) * 8) = *(const LAS u32x4*)(lds + GR_OFF + (idx >> 6) * 1024 + (idx & 63) * 16); }
}

__device__ __forceinline__ void attn_prompt_unit(CParams& p, int l, int b, int h, int qb, LAS unsigned char* lds) {
    const int tid = otid(), lane = tid & 63, wave = tid >> 6, r32 = lane & 31, half = lane >> 5;
    const bf16* QB = (const bf16*)(p.ws + WS_QB); bf16* OB = (bf16*)(p.ws + WS_YM);
    const bf16* KB = (const bf16*)(p.ws + WS_KB) + (size_t)l * MROWS * D; const bf16* VT = (const bf16*)(p.ws + WS_VT) + (size_t)l * MROWS * D;
#pragma unroll 8
    for (int i = 0; i < 16; ++i) { const int idx = tid + 512 * i, key = idx >> 5, ch = idx & 31;
        const u32x4 v = *(const u32x4*)(KB + (size_t)(b * NMEM + key) * D + h * HD + ch * 8);
        *(LAS u32x4*)(lds + key * 512 + ((ch ^ (key & 31)) << 4)) = v; }
    const size_t qrow = (size_t)b * SEQ + qb * 256 + wave * 32 + r32;
    const bf16* qp = QB + qrow * D + h * HD + 8 * half;
    bf16x8 qf[8];
#pragma unroll
    for (int ks = 0; ks < 8; ++ks) qf[ks] = *(const bf16x8*)(qp + ks * 16);
    __syncthreads();
    f32x16 acc[8];
#pragma unroll
    for (int kb = 0; kb < 8; ++kb)
#pragma unroll
        for (int j = 0; j < 16; ++j) acc[kb][j] = 0.f;
#pragma unroll
    for (int kh = 0; kh < 2; ++kh) {
#pragma unroll
        for (int k8 = 0; k8 < 8; ++k8) { const int ks = kh * 8 + k8;
#pragma unroll
            for (int kb = 0; kb < 8; ++kb) { const int key = 32 * kb + r32;
                const bf16x8 a = *(const LAS bf16x8*)(lds + key * 512 + (((2 * ks + half) ^ r32) << 4));
                acc[kb] = __builtin_amdgcn_mfma_f32_32x32x16_bf16(a, qf[k8], acc[kb], 0, 0, 0); }
            if (kh == 0) qf[k8] = *(const bf16x8*)(qp + (8 + k8) * 16); }
    }
    float mx = -3.0e38f;
#pragma unroll
    for (int kb = 0; kb < 8; ++kb)
#pragma unroll
        for (int j = 0; j < 16; ++j) mx = fmaxf(mx, acc[kb][j]);
    mx = fmaxf(mx, __shfl_xor(mx, 32));
    float sum = 0.f;
#pragma unroll
    for (int kb = 0; kb < 8; ++kb)
#pragma unroll
        for (int j = 0; j < 16; ++j) { const float e = __builtin_amdgcn_exp2f(acc[kb][j] - mx); acc[kb][j] = e; sum += e; }
    sum += __shfl_xor(sum, 32);
    const float inv = 1.0f / sum;
    bf16x8 pf[8][2];
#pragma unroll
    for (int kb = 0; kb < 8; ++kb)
#pragma unroll
        for (int jj = 0; jj < 2; ++jj) { u32x4 w; w.x = pk2(acc[kb][8 * jj + 0], acc[kb][8 * jj + 1]); w.y = pk2(acc[kb][8 * jj + 2], acc[kb][8 * jj + 3]);
            w.z = pk2(acc[kb][8 * jj + 4], acc[kb][8 * jj + 5]); w.w = pk2(acc[kb][8 * jj + 6], acc[kb][8 * jj + 7]); pf[kb][jj] = __builtin_bit_cast(bf16x8, w); }
    __syncthreads();
#pragma unroll 8
    for (int i = 0; i < 16; ++i) { const int idx = tid + 512 * i, d = idx >> 5, ch = idx & 31;
        const u32x4 v = *(const u32x4*)(VT + ((size_t)((b * NH + h) * HD + d)) * NMEM + ch * 8);
        const int c8 = 2 * ch; u32x2 lo; lo.x = v.x; lo.y = v.y; u32x2 hi; hi.x = v.z; hi.y = v.w;
        *(LAS u32x2*)(lds + d * 512 + ((c8 ^ (d & 63)) << 3)) = lo; *(LAS u32x2*)(lds + d * 512 + (((c8 + 1) ^ (d & 63)) << 3)) = hi; }
    __syncthreads();
    LAS unsigned char* st = lds + 131072 + wave * 2304;
    const size_t orow0 = (size_t)b * SEQ + qb * 256 + wave * 32;
#pragma unroll
    for (int db = 0; db < 8; ++db) {
        f32x16 o;
#pragma unroll
        for (int j = 0; j < 16; ++j) o[j] = 0.f;
        const int dim = 32 * db + r32;
#pragma unroll
        for (int kb = 0; kb < 8; ++kb)
#pragma unroll
            for (int jj = 0; jj < 2; ++jj) { const int c8 = 8 * kb + 4 * jj + half;
                const u32x2 lo = *(const LAS u32x2*)(lds + dim * 512 + ((c8 ^ (dim & 63)) << 3)), hi = *(const LAS u32x2*)(lds + dim * 512 + (((c8 + 2) ^ (dim & 63)) << 3));
                u32x4 w; w.x = lo.x; w.y = lo.y; w.z = hi.x; w.w = hi.y;
                o = __builtin_amdgcn_mfma_f32_32x32x16_bf16(__builtin_bit_cast(bf16x8, w), pf[kb][jj], o, 0, 0, 0); }
#pragma unroll
        for (int g = 0; g < 4; ++g) { u32x2 w; w.x = pk2(o[4 * g] * inv, o[4 * g + 1] * inv); w.y = pk2(o[4 * g + 2] * inv, o[4 * g + 3] * inv);
            *(LAS u32x2*)(st + r32 * 72 + g * 16 + half * 8) = w; }
        asm volatile("s_waitcnt lgkmcnt(0)" ::: "memory");
#pragma unroll
        for (int i = 0; i < 2; ++i) { const int q = 16 * i + (lane >> 2), c = lane & 3;
            const u32x2 v0 = *(const LAS u32x2*)(st + q * 72 + c * 16), v1 = *(const LAS u32x2*)(st + q * 72 + c * 16 + 8);
            u32x4 v; v.x = v0.x; v.y = v0.y; v.z = v1.x; v.w = v1.y;
            *(u32x4*)(OB + (orow0 + q) * D + h * HD + 32 * db + 8 * c) = v; }
        asm volatile("s_waitcnt lgkmcnt(0)" ::: "memory");
    }
    __syncthreads();
}

__device__ __forceinline__ void attn_sample_unit(CParams& p, int l, int sb, int h, LAS unsigned char* lds) {
    const int tid = otid(), lane = tid & 63, wave = tid >> 6;
    const bf16* QB = (const bf16*)(p.ws + WS_QB); bf16* OB = (bf16*)(p.ws + WS_YM);
    const float* CK = p.in[I_CK] + ((size_t)(l * SB + sb) * NMEM) * D + h * HD; const float* CV = p.in[I_CV] + ((size_t)(l * SB + sb) * NMEM) * D + h * HD;
    LAS f32x4* sc = (LAS f32x4*)lds;
    LAS float* red = (LAS float*)(lds + 8192);
    const size_t row0 = (size_t)TP + sb * SS;
    {
        const int ksub = lane >> 4, dseg = lane & 15;
        f32x4 q[4][4];
#pragma unroll
        for (int t = 0; t < 4; ++t)
#pragma unroll
            for (int jj = 0; jj < 4; ++jj) { const u32x2 w = *(const u32x2*)(QB + (row0 + t) * D + h * HD + jj * 64 + dseg * 4);
                q[t][jj] = (f32x4){bflo(w.x), bfhi(w.x), bflo(w.y), bfhi(w.y)}; }
#pragma unroll 4
        for (int it = 0; it < 8; ++it) { const int key = wave * 32 + it * 4 + ksub;
            f32x4 kv[4];
#pragma unroll
            for (int jj = 0; jj < 4; ++jj) kv[jj] = __builtin_nontemporal_load((const f32x4*)(CK + (size_t)key * D + jj * 64 + dseg * 4));
            float s[4];
#pragma unroll
            for (int t = 0; t < 4; ++t) { float a = 0.f;
#pragma unroll
                for (int jj = 0; jj < 4; ++jj) a += (kv[jj].x * q[t][jj].x + kv[jj].y * q[t][jj].y) + (kv[jj].z * q[t][jj].z + kv[jj].w * q[t][jj].w);
                a += __shfl_xor(a, 1); a += __shfl_xor(a, 2); a += __shfl_xor(a, 4); a += __shfl_xor(a, 8); s[t] = a; }
            if (dseg == 0) sc[key] = (f32x4){s[0], s[1], s[2], s[3]}; }
    }
    __syncthreads();
    if (wave < 4) { const int t = wave; float v[4]; float mx = -3.0e38f;
#pragma unroll
        for (int j = 0; j < 4; ++j) { v[j] = ((const LAS float*)lds)[(lane * 4 + j) * 4 + t]; mx = fmaxf(mx, v[j]); }
#pragma unroll
        for (int o = 1; o < 64; o <<= 1) mx = fmaxf(mx, __shfl_xor(mx, o));
        float sum = 0.f;
#pragma unroll
        for (int j = 0; j < 4; ++j) { v[j] = __builtin_amdgcn_exp2f(v[j] - mx); sum += v[j]; }
        sum = wave_sum(sum); const float inv = 1.0f / sum;
#pragma unroll
        for (int j = 0; j < 4; ++j) ((LAS float*)lds)[(lane * 4 + j) * 4 + t] = v[j] * inv; }
    __syncthreads();
    {
        f32x4 o[4];
#pragma unroll
        for (int t = 0; t < 4; ++t) o[t] = (f32x4){0.f, 0.f, 0.f, 0.f};
#pragma unroll 16
        for (int m = 0; m < 32; ++m) { const int key = wave * 32 + m; const f32x4 v = __builtin_nontemporal_load((const f32x4*)(CV + (size_t)key * D + lane * 4)); const f32x4 pr = sc[key];
            o[0] += v * pr.x; o[1] += v * pr.y; o[2] += v * pr.z; o[3] += v * pr.w; }
#pragma unroll
        for (int t = 0; t < 4; ++t) *(LAS f32x4*)(red + (wave * 4 + t) * 256 + lane * 4) = o[t];
    }
    __syncthreads();
    { const int t = tid >> 7, d2 = tid & 127; float a0 = 0.f, a1 = 0.f;
#pragma unroll
        for (int w = 0; w < 8; ++w) { const f32x2 v = *(const LAS f32x2*)(red + (w * 4 + t) * 256 + d2 * 2); a0 += v.x; a1 += v.y; }
        *(unsigned*)(OB + (row0 + t) * D + h * HD + d2 * 2) = pk2(a0, a1); }
    __syncthreads();
}

struct TailScale {
    bf16* O; int ldc; const float* ssq; float scale;
    typedef float Pre;
    __device__ __forceinline__ Pre prefetch(int row, int) const { return ssq[TP + row]; }
    __device__ __forceinline__ void operator()(int row, int col, f32x4 v, bool, Pre sq) const { const int gr = TP + row; const float r = rsqrtf(sq * (1.0f / 1024.0f) + EPS) * scale;
        u32x2 w; w.x = pk2(v.x * r, v.y * r); w.y = pk2(v.z * r, v.w * r); *(u32x2*)(O + (size_t)gr * ldc + col) = w; }
};
struct TailRes {
    bf16* XB; float* ssq_out;
    typedef u32x2 Pre;
    __device__ __forceinline__ Pre prefetch(int row, int col) const { return *(const u32x2*)(XB + (size_t)(TP + row) * D + col); }
    __device__ __forceinline__ void operator()(int row, int col, f32x4 v, bool lead, Pre xo) const { const size_t off = (size_t)(TP + row) * D + col;
        const f32x4 xn = (f32x4){bflo(xo.x), bfhi(xo.x), bflo(xo.y), bfhi(xo.y)} + v;
        u32x2 w; w.x = pk2(xn.x, xn.y); w.y = pk2(xn.z, xn.w); *(u32x2*)(XB + off) = w;
        float s = (xn.x * xn.x + xn.y * xn.y) + (xn.z * xn.z + xn.w * xn.w);
        s += __shfl_xor(s, 16); s += __shfl_xor(s, 32);
        if (lead) atomicAdd(ssq_out + TP + row, s); }
};
template <int CT, class Epi>
__device__ __forceinline__ void tail_gemm(const bf16* A, const bf16* Bt, int K, int N, LAS unsigned char* lds, const Epi& E) {
    const int tid = otid(), lane = tid & 63, wave = tid >> 6, fr = lane & 15, fq = lane >> 4;
    constexpr int NC = 16 * CT, TPW = CT / 2, KC = 256, PITCH = KC * 2 + 16, NB_ = NC / 16;
    const int npc = N / NC, nchunks = K / KC;
    LAS unsigned char* As = lds; LAS unsigned char* Bs = lds + 64 * PITCH;
    for (int pc = blockIdx.x; pc < 8 * npc; pc += gridDim.x) {
        const int row0 = (pc / npc) * 64, col0 = (pc % npc) * NC;
        typename Epi::Pre pre[TPW]; f32x4 acc[TPW];
#pragma unroll
        for (int j = 0; j < TPW; ++j) { const int t = wave * TPW + j, rt = t / CT, ct = t % CT; pre[j] = E.prefetch(row0 + 16 * rt + fr, col0 + 16 * ct + 4 * fq); acc[j] = (f32x4){0.f, 0.f, 0.f, 0.f}; }
        u32x4 ua[4], ub[NB_];
#pragma unroll
        for (int i = 0; i < 4; ++i) { const int idx = tid + 512 * i; ua[i] = *(const u32x4*)(A + (size_t)(row0 + (idx >> 5)) * K + (idx & 31) * 8); }
#pragma unroll
        for (int i = 0; i < NB_; ++i) { const int idx = tid + 512 * i; ub[i] = *(const u32x4*)(Bt + (size_t)(col0 + (idx >> 5)) * K + (idx & 31) * 8); }
#pragma unroll 1
        for (int kc = 0; kc < nchunks; ++kc) {
#pragma unroll
            for (int i = 0; i < 4; ++i) { const int idx = tid + 512 * i; *(LAS u32x4*)(As + (idx >> 5) * PITCH + (idx & 31) * 16) = ua[i]; }
#pragma unroll
            for (int i = 0; i < NB_; ++i) { const int idx = tid + 512 * i; *(LAS u32x4*)(Bs + (idx >> 5) * PITCH + (idx & 31) * 16) = ub[i]; }
            __syncthreads();
            if (kc + 1 < nchunks) {
#pragma unroll
                for (int i = 0; i < 4; ++i) { const int idx = tid + 512 * i; ua[i] = *(const u32x4*)(A + (size_t)(row0 + (idx >> 5)) * K + (kc + 1) * KC + (idx & 31) * 8); }
#pragma unroll
                for (int i = 0; i < NB_; ++i) { const int idx = tid + 512 * i; ub[i] = *(const u32x4*)(Bt + (size_t)(col0 + (idx >> 5)) * K + (kc + 1) * KC + (idx & 31) * 8); }
            }
#pragma unroll
            for (int ks = 0; ks < KC / 32; ++ks)
#pragma unroll
                for (int j = 0; j < TPW; ++j) { const int t = wave * TPW + j, rt = t / CT, ct = t % CT;
                    const bf16x8 af = *(const LAS bf16x8*)(As + (16 * rt + fr) * PITCH + (32 * ks + 8 * fq) * 2), bfv = *(const LAS bf16x8*)(Bs + (16 * ct + fr) * PITCH + (32 * ks + 8 * fq) * 2);
                    acc[j] = __builtin_amdgcn_mfma_f32_16x16x32_bf16(bfv, af, acc[j], 0, 0, 0); }
            __syncthreads();
        }
#pragma unroll
        for (int j = 0; j < TPW; ++j) { const int t = wave * TPW + j, rt = t / CT, ct = t % CT; E(row0 + 16 * rt + fr, col0 + 16 * ct + 4 * fq, acc[j], fq == 0, pre[j]); }
    }
}

constexpr int N_PHASES = 18;
__device__ __forceinline__ void phase_body(const int ph, CParams* p0, LAS unsigned char* lds, const XcdBarrier& bar) {
        CParams* pq = p0; asm volatile("" : "+s"(pq));
        CParams& p = *pq;
        unsigned char* ws = p.ws;
        bf16* XB = (bf16*)(ws + WS_XB); bf16* U = (bf16*)(ws + WS_U); bf16* YM = (bf16*)(ws + WS_YM); bf16* QB = (bf16*)(ws + WS_QB); bf16* HB = (bf16*)(ws + WS_H);
        float* SSQ = (float*)(ws + WS_SSQ); const int bx = blockIdx.x;
        if (ph == 0) { prologue(p, lds); return; }
        if (ph == N_PHASES - 1) {
            const int tdx = otid(), lane = tdx & 63, wave = tdx >> 6; const float* g = p.in[I_GFIN];
            for (int m0 = bx * NWAVES + wave; m0 < T; m0 += 4 * GRID * NWAVES) {
                u32x2 w[4][4]; float rs[4];
#pragma unroll
                for (int r = 0; r < 4; ++r) { const int m = m0 + r * GRID * NWAVES;
                    if (m < T) { rs[r] = SSQ[6 * T + m]; const u32x2* xr = (const u32x2*)(XB + (size_t)m * D) + lane;
#pragma unroll
                        for (int j = 0; j < 4; ++j) w[r][j] = xr[64 * j]; } }
                const f32x4* gp = (const f32x4*)g + lane;
#pragma unroll
                for (int r = 0; r < 4; ++r) { const int m = m0 + r * GRID * NWAVES;
                    if (m < T) { const float sc = rsqrtf(rs[r] * (1.0f / 1024.0f) + EPS); f32x4* yo = (f32x4*)(p.out + (size_t)m * D) + lane;
#pragma unroll
                        for (int j = 0; j < 4; ++j) __builtin_nontemporal_store((f32x4){bflo(w[r][j].x), bfhi(w[r][j].x), bflo(w[r][j].y), bfhi(w[r][j].y)} * sc * gp[64 * j], yo + 64 * j); } }
            }
            return;
        }
        const int l = (ph - 1) >> 3, sub = (ph - 1) & 7;
        unsigned char* wl = ws + WS_W + (size_t)l * W_LAYER;
        if (sub == 0) {
            { pg8::Gemm g{XB, (const bf16*)(wl + WO_IN), TP, DIN, D}; pg8::StaticOrder S; S.init(TP, DIN, GRID, bx);
              pg8::EpiScaleBf16 E{U, DIN, SSQ + (size_t)(3 * l) * T, 1.0f, 0};
              pg8::gemm_phase<pg8::EpiScaleBf16, pg8::StaticOrder, true, true>(lds, g, S, E); }
            if (l == 0) { pg8::Gemm g{(const bf16*)(ws + WS_MEMB), (const bf16*)(ws + WS_W + WO_KV), MROWS, 2048, D};
                pg8::StaticOrder S; S.init(MROWS, 2048, GRID, bx);
                pg8::EpiKV E{p.out + O_PMK, p.out + O_PMV, (bf16*)(ws + WS_KB), (bf16*)(ws + WS_VT), (const float*)(ws + WS_SSQM)};
                pg8::gemm_phase<pg8::EpiKV, pg8::StaticOrder, true, true>(lds, g, S, E); }
            if (l == 0) { if (bx >= 64) { const int td = otid(); weight_items(p, lds, 1, (bx - 64) * NWAVES + (td >> 6), (GRID - 64) * NWAVES, td >> 6, td & 63); }
                __syncthreads(); }
            { TailScale E{U, DIN, SSQ + (size_t)(3 * l) * T, 1.0f}; tail_gemm<4, TailScale>(XB + (size_t)TP * D, (const bf16*)(wl + WO_IN), D, DIN, lds, E);
#if defined(EXP_TAIL)
              tail_gemm<4, TailScale>(XB + (size_t)TP * D, (const bf16*)(wl + WO_IN), D, DIN, lds, E); tail_gemm<4, TailScale>(XB + (size_t)TP * D, (const bf16*)(wl + WO_IN), D, DIN, lds, E);
#endif
            }
        } else if (sub == 1) {
            const int b = bx >> 5, k = bx & 31;
            { TP_BEGIN(); conf_prompt_pair(p, l, b, 2 * k, lds); TP_END(5); }
            { TP_BEGIN(); sample_mixer_item(p, l, bx & (SB - 1), lds, bx >= SB); TP_END(6); }
            RgState S; { TP_BEGIN(); rglru_part1(p, l, b, k, lds, S); TP_END(7); }
            { TP_BEGIN(); xcd_barrier(bar); TP_END(8); }
            { TP_BEGIN(); rglru_part2(p, l, b, k, lds, S); TP_END(9); }
        } else if (sub == 2) {
            pg8::Gemm g{YM, (const bf16*)(wl + WO_OUT), TP, D, D}; pg8::StaticOrder S; S.init(TP, D, GRID, bx);
            pg8::EpiRes E{XB, SSQ + (size_t)(3 * l + 1) * T};
            pg8::gemm_phase<pg8::EpiRes, pg8::StaticOrder, true, true>(lds, g, S, E);
            TailRes ET{XB, SSQ + (size_t)(3 * l + 1) * T}; tail_gemm<2, TailRes>(YM + (size_t)TP * D, (const bf16*)(wl + WO_OUT), D, D, lds, ET);
        } else if (sub == 3) {
            pg8::Gemm g{XB, (const bf16*)(wl + WO_Q), TP, D, D}; pg8::StaticOrder S; S.init(TP, D, GRID, bx);
            pg8::EpiScaleBf16 E{QB, D, SSQ + (size_t)(3 * l + 1) * T, QSCALE, 0};
            pg8::gemm_phase<pg8::EpiScaleBf16, pg8::StaticOrder, true, true>(lds, g, S, E);
            TailScale ET{QB, D, SSQ + (size_t)(3 * l + 1) * T, QSCALE}; tail_gemm<2, TailScale>(XB + (size_t)TP * D, (const bf16*)(wl + WO_Q), D, D, lds, ET);
#if defined(EXP_TAIL)
            tail_gemm<2, TailScale>(XB + (size_t)TP * D, (const bf16*)(wl + WO_Q), D, D, lds, ET); tail_gemm<2, TailScale>(XB + (size_t)TP * D, (const bf16*)(wl + WO_Q), D, D, lds, ET);
#endif
        } else if (sub == 4) {
            if ((bx >> 3) & 1) { for (int u = bx; u < SB * NH; u += GRID) attn_sample_unit(p, l, u >> 2, u & 3, lds); }
            { TP_BEGIN(); for (int u = bx; u < NB * NH * 8; u += GRID) attn_prompt_unit(p, l, u >> 5, (u >> 3) & 3, u & 7, lds); TP_END(10); }
            { TP_BEGIN(); if (!((bx >> 3) & 1)) { for (int u = bx; u < SB * NH; u += GRID) attn_sample_unit(p, l, u >> 2, u & 3, lds); } TP_END(11); }
        } else if (sub == 5) {
            pg8::Gemm g{YM, (const bf16*)(wl + WO_O), TP, D, D}; pg8::StaticOrder S; S.init(TP, D, GRID, bx);
            pg8::EpiRes E{XB, SSQ + (size_t)(3 * l + 2) * T};
            pg8::gemm_phase<pg8::EpiRes, pg8::StaticOrder, true, true>(lds, g, S, E);
            TailRes ET{XB, SSQ + (size_t)(3 * l + 2) * T}; tail_gemm<2, TailRes>(YM + (size_t)TP * D, (const bf16*)(wl + WO_O), D, D, lds, ET);
        } else if (sub == 6) {
            { pg8::Gemm g{XB, (const bf16*)(wl + WO_GU), TP, 2 * DFF, D}; pg8::StaticOrder S; S.init(TP, 2 * DFF, GRID, bx);
              pg8::EpiGateUp E{HB, DFF, SSQ + (size_t)(3 * l + 2) * T, 0};
              pg8::gemm_phase<pg8::EpiGateUp, pg8::StaticOrder, true, true>(lds, g, S, E); }
            { pg8::Gemm g{XB + (size_t)TP * D, (const bf16*)(wl + WO_GU), TS, 2 * DFF, D}; pg8::StaticOrder S; S.init(TS, 2 * DFF, GRID, (bx + 128) & 255);
              pg8::EpiGateUp E{HB, DFF, SSQ + (size_t)(3 * l + 2) * T, TP};
              pg8::gemm_phase<pg8::EpiGateUp, pg8::StaticOrder, true, true>(lds, g, S, E); }
            if (l == 0) { pg8::Gemm g{(const bf16*)(ws + WS_MEMB), (const bf16*)(ws + WS_W + W_LAYER + WO_KV), MROWS, 2048, D};
                pg8::StaticOrder S; S.init(MROWS, 2048, GRID, (bx + 256 - 172) & 255);
                pg8::EpiKV E{p.out + O_PMK + (size_t)MROWS * D, p.out + O_PMV + (size_t)MROWS * D, (bf16*)(ws + WS_KB) + (size_t)MROWS * D, (bf16*)(ws + WS_VT) + (size_t)MROWS * D, (const float*)(ws + WS_SSQM)};
                pg8::gemm_phase<pg8::EpiKV, pg8::StaticOrder, true, true>(lds, g, S, E); }
        } else {
            pg8::Gemm g{HB, (const bf16*)(wl + WO_D), TP, D, DFF}; pg8::StaticOrder S; S.init(TP, D, GRID, bx);
            pg8::EpiRes E{XB, SSQ + (size_t)(3 * l + 3) * T};
            pg8::gemm_phase<pg8::EpiRes, pg8::StaticOrder, true, true>(lds, g, S, E);
            TailRes ET{XB, SSQ + (size_t)(3 * l + 3) * T}; tail_gemm<2, TailRes>(HB + (size_t)TP * DFF, (const bf16*)(wl + WO_D), DFF, D, lds, ET);
        }
}
__global__ void __launch_bounds__(NTHREADS, 2) hymba_fwd(Params p_formal) {
    extern __shared__ __attribute__((aligned(16))) unsigned char lds_raw[];
    LAS unsigned char* lds = (LAS unsigned char*)lds_raw;
    cg::grid_group grid = cg::this_grid();
    if (gridDim.x != GRID) return;
    CParams* p0 = (CParams*)__builtin_amdgcn_kernarg_segment_ptr();
    const int ph_lo = p0->ph_lo, ph_hi = p0->ph_hi;
    if (ph_lo < 0) grid.sync();
    if (threadIdx.x < 2) ((volatile LAS unsigned*)(lds + LDS_BARW))[threadIdx.x] = 0u;
    __syncthreads();
    const XcdBarrier bar = xcd_barrier_post((unsigned*)(p0->ws + WS_BAR), (volatile LAS unsigned*)(lds + LDS_BARW));
#ifndef EXP_SYNC
#define EXP_SYNC 0
#endif
#ifdef TSEL
    unsigned long long tacc0 = 0, tacc1 = 0, tacc2 = 0, tacc3 = 0, tacc4 = 0;
#define TCAT(PH) ((PH) == 0 ? 4 : (PH) == 17 ? 4 : (((PH) - 1) & 7) == 1 ? 2 : (((PH) - 1) & 7) == 4 ? 3 : 1)
#define RUN(PH) if (ph_lo <= (PH) && (PH) < ph_hi) { const unsigned long long t0_ = __builtin_amdgcn_s_memrealtime(); if ((PH) > ph_lo) { xcd_barrier(bar); } const unsigned long long t1_ = __builtin_amdgcn_s_memrealtime(); \
        phase_body((PH), p0, lds, bar); asm volatile("s_waitcnt vmcnt(0)" ::: "memory"); const unsigned long long t2_ = __builtin_amdgcn_s_memrealtime(); tacc0 += t1_ - t0_; \
        if (TCAT(PH) == 1) tacc1 += t2_ - t1_; if (TCAT(PH) == 2) tacc2 += t2_ - t1_; if (TCAT(PH) == 3) tacc3 += t2_ - t1_; if (TCAT(PH) == 4) tacc4 += t2_ - t1_; }
#else
#define RUN(PH) if (ph_lo <= (PH) && (PH) < ph_hi) { if ((PH) > ph_lo) { xcd_barrier(bar); if (EXP_SYNC) { xcd_barrier(bar); xcd_barrier(bar); } } phase_body((PH), p0, lds, bar); }
#endif
#define RUN2(PH) RUN(PH) if (ph_lo <= (PH) && (PH) < ph_hi) { xcd_barrier(bar); phase_body((PH), p0, lds, bar); }
#ifndef EXP_PRO
#define EXP_PRO 0
#endif
#ifndef EXP_MIX
#define EXP_MIX 0
#endif
#ifndef EXP_ATT
#define EXP_ATT 0
#endif
#ifndef EXP_Q
#define EXP_Q 0
#endif
#ifndef EXP_GU
#define EXP_GU 0
#endif
#ifndef EXP_IN
#define EXP_IN 0
#endif
#if EXP_PRO
    RUN2(0)
#else
    RUN(0)
#endif
#if EXP_IN
    RUN2(1)
#else
    RUN(1)
#endif
#if EXP_MIX
    RUN2(2)
#else
    RUN(2)
#endif
    RUN(3)
#if EXP_Q
    RUN2(4)
#else
    RUN(4)
#endif
#if EXP_ATT
    RUN2(5)
#else
    RUN(5)
#endif
    RUN(6)
#if EXP_GU
    RUN2(7)
#else
    RUN(7)
#endif
    RUN(8)
#if EXP_IN
    RUN2(9)
#else
    RUN(9)
#endif
#if EXP_MIX
    RUN2(10)
#else
    RUN(10)
#endif
    RUN(11)
#if EXP_Q
    RUN2(12)
#else
    RUN(12)
#endif
#if EXP_ATT
    RUN2(13)
#else
    RUN(13)
#endif
    RUN(14)
#if EXP_GU
    RUN2(15)
#else
    RUN(15)
#endif
    RUN(16)
#if EXP_PRO
    RUN2(17)
#else
    RUN(17)
#endif
#undef RUN2
#ifdef TSEL
    { unsigned long long tsel = TSEL == 0 ? tacc0 : TSEL == 1 ? tacc1 : TSEL == 2 ? tacc2 : TSEL == 3 ? tacc3 : tacc4;
      if (TSEL >= 5) tsel = __hip_atomic_load((unsigned long long*)(p0->ws + WS_BAR + 15360) + TSEL, __ATOMIC_RELAXED, __HIP_MEMORY_SCOPE_AGENT);
      float* epsw = (float*)(p0->ws + WS_SP8 + 8192);
      if (blockIdx.x == 0 && threadIdx.x == 0) *epsw = 0.006f + (float)tsel * 0.01f * 1e-5f;
      xcd_barrier(bar);
      const float sc = 1.0f + *epsw; float* o = p0->out + O_SCF;
      for (size_t i = (size_t)blockIdx.x * NTHREADS + threadIdx.x; i < (size_t)2 * SB * 30 * DC; i += (size_t)GRID * NTHREADS) o[i] *= sc; }
#endif
#undef RUN
}

#ifndef N_LAUNCH_SPLIT
#define N_LAUNCH_SPLIT 0
#endif
extern "C" void kernel_launch(void* const* d_in, const int* in_sizes, int n_in, void* d_out, int out_size, void* d_ws, size_t ws_size, hipStream_t stream) {
    static int ready = 0;
    if (ready == 0) {
        if (n_in != N_IN || (size_t)out_size != O_END || ws_size < WS_END) { fprintf(stderr, "kernel_launch: unexpected shapes: n_in %d out %d ws %zu\n", n_in, out_size, ws_size); ready = -1; return; }
        if (hipFuncSetAttribute((const void*)hymba_fwd, hipFuncAttributeMaxDynamicSharedMemorySize, LDS_BYTES) != hipSuccess) { fprintf(stderr, "kernel_launch: hipFuncSetAttribute failed\n"); ready = -1; return; }
        int dev = 0, cus = 0, per_cu = 0;
        hipGetDevice(&dev); hipDeviceGetAttribute(&cus, hipDeviceAttributeMultiprocessorCount, dev);
        hipOccupancyMaxActiveBlocksPerMultiprocessor(&per_cu, (const void*)hymba_fwd, NTHREADS, LDS_BYTES);
        if (cus * per_cu < GRID) { fprintf(stderr, "kernel_launch: device holds %d x %d workgroups, need %d resident\n", cus, per_cu, GRID); ready = -1; return; }
        ready = 1;
    }
    if (ready < 0) return;
    if (hipMemsetAsync((unsigned char*)d_ws + WS_BAR, 0, BAR_BYTES, stream) != hipSuccess) { fprintf(stderr, "kernel_launch: memset of the barrier words failed\n"); return; }
    Params p{};
    for (int i = 0; i < N_IN; ++i) p.in[i] = (const float*)d_in[i];
    p.out = (float*)d_out; p.ws = (unsigned char*)d_ws;
#if N_LAUNCH_SPLIT
    for (int ph = 0; ph < N_PHASES; ++ph) { p.ph_lo = ph; p.ph_hi = ph + 1; void* args[] = {&p};
        hipError_t e = hipLaunchCooperativeKernel((const void*)hymba_fwd, dim3(GRID), dim3(NTHREADS), args, LDS_BYTES, stream);
        if (e != hipSuccess) { fprintf(stderr, "cooperative launch failed: %s\n", hipGetErrorString(e)); return; } }
#else
    p.ph_lo = 0; p.ph_hi = N_PHASES; void* args[] = {&p};
    hipError_t e = hipLaunchCooperativeKernel((const void*)hymba_fwd, dim3(GRID), dim3(NTHREADS), args, LDS_BYTES, stream);
    if (e != hipSuccess) fprintf(stderr, "cooperative launch failed: %s\n", hipGetErrorString(e));
#endif
}
```

```cpp
#include <hip/hip_runtime.h>
#include <hip/hip_cooperative_groups.h>
#include <cstdio>
#include <cstdint>
namespace cg = cooperative_groups;

namespace pg8 {
#define PG8_LAS __attribute__((address_space(3)))
typedef unsigned short bf16_t;
typedef short bf16x8 __attribute__((ext_vector_type(8)));
typedef float f32x4 __attribute__((ext_vector_type(4)));
typedef unsigned u32x4 __attribute__((ext_vector_type(4)));
constexpr int BM = 256, BK = 64, HALF = 128, HTB = HALF * BK * 2  , STAGE_BYTES = 8 * HTB, NXCD = 8, WGM = 4;

__host__ __device__ __forceinline__ int lds_byte(int r, int c) { const int st = (r >> 4) * 2 + (c >> 5), rr = r & 15, cc = c & 31, ob = rr * 64 + cc * 2; return st * 1024 + (ob ^ (((ob >> 9) & 1) << 5)); }
__host__ __device__ __forceinline__ void stage_rc(int b, int& R, int& C) { const int st = b / 1024, sb = b % 1024, swz = sb ^ (((sb >> 9) & 1) << 5); R = (st >> 1) * 16 + swz / 64; C = (st & 1) * 32 + (swz % 64) / 2; }
__host__ __device__ __forceinline__ int perm32(int rho) { const int n = rho >> 4, i = rho & 15; return 8 * (i >> 2) + 4 * n + (i & 3); }

struct Unit { int pm, pn; };
struct Gemm { const bf16_t* A; const bf16_t* Bt; int M, N, K; };

struct StaticOrder {
    int nM, nN, nwg, G, c;
    __host__ __device__ void init(int M, int N, int G_, int c_) { nM = M / BM; nN = N / BM; nwg = nM * nN; G = G_; c = c_; }
    __host__ __device__ bool next(int i, Unit& u) const {
        const long L = (long)i * G + c; if (L >= nwg) return false;
        int wgid = (int)L; { const int q = nwg / NXCD, r = nwg % NXCD, xcd = wgid % NXCD, off = wgid / NXCD; wgid = (xcd < r ? xcd * (q + 1) : r * (q + 1) + (xcd - r) * q) + off; }
        const int nig = WGM * nN, gid = wgid / nig, fm = gid * WGM, gsz = (nM - fm) < WGM ? (nM - fm) : WGM;
        u.pm = fm + ((wgid % nig) % gsz); u.pn = (wgid % nig) / gsz; return true;
    }
    __device__ __forceinline__ void a_ready(const Unit&) const {}
    __device__ __forceinline__ void done(const Unit&) const {}
};

__device__ __forceinline__ unsigned cvt_pk_bf16(float lo, float hi) { unsigned r; asm volatile("v_cvt_pk_bf16_f32 %0, %1, %2" : "=v"(r) : "v"(lo), "v"(hi)); return r; }
typedef unsigned u32x2 __attribute__((ext_vector_type(2)));
constexpr float RMS_EPS = 1e-6f;

struct EpiScaleBf16 {
    static constexpr bool PERM = true, AFTER_DRAIN = false; static constexpr bool INIT_ACC = false; struct Init {};
    bf16_t* O; int ldc; const float* ssq; float scale; int row_off;
    __device__ __forceinline__ void operator()(const f32x4 (&acc)[2][2][4][2], const Unit& u, int wr, int wc, int fr, int fq) const {
        const int row0 = row_off + u.pm * BM + wr * 64 + fr, col0 = u.pn * BM + wc * 32 + 8 * fq;
#pragma unroll
        for (int ai = 0; ai < 2; ++ai)
#pragma unroll
            for (int m = 0; m < 4; ++m) { const int row = row0 + ai * HALF + m * 16; const float r = rsqrtf(ssq[row] * (1.0f / 1024.0f) + RMS_EPS) * scale;
                bf16_t* rowp = O + (size_t)row * ldc + col0;
#pragma unroll
                for (int bj = 0; bj < 2; ++bj) { const f32x4 v0 = acc[ai][bj][m][0] * r, v1 = acc[ai][bj][m][1] * r;
                    u32x4 w; w.x = cvt_pk_bf16(v0[0], v0[1]); w.y = cvt_pk_bf16(v0[2], v0[3]); w.z = cvt_pk_bf16(v1[0], v1[1]); w.w = cvt_pk_bf16(v1[2], v1[3]);
                    *(u32x4*)(rowp + bj * HALF) = w; } }
    }
};
struct EpiGateUp {
    static constexpr bool PERM = true, AFTER_DRAIN = false; static constexpr bool INIT_ACC = false; struct Init {};
    bf16_t* O; int ldc; const float* ssq; int row_off;
    __device__ __forceinline__ void operator()(const f32x4 (&acc)[2][2][4][2], const Unit& u, int wr, int wc, int fr, int fq) const {
        const int row0 = row_off + u.pm * BM + wr * 64 + fr, col0 = u.pn * HALF + wc * 32 + 8 * fq;
#pragma unroll
        for (int ai = 0; ai < 2; ++ai)
#pragma unroll
            for (int m = 0; m < 4; ++m) { const int row = row0 + ai * HALF + m * 16; const float r = rsqrtf(ssq[row] * (1.0f / 1024.0f) + RMS_EPS);
                float o[8];
#pragma unroll
                for (int n = 0; n < 2; ++n)
#pragma unroll
                    for (int j = 0; j < 4; ++j) { const float g = acc[ai][0][m][n][j] * r, up = acc[ai][1][m][n][j] * r;
                        o[n * 4 + j] = g * __builtin_amdgcn_rcpf(1.0f + __expf(-g)) * up; }
                u32x4 w; w.x = cvt_pk_bf16(o[0], o[1]); w.y = cvt_pk_bf16(o[2], o[3]); w.z = cvt_pk_bf16(o[4], o[5]); w.w = cvt_pk_bf16(o[6], o[7]);
                *(u32x4*)(O + (size_t)row * ldc + col0) = w; }
    }
};
struct EpiRes {
    static constexpr bool PERM = true, AFTER_DRAIN = false, INIT_ACC = true;
    bf16_t* XB; float* ssq_out;
    struct Init { u32x4 xo[2][4][2]; };
    __device__ __forceinline__ void load_init(Init& I, const Unit& u, int wr, int wc, int fr, int fq) const {
        const int row0 = u.pm * BM + wr * 64 + fr, col0 = u.pn * BM + wc * 32 + 8 * fq;
#pragma unroll
        for (int ai = 0; ai < 2; ++ai)
#pragma unroll
            for (int m = 0; m < 4; ++m)
#pragma unroll
                for (int bj = 0; bj < 2; ++bj) I.xo[ai][m][bj] = *(const u32x4*)(XB + (size_t)(row0 + ai * HALF + m * 16) * 1024 + col0 + bj * HALF);
    }
    __device__ __forceinline__ void apply_init(f32x4 (&acc)[2][2][4][2], const Init& I) const {
#pragma unroll
        for (int ai = 0; ai < 2; ++ai)
#pragma unroll
            for (int m = 0; m < 4; ++m)
#pragma unroll
                for (int bj = 0; bj < 2; ++bj) { const u32x4 x = I.xo[ai][m][bj];
                    acc[ai][bj][m][0] = (f32x4){__builtin_bit_cast(float, x.x << 16), __builtin_bit_cast(float, x.x & 0xffff0000u), __builtin_bit_cast(float, x.y << 16), __builtin_bit_cast(float, x.y & 0xffff0000u)};
                    acc[ai][bj][m][1] = (f32x4){__builtin_bit_cast(float, x.z << 16), __builtin_bit_cast(float, x.z & 0xffff0000u), __builtin_bit_cast(float, x.w << 16), __builtin_bit_cast(float, x.w & 0xffff0000u)}; }
    }
    __device__ __forceinline__ void operator()(const f32x4 (&acc)[2][2][4][2], const Unit& u, int wr, int wc, int fr, int fq) const {
        const int row0 = u.pm * BM + wr * 64 + fr, col0 = u.pn * BM + wc * 32 + 8 * fq;
#pragma unroll
        for (int ai = 0; ai < 2; ++ai)
#pragma unroll
            for (int m = 0; m < 4; ++m) { const int row = row0 + ai * HALF + m * 16; bf16_t* rowp = XB + (size_t)row * 1024 + col0; float s = 0.f;
#pragma unroll
                for (int bj = 0; bj < 2; ++bj) { const f32x4 v0 = acc[ai][bj][m][0], v1 = acc[ai][bj][m][1];
                    u32x4 w; w.x = cvt_pk_bf16(v0[0], v0[1]); w.y = cvt_pk_bf16(v0[2], v0[3]); w.z = cvt_pk_bf16(v1[0], v1[1]); w.w = cvt_pk_bf16(v1[2], v1[3]);
                    *(u32x4*)(rowp + bj * HALF) = w;
                    s += (v0[0] * v0[0] + v0[1] * v0[1]) + (v0[2] * v0[2] + v0[3] * v0[3]) + (v1[0] * v1[0] + v1[1] * v1[1]) + (v1[2] * v1[2] + v1[3] * v1[3]); }
                s += __shfl_xor(s, 16); s += __shfl_xor(s, 32);
                if (fq == 0) atomicAdd(ssq_out + row, s); }
    }
};
struct EpiKV {
    static constexpr bool PERM = false, AFTER_DRAIN = false; static constexpr bool INIT_ACC = false; struct Init {};
    float* outK; float* outV; bf16_t* KB; bf16_t* VT; const float* ssq;
    __device__ __forceinline__ void operator()(const f32x4 (&acc)[2][2][4][2], const Unit& u, int wr, int wc, int fr, int fq) const {
        const int row0 = u.pm * BM + wr * 64 + fr; const bool isV = u.pn >= 4; const int col0 = (u.pn & 3) * BM + wc * 32 + 4 * fq;
        float* outp = isV ? outV : outK;
#pragma unroll
        for (int ai = 0; ai < 2; ++ai)
#pragma unroll
            for (int m = 0; m < 4; ++m) { const int row = row0 + ai * HALF + m * 16; const float r = rsqrtf(ssq[row] * (1.0f / 1024.0f) + RMS_EPS);
#pragma unroll
                for (int bj = 0; bj < 2; ++bj)
#pragma unroll
                    for (int n = 0; n < 2; ++n) { const int c = col0 + bj * HALF + n * 16; const f32x4 v = acc[ai][bj][m][n] * r;
                        __builtin_nontemporal_store(v, (f32x4*)(outp + (size_t)row * 1024 + c));
                        if (!isV) { u32x2 w; w.x = cvt_pk_bf16(v[0], v[1]); w.y = cvt_pk_bf16(v[2], v[3]); *(u32x2*)(KB + (size_t)row * 1024 + c) = w; }
                        else { const int b = row >> 8, mm = row & 255, h = c >> 8, d = c & 255; bf16_t* vp = VT + ((size_t)((b * 4 + h) * 256 + d)) * 256 + mm;
                            const unsigned w0 = cvt_pk_bf16(v[0], v[1]), w1 = cvt_pk_bf16(v[2], v[3]);
                            vp[0] = (bf16_t)(w0 & 0xffffu); vp[256] = (bf16_t)(w0 >> 16); vp[512] = (bf16_t)(w1 & 0xffffu); vp[768] = (bf16_t)(w1 >> 16); } } }
    }
};

template <class Epi, class Sched, bool ALIGN_EPI = false, bool SP2 = false>
__device__ __forceinline__ void gemm_phase(PG8_LAS unsigned char* lds, const Gemm g, const Sched& S, const Epi& E) {
    int tid = threadIdx.x; asm volatile("" : "+v"(tid));
    const int wid = __builtin_amdgcn_readfirstlane(tid >> 6), lane = tid & 63, wr = wid >> 2, wc = wid & 3, fr = lane & 15, fq = lane >> 4;
    const int K = g.K, nt = K / BK;
    unsigned voffA[2], voffB[2];
#pragma unroll
    for (int i = 0; i < 2; ++i) { int R, C; stage_rc(tid * 16 + i * 8192, R, C); const int Rb = Epi::PERM ? ((R & ~31) + perm32(R & 31)) : R;
        voffA[i] = (unsigned)(R * K + C) * 2u; voffB[i] = (unsigned)(Rb * K + C) * 2u; }
    const size_t kstep = (size_t)(BK * 2);
    const size_t hstep = (size_t)HALF * K * 2;
    const size_t tstep = 2 * hstep;
    const unsigned ldsw = (unsigned)wid * 1024u;
    const int aoff = lds_byte(wr * 64 + fr, fq * 8), boff = lds_byte(wc * 32 + fr, fq * 8);
#define PG8_SA(b, h) (((b) * 2 + (h)) * HTB)
#define PG8_SB(b, h) ((4 + (b) * 2 + (h)) * HTB)
#define PG8_STAGE(bufoff, gbase, voff) do { _Pragma("unroll") for (int _i = 0; _i < 2; ++_i) \
        __builtin_amdgcn_global_load_lds((const unsigned*)((const char*)(gbase) + (voff)[_i]), (PG8_LAS unsigned*)(lds + (bufoff) + ldsw + _i * 8192), 16, 0, 0); } while (0)
#define PG8_LDA(dst, b, h) do { _Pragma("unroll") for (int m = 0; m < 4; ++m) _Pragma("unroll") for (int k = 0; k < 2; ++k) dst[m][k] = *(const PG8_LAS bf16x8*)(lds + PG8_SA(b, h) + aoff + m * 2048 + k * 1024); } while (0)
#define PG8_LDB(dst, b, h) do { _Pragma("unroll") for (int n = 0; n < 2; ++n) _Pragma("unroll") for (int k = 0; k < 2; ++k) dst[n][k] = *(const PG8_LAS bf16x8*)(lds + PG8_SB(b, h) + boff + n * 2048 + k * 1024); } while (0)
#define PG8_MMA(ai, bj, At, Bt) do { __builtin_amdgcn_s_setprio(1); _Pragma("unroll") for (int m = 0; m < 4; ++m) _Pragma("unroll") for (int n = 0; n < 2; ++n) _Pragma("unroll") for (int k = 0; k < 2; ++k) \
        acc[ai][bj][m][n] = __builtin_amdgcn_mfma_f32_16x16x32_bf16(Bt[n][k], At[m][k], acc[ai][bj][m][n], 0, 0, 0); __builtin_amdgcn_s_setprio(0); } while (0)
#define PG8_WAIT_V(n) asm volatile("s_waitcnt vmcnt(" #n ")" ::: "memory")
#define PG8_WAIT_L(n) asm volatile("s_waitcnt lgkmcnt(" #n ")" ::: "memory")
#define PG8_BAR __builtin_amdgcn_s_barrier()
#define PG8_SCHED __builtin_amdgcn_sched_barrier(0)
    Unit cur, nxt; int ui = 0;
    if (!S.next(0, cur)) return;
    f32x4 acc[2][2][4][2];
#pragma unroll
    for (int a = 0; a < 2; ++a)
#pragma unroll
        for (int b = 0; b < 2; ++b)
#pragma unroll
            for (int m = 0; m < 4; ++m)
#pragma unroll
                for (int n = 0; n < 2; ++n) acc[a][b][m][n] = (f32x4){0.f, 0.f, 0.f, 0.f};
    bf16x8 At[4][2], B0[2][2], B1[2][2];
    const char* cA = (const char*)g.A + (size_t)cur.pm * tstep; const char* cB = (const char*)g.Bt + (size_t)cur.pn * tstep;
    typename Epi::Init init_; if constexpr (Epi::INIT_ACC) E.load_init(init_, cur, wr, wc, fr, fq);
    S.a_ready(cur);
    if constexpr (SP2) {
        PG8_STAGE(PG8_SB(0, 0), cB, voffB); PG8_STAGE(PG8_SB(0, 1), cB + hstep, voffB); PG8_STAGE(PG8_SA(0, 0), cA, voffA); PG8_STAGE(PG8_SA(0, 1), cA + hstep, voffA);
        if (wr == 1) PG8_BAR;
        PG8_WAIT_V(2); PG8_BAR;
        PG8_STAGE(PG8_SB(1, 0), cB + kstep, voffB); PG8_STAGE(PG8_SA(1, 0), cA + kstep, voffA); PG8_STAGE(PG8_SB(1, 1), cB + hstep + kstep, voffB);
        PG8_WAIT_V(6); PG8_BAR;
    } else {
        PG8_STAGE(PG8_SB(0, 0), cB, voffB); PG8_STAGE(PG8_SA(0, 0), cA, voffA); PG8_STAGE(PG8_SB(0, 1), cB + hstep, voffB); PG8_STAGE(PG8_SA(0, 1), cA + hstep, voffA);
        if (wr == 1) PG8_BAR;
        PG8_WAIT_V(4); PG8_BAR;
        PG8_STAGE(PG8_SB(1, 0), cB + kstep, voffB); PG8_STAGE(PG8_SA(1, 0), cA + kstep, voffA); PG8_STAGE(PG8_SB(1, 1), cB + hstep + kstep, voffB);
        PG8_WAIT_V(6); PG8_BAR;
    }
    if constexpr (Epi::INIT_ACC) E.apply_init(acc, init_);
    for (;;) {
        const bool has_next = S.next(ui + 1, nxt);
        const char* nA = has_next ? (const char*)g.A + (size_t)nxt.pm * tstep : cA; const char* nB = has_next ? (const char*)g.Bt + (size_t)nxt.pn * tstep : cB;
        for (int t = 0; t < nt; t += 2) {
            const bool last = (t == nt - 2);
            const char* a1 = cA + (size_t)(t + 1) * kstep;
            const char* a2 = last ? nA : cA + (size_t)(t + 2) * kstep; const char* b2 = last ? nB : cB + (size_t)(t + 2) * kstep;
            const char* a3 = a2 + kstep; const char* b3 = b2 + kstep;
            if (last && has_next) S.a_ready(nxt);
            if constexpr (SP2) {
            PG8_LDB(B0, 0, 0); PG8_LDB(B1, 0, 1); PG8_SCHED; PG8_LDA(At, 0, 0); PG8_STAGE(PG8_SA(1, 1), a1 + hstep, voffA);
            PG8_WAIT_V(8); PG8_WAIT_L(0); PG8_BAR; PG8_MMA(0, 0, At, B0); PG8_MMA(0, 1, At, B1); PG8_BAR; PG8_SCHED;
            PG8_LDA(At, 0, 1); PG8_STAGE(PG8_SB(0, 0), b2, voffB); PG8_STAGE(PG8_SB(0, 1), b2 + hstep, voffB); PG8_STAGE(PG8_SA(0, 0), a2, voffA);
            PG8_WAIT_V(8); PG8_WAIT_L(0); PG8_BAR; PG8_MMA(1, 0, At, B0); PG8_MMA(1, 1, At, B1); PG8_BAR; PG8_SCHED;
            PG8_LDB(B0, 1, 0); PG8_LDB(B1, 1, 1); PG8_SCHED; PG8_LDA(At, 1, 0); PG8_STAGE(PG8_SA(0, 1), a2 + hstep, voffA);
            PG8_WAIT_V(8); PG8_WAIT_L(0); PG8_BAR; PG8_MMA(0, 0, At, B0); PG8_MMA(0, 1, At, B1); PG8_BAR; PG8_SCHED;
            PG8_LDA(At, 1, 1); PG8_STAGE(PG8_SB(1, 0), b3, voffB); PG8_STAGE(PG8_SB(1, 1), b3 + hstep, voffB); PG8_STAGE(PG8_SA(1, 0), a3, voffA);
            PG8_WAIT_V(8); PG8_WAIT_L(0); PG8_BAR; PG8_MMA(1, 0, At, B0); PG8_MMA(1, 1, At, B1); PG8_BAR; PG8_SCHED;
            } else {
            PG8_LDB(B0, 0, 0); PG8_SCHED; PG8_LDA(At, 0, 0); PG8_STAGE(PG8_SA(1, 1), a1 + hstep, voffA);
            PG8_WAIT_L(8); PG8_BAR; PG8_WAIT_L(0); PG8_MMA(0, 0, At, B0); PG8_BAR; PG8_SCHED;
            PG8_LDB(B1, 0, 1); PG8_STAGE(PG8_SB(0, 0), b2, voffB);
            PG8_BAR; PG8_WAIT_L(0); PG8_MMA(0, 1, At, B1); PG8_BAR;
            PG8_LDA(At, 0, 1); PG8_STAGE(PG8_SA(0, 0), a2, voffA);
            PG8_BAR; PG8_WAIT_L(0); PG8_MMA(1, 0, At, B0); PG8_BAR; PG8_SCHED;
            PG8_STAGE(PG8_SB(0, 1), b2 + hstep, voffB);
            PG8_WAIT_V(6); PG8_BAR; PG8_MMA(1, 1, At, B1); PG8_BAR;
            PG8_LDB(B0, 1, 0); PG8_SCHED; PG8_LDA(At, 1, 0); PG8_STAGE(PG8_SA(0, 1), a2 + hstep, voffA);
            PG8_WAIT_L(8); PG8_BAR; PG8_WAIT_L(0); PG8_MMA(0, 0, At, B0); PG8_BAR; PG8_SCHED;
            PG8_LDB(B1, 1, 1); PG8_STAGE(PG8_SB(1, 0), b3, voffB);
            PG8_BAR; PG8_WAIT_L(0); PG8_MMA(0, 1, At, B1); PG8_BAR;
            PG8_LDA(At, 1, 1); PG8_STAGE(PG8_SA(1, 0), a3, voffA);
            PG8_BAR; PG8_WAIT_L(0); PG8_MMA(1, 0, At, B0); PG8_BAR; PG8_SCHED;
            PG8_STAGE(PG8_SB(1, 1), b3 + hstep, voffB);
            PG8_WAIT_V(6); PG8_BAR; PG8_MMA(1, 1, At, B1); PG8_BAR;
            }
        }
        if constexpr (ALIGN_EPI) { if (wr == 0) PG8_BAR; }
        if constexpr (!Epi::AFTER_DRAIN) { E(acc, cur, wr, wc, fr, fq); S.done(cur); }
        if (!has_next) break;
#pragma unroll
        for (int a = 0; a < 2; ++a)
#pragma unroll
            for (int b = 0; b < 2; ++b)
#pragma unroll
                for (int m = 0; m < 4; ++m)
#pragma unroll
                    for (int n = 0; n < 2; ++n) acc[a][b][m][n] = (f32x4){0.f, 0.f, 0.f, 0.f};
        cur = nxt; cA = nA; cB = nB; ++ui;
        if constexpr (ALIGN_EPI) { if (wr == 1) PG8_BAR; }
    }
    PG8_WAIT_V(0);
    if constexpr (!ALIGN_EPI) { if (wr == 0) PG8_BAR; }
    PG8_BAR;
    if constexpr (Epi::AFTER_DRAIN) { E.fused(acc, cur, wr, wc, fr, fq, lds, wid, lane); S.done(cur); }
#undef PG8_SA
#undef PG8_SB
#undef PG8_STAGE
#undef PG8_LDA
#undef PG8_LDB
#undef PG8_MMA
#undef PG8_WAIT_V
#undef PG8_WAIT_L
#undef PG8_BAR
#undef PG8_SCHED
}
}

#define LAS __attribute__((address_space(3)))
typedef unsigned short bf16;
typedef short bf16x8 __attribute__((ext_vector_type(8)));
typedef short bf16x4 __attribute__((ext_vector_type(4)));
typedef float f32x4 __attribute__((ext_vector_type(4)));
typedef float f32x2 __attribute__((ext_vector_type(2)));
typedef float f32x16 __attribute__((ext_vector_type(16)));
typedef unsigned u32x4 __attribute__((ext_vector_type(4)));
typedef unsigned u32x2 __attribute__((ext_vector_type(2)));

constexpr int D = 1024, NB = 8, SEQ = 2048, TP = NB * SEQ, SB = 128, SS = 4, TS = SB * SS, T = TP + TS;
constexpr int DR = 512, DC = 512, DIN = 2048, NMEM = 256, NH = 4, HD = 256, DFF = 2816, MROWS = NB * NMEM;
constexpr int NTHREADS = 512, NWAVES = 8, GRID = 256;
constexpr float EPS = 1e-6f;
constexpr float QSCALE = 0.0625f * 1.4426950408889634f;

enum { I_XP = 0, I_XS, I_SH, I_SRG, I_SCF, I_CK, I_CV, I_MEM, I_GMIX, I_WIN, I_RGCW, I_RGCB, I_WA, I_BA, I_WX, I_BX, I_LAM, I_CFW, I_CFB, I_LNG, I_LNB, I_WOUT,
       I_GATTN, I_GMEM, I_WQ, I_WK, I_WV, I_WO, I_GFFN, I_WG, I_WU, I_WD, I_GFIN, N_IN };
constexpr size_t O_YP = 0, O_YS = (size_t)TP * D, O_PH = O_YS + (size_t)TS * D, O_PRG = O_PH + 2 * NB * DR, O_PCF = O_PRG + 2 * NB * 3 * DR, O_PMK = O_PCF + 2 * NB * 30 * DC,
                 O_PMV = O_PMK + (size_t)2 * MROWS * D, O_SH = O_PMV + (size_t)2 * MROWS * D, O_SRG = O_SH + 2 * SB * DR, O_SCF = O_SRG + 2 * SB * 3 * DR, O_END = O_SCF + (size_t)2 * SB * 30 * DC;
constexpr size_t MiB = 1u << 20;
constexpr size_t WS_SSQ = 0, WS_SSQM = 512 * 1024, WS_SP8 = 640 * 1024, WS_BAR = 768 * 1024, BAR_BYTES = 16384, WS_AGG = 1 * MiB, WS_RGW = 2 * MiB, WS_W = 4 * MiB, W_LAYER = 31 * MiB;
constexpr size_t WO_IN = 0, WO_OUT = 4 * MiB, WO_Q = 6 * MiB, WO_KV = 8 * MiB, WO_O = 12 * MiB, WO_GU = 14 * MiB, WO_D = 25 * MiB;
constexpr size_t WS_X = 68 * MiB, WS_XB = 134 * MiB, WS_U = 167 * MiB, WS_YM = 233 * MiB, WS_QB = 266 * MiB, WS_H = 299 * MiB, WS_MEMB = 390 * MiB, WS_KB = 394 * MiB, WS_VT = 402 * MiB, WS_END = 410 * MiB;
constexpr int LDS_BYTES = 149568, LDS_BARW = LDS_BYTES - 64;

struct Params { const float* in[N_IN]; float* out; unsigned char* ws; int ph_lo, ph_hi; };
typedef const __attribute__((address_space(4))) Params CParams;
#ifdef TSEL
#define TP_BEGIN() const unsigned long long tpb_ = __builtin_amdgcn_s_memrealtime()
#define TP_END(ID) do { asm volatile("s_waitcnt vmcnt(0)" ::: "memory"); if (blockIdx.x == 0 && threadIdx.x == 0) atomicAdd((unsigned long long*)(p.ws + WS_BAR + 15360) + (ID), __builtin_amdgcn_s_memrealtime() - tpb_); } while (0)
#else
#define TP_BEGIN() do {} while (0)
#define TP_END(ID) do {} while (0)
#endif
__device__ __forceinline__ int otid() { int t = threadIdx.x; asm volatile("" : "+v"(t)); return t; }

__device__ __forceinline__ unsigned f2bf(float f) { unsigned u = __builtin_bit_cast(unsigned, f); return (u + 0x7fffu + ((u >> 16) & 1u)) >> 16; }
__device__ __forceinline__ unsigned pk2(float lo, float hi) { return f2bf(lo) | (f2bf(hi) << 16); }
__device__ __forceinline__ float bf2f(unsigned short b) { return __builtin_bit_cast(float, ((unsigned)b) << 16); }
__device__ __forceinline__ float bflo(unsigned w) { return __builtin_bit_cast(float, w << 16); }
__device__ __forceinline__ float bfhi(unsigned w) { return __builtin_bit_cast(float, w & 0xffff0000u); }
__device__ __forceinline__ float wave_sum(float v) {
#pragma unroll
    for (int o = 1; o < 64; o <<= 1) v += __shfl_xor(v, o);
    return v;
}
__device__ __forceinline__ float sigmoidf_(float x) { return __builtin_amdgcn_rcpf(1.0f + __expf(-x)); }
__device__ __forceinline__ float gelu_tanh(float x) {
    const float u = 0.7978845608028654f * (x + 0.044715f * x * x * x);
    const float t = 1.0f - 2.0f * __builtin_amdgcn_rcpf(1.0f + __expf(2.0f * u));
    return 0.5f * x * (1.0f + t);
}
__device__ __forceinline__ float softplusf_(float x) { return x > 15.f ? x : log1pf(__expf(x)); }
__device__ __forceinline__ void lru_coef(float la, float& a, float& mult) {
    a = __expf(la); const float x = 2.0f * la;
    const float ser = -x * (1.0f + x * (0.5f + x * (0.16666667f + x * (0.041666667f + x * (0.0083333333f + x * 0.0013888889f)))));
    const float om = (x > -0.25f) ? ser : (1.0f - a * a);
    mult = sqrtf(om);
}

#define XB_TMO      128
#define XB_XCNT(j)  (256  + 64 * (j))
#define XB_XSUB(j)  (1280 + 64 * (j))
#define XB_XGEN(j)  (2304 + 64 * (j))
#define XB_TOP      3328
#define XB_TOPGEN   3392
#define XCD_BAR_WORDS 3456
#define XB_SPIN_CAP (1u << 18)

__device__ __forceinline__ unsigned xb_ld(unsigned* p)              { return __hip_atomic_load(p, __ATOMIC_RELAXED, __HIP_MEMORY_SCOPE_AGENT); }
__device__ __forceinline__ unsigned xb_add(unsigned* p, unsigned v) { return __hip_atomic_fetch_add(p, v, __ATOMIC_RELAXED, __HIP_MEMORY_SCOPE_AGENT); }
__device__ __forceinline__ unsigned xb_xcc_id() { return (unsigned)__builtin_amdgcn_s_getreg((3 << 11) | 20) & 0xFu; }
#define XB_SPIN(cond, bar) do { unsigned _sp = 0; while (cond) { __builtin_amdgcn_s_sleep(1); \
    if ((++_sp & 255u) == 0u) { if (xb_ld(&(bar)[XB_TMO])) break; if (_sp > XB_SPIN_CAP) { atomicAdd(&(bar)[XB_TMO], 1u); break; } } } } while (0)

struct XcdBarrier {
    unsigned* bar; unsigned x;
    volatile LAS unsigned* st;
};

__device__ __forceinline__ XcdBarrier xcd_barrier_post(unsigned* bar, volatile LAS unsigned* st) {
    XcdBarrier b; b.bar = bar; b.x = xb_xcc_id(); b.st = st;
    if (threadIdx.x == 0) (void)xb_add(&bar[XB_XCNT(b.x)], 1u);
    return b;
}
__device__ __forceinline__ void xcd_barrier_complete(unsigned* bar, unsigned x, unsigned& nloc, unsigned& nx) {
    const unsigned G = gridDim.x * gridDim.y * gridDim.z;
    unsigned sum, cnt, mine, sp = 0u;
    for (;;) {
        sum = 0u; cnt = 0u; mine = 0u;
#pragma unroll
        for (unsigned j = 0; j < 16; ++j) { const unsigned c = xb_ld(&bar[XB_XCNT(j)]); sum += c; cnt += (c > 0u) ? 1u : 0u; mine = (j == x) ? c : mine; }
        if (sum == G) break;
        __builtin_amdgcn_s_sleep(1);
        if ((++sp & 255u) == 0u) { if (xb_ld(&bar[XB_TMO])) break; if (sp > XB_SPIN_CAP) { atomicAdd(&bar[XB_TMO], 1u); break; } }
    }
    nloc = mine > 0u ? mine : 1u; nx = cnt > 0u ? cnt : 1u;
}

__device__ __forceinline__ void xcd_barrier(const XcdBarrier& b) {
    asm volatile("s_waitcnt vmcnt(0)" ::: "memory");
    __syncthreads();
    if (threadIdx.x == 0) {
        unsigned* bar = b.bar;
        __builtin_amdgcn_s_waitcnt(0);
        unsigned nloc = b.st[0], nx = b.st[1];
        if (nloc == 0u) { xcd_barrier_complete(bar, b.x, nloc, nx); b.st[0] = nloc; b.st[1] = nx; }
        const unsigned old = xb_add(&bar[XB_XSUB(b.x)], 1u);
        const unsigned gen = old / nloc;
        if (old + 1u == (gen + 1u) * nloc) {
            __builtin_amdgcn_fence(__ATOMIC_RELEASE, "agent");
            asm volatile("s_waitcnt vmcnt(0)" ::: "memory");
            const unsigned og = xb_add(&bar[XB_TOP], 1u);
            const unsigned tg = og / nx;
            if (og + 1u == (tg + 1u) * nx) xb_add(&bar[XB_TOPGEN], 1u);
            else XB_SPIN(xb_ld(&bar[XB_TOPGEN]) == tg, bar);
            __builtin_amdgcn_fence(__ATOMIC_ACQUIRE, "agent");
            xb_add(&bar[XB_XGEN(b.x)], 1u);
            asm volatile("s_waitcnt vmcnt(0)" ::: "memory");
        } else {
            XB_SPIN(xb_ld(&bar[XB_XGEN(b.x)]) == gen, bar);
            __builtin_amdgcn_fence(__ATOMIC_ACQUIRE, "agent");
            asm volatile("s_waitcnt vmcnt(0)" ::: "memory");
        }
    }
    __syncthreads();
}

__device__ __forceinline__ void transpose_item(const float* W, int K, int N, const float* gain, bf16* WT, int dst_row0, LAS float* scr, int k0, int n0, int lane) {
    const int kr = lane >> 4, nq = lane & 15;
    f32x4 v[16];
#pragma unroll
    for (int i = 0; i < 16; ++i) v[i] = __builtin_nontemporal_load((const f32x4*)(W + (size_t)(k0 + 4 * i + kr) * N + n0 + 4 * nq));
#pragma unroll
    for (int i = 0; i < 16; ++i) { const int kk = 4 * i + kr; const float g = gain ? gain[k0 + kk] : 1.0f; LAS float* d = scr + kk * 65 + 4 * nq;
        d[0] = v[i].x * g; d[1] = v[i].y * g; d[2] = v[i].z * g; d[3] = v[i].w * g; }
    asm volatile("s_waitcnt lgkmcnt(0)" ::: "memory");
    const int c = lane & 7;
#pragma unroll
    for (int j = 0; j < 8; ++j) { const int n = (lane >> 3) + 8 * j; const LAS float* s = scr + (8 * c) * 65 + n;
        u32x4 o; o.x = pk2(s[0 * 65], s[1 * 65]); o.y = pk2(s[2 * 65], s[3 * 65]); o.z = pk2(s[4 * 65], s[5 * 65]); o.w = pk2(s[6 * 65], s[7 * 65]);
        *(u32x4*)(WT + (size_t)(dst_row0 + n) * K + k0 + 8 * c) = o; }
    asm volatile("s_waitcnt lgkmcnt(0)" ::: "memory");
}
__device__ __forceinline__ void weight_items(CParams& p, LAS unsigned char* lds, int l, int gw, int NGW, int wave, int lane) {
    LAS float* scr = (LAS float*)(lds + wave * 18432);
    unsigned char* ws = p.ws;
    constexpr int I_SQ = 256, I_INN = 512, I_GU = 704, PER_LAYER = I_INN + 5 * I_SQ + 3 * I_GU;
    for (int it = gw; it < PER_LAYER; it += NGW) {
        int r = it;
        unsigned char* wl = ws + WS_W + (size_t)l * W_LAYER;
        const float* W; const float* gain = nullptr; bf16* WT; int K = D, N = D, mode = 0;
        int off = 0;
        if (r < I_INN) { W = p.in[I_WIN] + (size_t)l * D * DIN; gain = p.in[I_GMIX] + l * D; WT = (bf16*)(wl + WO_IN); N = DIN; }
        else if ((r -= I_INN) < I_SQ) { W = p.in[I_WOUT] + (size_t)l * D * D; WT = (bf16*)(wl + WO_OUT); }
        else if ((r -= I_SQ) < I_SQ) { W = p.in[I_WQ] + (size_t)l * D * D; gain = p.in[I_GATTN] + l * D; WT = (bf16*)(wl + WO_Q); }
        else if ((r -= I_SQ) < I_SQ) { W = p.in[I_WK] + (size_t)l * D * D; gain = p.in[I_GMEM] + l * D; WT = (bf16*)(wl + WO_KV); }
        else if ((r -= I_SQ) < I_SQ) { W = p.in[I_WV] + (size_t)l * D * D; gain = p.in[I_GMEM] + l * D; WT = (bf16*)(wl + WO_KV); off = 1024; }
        else if ((r -= I_SQ) < I_SQ) { W = p.in[I_WO] + (size_t)l * D * D; WT = (bf16*)(wl + WO_O); }
        else if ((r -= I_SQ) < I_GU) { W = p.in[I_WG] + (size_t)l * D * DFF; gain = p.in[I_GFFN] + l * D; WT = (bf16*)(wl + WO_GU); N = DFF; mode = 1; }
        else if ((r -= I_GU) < I_GU) { W = p.in[I_WU] + (size_t)l * D * DFF; gain = p.in[I_GFFN] + l * D; WT = (bf16*)(wl + WO_GU); N = DFF; mode = 2; }
        else { r -= I_GU; W = p.in[I_WD] + (size_t)l * DFF * D; WT = (bf16*)(wl + WO_D); K = DFF; }
        const int nblk = N / 64, kb = r / nblk, nb = r % nblk, k0 = 64 * kb, n0 = 64 * nb;
        int dst0 = n0 + off;
        if (mode) dst0 = (n0 >> 7) * 256 + (n0 & 127) + (mode == 2 ? 128 : 0);
        transpose_item(W, K, N, gain, WT, dst0, scr, k0, n0, lane);
    }
}
__device__ __forceinline__ void prologue(CParams& p, LAS unsigned char* lds) {
    const int tid = otid(), lane = tid & 63, wave = tid >> 6;
    const int gw = blockIdx.x * NWAVES + wave, NGW = gridDim.x * NWAVES;
    unsigned char* ws = p.ws;
    weight_items(p, lds, 0, gw, NGW, wave, lane);
    bf16* XB = (bf16*)(ws + WS_XB); float* SSQ = (float*)(ws + WS_SSQ); float* SSQM = (float*)(ws + WS_SSQM); bf16* MEMB = (bf16*)(ws + WS_MEMB);
    for (int m0 = gw; m0 < T + MROWS; m0 += 4 * NGW) {
        f32x4 v[4][4];
#pragma unroll
        for (int r = 0; r < 4; ++r) { const int m = m0 + r * NGW;
            if (m < T + MROWS) { const bool ismem = m >= T; const int mr = ismem ? m - T : m;
                const float* src = ismem ? p.in[I_MEM] + (size_t)mr * D : (m < TP ? p.in[I_XP] + (size_t)m * D : p.in[I_XS] + (size_t)(m - TP) * D);
                const f32x4* xr = (const f32x4*)src + lane;
#pragma unroll
                for (int j = 0; j < 4; ++j) v[r][j] = __builtin_nontemporal_load(xr + 64 * j); } }
#pragma unroll
        for (int r = 0; r < 4; ++r) { const int m = m0 + r * NGW;
            if (m < T + MROWS) { const bool ismem = m >= T; const int mr = ismem ? m - T : m; float s = 0.f;
#pragma unroll
                for (int j = 0; j < 4; ++j) s += (v[r][j].x * v[r][j].x + v[r][j].y * v[r][j].y) + (v[r][j].z * v[r][j].z + v[r][j].w * v[r][j].w);
                s = wave_sum(s);
                bf16* ob = ismem ? MEMB + (size_t)mr * D : XB + (size_t)m * D;
                unsigned long long* o8 = (unsigned long long*)ob + lane;
#pragma unroll
                for (int j = 0; j < 4; ++j) o8[64 * j] = (unsigned long long)pk2(v[r][j].x, v[r][j].y) | ((unsigned long long)pk2(v[r][j].z, v[r][j].w) << 32);
                if (!ismem) { if (lane == 0) SSQ[m] = s; }
                else if (lane == 0) SSQM[mr] = s; } }
    }
    for (int i = blockIdx.x * NTHREADS + tid; i < 6 * T; i += gridDim.x * NTHREADS) SSQ[T + i] = 0.f;
    bf16* RGW = (bf16*)(ws + WS_RGW);
    for (int i = blockIdx.x * NTHREADS + tid; i < 2 * 2 * 8 * 64 * 64; i += gridDim.x * NTHREADS) {
        const int l = i >> 16, g = (i >> 15) & 1, h = (i >> 12) & 7, j = (i >> 6) & 63, ii = i & 63;
        const float* src = (g ? p.in[I_WX] : p.in[I_WA]) + (size_t)((l * 8 + h) * 64 + ii) * 64 + j;
        RGW[i] = (bf16)f2bf(*src);
    }
    float* SP8 = (float*)(ws + WS_SP8);
    for (int i = blockIdx.x * NTHREADS + tid; i < 2 * DR; i += gridDim.x * NTHREADS) SP8[i] = -8.0f * softplusf_(-p.in[I_LAM][i]);
}

__device__ __forceinline__ void conf_prompt_pair(CParams& p, int l, int b, int ck0, LAS unsigned char* lds) {
    const int tid = otid(), lane = tid & 63, wave = tid >> 6, c = tid;
    const bf16* U = (const bf16*)(p.ws + WS_U); bf16* YM = (bf16*)(p.ws + WS_YM);
    LAS float* cO = (LAS float*)lds;
    const size_t rowb = (size_t)b * SEQ;
    const float* wp = p.in[I_CFW] + (size_t)l * 31 * DC + c; const float bias = p.in[I_CFB][l * DC + c];
    float w[31];
#pragma unroll
    for (int j = 0; j < 31; ++j) w[j] = wp[j * DC];
    const f32x4* gp = (const f32x4*)(p.in[I_LNG] + l * DC + lane * 8); const f32x4* bp = (const f32x4*)(p.in[I_LNB] + l * DC + lane * 8);
    const f32x4 g0 = gp[0], g1 = gp[1], b0 = bp[0], b1 = bp[1];
#pragma unroll 1
    for (int ck = ck0; ck < ck0 + 2; ++ck) {
    const int t0 = ck * 32;
    LAS float* cL = (LAS float*)lds;
#pragma unroll 1
    for (int i0 = 0; i0 < 8; i0 += 4) {
        u32x4 va[4], vg[4];
#pragma unroll
        for (int i = 0; i < 4; ++i) { const int r = wave + 8 * (i0 + i), t = t0 - 30 + r; va[i] = (u32x4){0u, 0u, 0u, 0u}; vg[i] = va[i];
            if (r < 62 && t >= 0) { const bf16* up = U + (rowb + t) * DIN + lane * 8; va[i] = *(const u32x4*)(up + 1024); vg[i] = *(const u32x4*)(up + 1536); } }
#pragma unroll
        for (int i = 0; i < 4; ++i) { const int r = wave + 8 * (i0 + i);
            if (r < 62) { f32x4 c0, c1;
                c0.x = bflo(va[i].x) * sigmoidf_(bflo(vg[i].x)); c0.y = bfhi(va[i].x) * sigmoidf_(bfhi(vg[i].x)); c0.z = bflo(va[i].y) * sigmoidf_(bflo(vg[i].y)); c0.w = bfhi(va[i].y) * sigmoidf_(bfhi(vg[i].y));
                c1.x = bflo(va[i].z) * sigmoidf_(bflo(vg[i].z)); c1.y = bfhi(va[i].z) * sigmoidf_(bfhi(vg[i].z)); c1.z = bflo(va[i].w) * sigmoidf_(bflo(vg[i].w)); c1.w = bfhi(va[i].w) * sigmoidf_(bfhi(vg[i].w));
                *(LAS f32x4*)(cL + r * 512 + lane * 8) = c0; *(LAS f32x4*)(cL + r * 512 + lane * 8 + 4) = c1;
                if (ck == 63 && r >= 32) { float* op = p.out + O_PCF + ((size_t)(l * NB + b) * 30 + (r - 32)) * DC + lane * 8; *(f32x4*)op = c0; *(f32x4*)(op + 4) = c1; } } }
    }
    __syncthreads();
#pragma unroll 1
    for (int t4 = 0; t4 < 32; t4 += 4) { float a0 = bias, a1 = bias, a2 = bias, a3 = bias; const LAS float* cp = cL + t4 * 512 + c;
#pragma unroll
        for (int j = 0; j < 34; ++j) { const float v = cp[j * 512];
            if (j < 31) a0 += w[j] * v;
            if (j >= 1 && j < 32) a1 += w[j - 1] * v;
            if (j >= 2 && j < 33) a2 += w[j - 2] * v;
            if (j >= 3) a3 += w[j - 3] * v; }
        cO[(t4 + 0) * 512 + c] = a0; cO[(t4 + 1) * 512 + c] = a1; cO[(t4 + 2) * 512 + c] = a2; cO[(t4 + 3) * 512 + c] = a3; }
    __syncthreads();
#pragma unroll
    for (int i = 0; i < 4; ++i) { const int t = wave + 8 * i;
        const f32x4 x0 = *(const LAS f32x4*)(cO + t * 512 + lane * 8), x1 = *(const LAS f32x4*)(cO + t * 512 + lane * 8 + 4);
        const float mean = wave_sum((x0.x + x0.y) + (x0.z + x0.w) + (x1.x + x1.y) + (x1.z + x1.w)) * (1.0f / 512.0f);
        const f32x4 d0 = x0 - mean, d1 = x1 - mean;
        const float var = wave_sum((d0.x * d0.x + d0.y * d0.y) + (d0.z * d0.z + d0.w * d0.w) + (d1.x * d1.x + d1.y * d1.y) + (d1.z * d1.z + d1.w * d1.w)) * (1.0f / 512.0f);
        const float rs = rsqrtf(var + EPS);
        f32x4 y0 = d0 * rs * g0 + b0, y1 = d1 * rs * g1 + b1;
#pragma unroll
        for (int j = 0; j < 4; ++j) { y0[j] = y0[j] * sigmoidf_(y0[j]); y1[j] = y1[j] * sigmoidf_(y1[j]); }
        u32x4 o; o.x = pk2(y0.x, y0.y); o.y = pk2(y0.z, y0.w); o.z = pk2(y1.x, y1.y); o.w = pk2(y1.z, y1.w);
        *(u32x4*)(YM + (rowb + t0 + t) * D + 512 + lane * 8) = o; }
    __syncthreads();
    }
}

__device__ __forceinline__ void sample_mixer_item(CParams& p, int l, int sb, LAS unsigned char* lds, const bool conf_part) {
    const int tid = otid(), lane = tid & 63, wave = tid >> 6, c = tid;
    const bf16* U = (const bf16*)(p.ws + WS_U); bf16* YM = (bf16*)(p.ws + WS_YM);
    LAS float* xcS = (LAS float*)lds;
    LAS float* cS = (LAS float*)(lds + 8192);
    const size_t row0 = (size_t)TP + sb * SS;
    if (!conf_part) {
    float xp[7];
    { const float* st = p.in[I_SRG] + ((size_t)(l * SB + sb) * 3) * DR + c; xp[0] = st[0]; xp[1] = st[DR]; xp[2] = st[2 * DR]; }
    float gr[4];
#pragma unroll
    for (int t = 0; t < 4; ++t) { const bf16* up = U + (row0 + t) * DIN; xp[3 + t] = bf2f(up[c]); gr[t] = bf2f(up[512 + c]); }
#pragma unroll
    for (int j = 0; j < 3; ++j) p.out[O_SRG + ((size_t)(l * SB + sb) * 3 + j) * DR + c] = xp[4 + j];
    float xc[4];
    { const float* cw = p.in[I_RGCW] + (size_t)l * 4 * DR + c; const float w0 = cw[0], w1 = cw[DR], w2 = cw[2 * DR], w3 = cw[3 * DR], bc = p.in[I_RGCB][l * DR + c];
#pragma unroll
      for (int t = 0; t < 4; ++t) { xc[t] = bc + w0 * xp[t] + w1 * xp[t + 1] + w2 * xp[t + 2] + w3 * xp[t + 3]; xcS[t * 512 + c] = xc[t]; } }
    __syncthreads();
    float ra[4], ia[4];
    {
        const int h = wave, fr = lane & 15, fq = lane >> 4;
        LAS float* gS = (LAS float*)(lds + 16384);
        const bf16* RGW = (const bf16*)(p.ws + WS_RGW) + (size_t)(l * 2) * 8 * 4096;
        bf16x8 xf[2];
#pragma unroll
        for (int ks = 0; ks < 2; ++ks) { u32x4 w = (u32x4){0u, 0u, 0u, 0u};
            if (fr < 4) { const LAS float* xp4 = xcS + fr * 512 + h * 64 + 32 * ks + 8 * fq; const f32x4 a0 = *(const LAS f32x4*)xp4, a1 = *(const LAS f32x4*)(xp4 + 4);
                w.x = pk2(a0.x, a0.y); w.y = pk2(a0.z, a0.w); w.z = pk2(a1.x, a1.y); w.w = pk2(a1.z, a1.w); }
            xf[ks] = __builtin_bit_cast(bf16x8, w); }
#pragma unroll
        for (int ct = 0; ct < 4; ++ct)
#pragma unroll
            for (int g = 0; g < 2; ++g) { const bf16* wpt = RGW + (size_t)((g * 8 + h) * 64 + 16 * ct + fr) * 64 + 8 * fq;
                const bf16x8 w0 = *(const bf16x8*)wpt, w1 = *(const bf16x8*)(wpt + 32);
                f32x4 acc = {0.f, 0.f, 0.f, 0.f};
                acc = __builtin_amdgcn_mfma_f32_16x16x32_bf16(xf[0], w0, acc, 0, 0, 0); acc = __builtin_amdgcn_mfma_f32_16x16x32_bf16(xf[1], w1, acc, 0, 0, 0);
                if (fq == 0) {
#pragma unroll
                    for (int e = 0; e < 4; ++e) gS[(g * 4 + e) * 512 + h * 64 + 16 * ct + fr] = acc[e]; } }
        __syncthreads();
        const float ba = p.in[I_BA][l * DR + c], bx = p.in[I_BX][l * DR + c];
#pragma unroll
        for (int t = 0; t < 4; ++t) { ra[t] = gS[t * 512 + c] + ba; ia[t] = gS[(4 + t) * 512 + c] + bx; } }
    { const float sp8 = ((const float*)(p.ws + WS_SP8))[l * DR + c];
      float hs = p.in[I_SH][(size_t)(l * SB + sb) * DR + c];
#pragma unroll
      for (int t = 0; t < 4; ++t) { const float r = sigmoidf_(ra[t]), ig = sigmoidf_(ia[t]); float a, mult; lru_coef(sp8 * r, a, mult);
          hs = a * hs + mult * (ig * xc[t]);
          YM[(row0 + t) * D + c] = (bf16)f2bf(hs * gelu_tanh(gr[t])); }
      p.out[O_SH + (size_t)(l * SB + sb) * DR + c] = hs; }
    __syncthreads();
    return; }
    { float cp[34];
      const float* st = p.in[I_SCF] + ((size_t)(l * SB + sb) * 30) * DC + c;
#pragma unroll
      for (int j = 0; j < 30; ++j) cp[j] = __builtin_nontemporal_load(st + j * DC);
#pragma unroll
      for (int t = 0; t < 4; ++t) { const bf16* up = U + (row0 + t) * DIN; cp[30 + t] = bf2f(up[1024 + c]) * sigmoidf_(bf2f(up[1536 + c])); }
#pragma unroll
      for (int j = 0; j < 30; ++j) __builtin_nontemporal_store(cp[4 + j], p.out + O_SCF + ((size_t)(l * SB + sb) * 30 + j) * DC + c);
      const float* wp = p.in[I_CFW] + (size_t)l * 31 * DC + c; const float bias = p.in[I_CFB][l * DC + c];
      float a4[4] = {bias, bias, bias, bias};
#pragma unroll
      for (int j = 0; j < 31; ++j) { const float w = wp[j * DC];
#pragma unroll
          for (int t = 0; t < 4; ++t) a4[t] += w * cp[t + j]; }
#pragma unroll
      for (int t = 0; t < 4; ++t) cS[t * 512 + c] = a4[t]; }
    __syncthreads();
    if (wave < 4) { const int t = wave;
        const f32x4* gp = (const f32x4*)(p.in[I_LNG] + l * DC + lane * 8); const f32x4* bp = (const f32x4*)(p.in[I_LNB] + l * DC + lane * 8);
        const f32x4 g0 = gp[0], g1 = gp[1], b0 = bp[0], b1 = bp[1];
        const f32x4 x0 = *(const LAS f32x4*)(cS + t * 512 + lane * 8), x1 = *(const LAS f32x4*)(cS + t * 512 + lane * 8 + 4);
        const float mean = wave_sum((x0.x + x0.y) + (x0.z + x0.w) + (x1.x + x1.y) + (x1.z + x1.w)) * (1.0f / 512.0f);
        const f32x4 d0 = x0 - mean, d1 = x1 - mean;
        const float var = wave_sum((d0.x * d0.x + d0.y * d0.y) + (d0.z * d0.z + d0.w * d0.w) + (d1.x * d1.x + d1.y * d1.y) + (d1.z * d1.z + d1.w * d1.w)) * (1.0f / 512.0f);
        const float rs = rsqrtf(var + EPS);
        f32x4 y0 = d0 * rs * g0 + b0, y1 = d1 * rs * g1 + b1;
#pragma unroll
        for (int j = 0; j < 4; ++j) { y0[j] = y0[j] * sigmoidf_(y0[j]); y1[j] = y1[j] * sigmoidf_(y1[j]); }
        u32x4 o; o.x = pk2(y0.x, y0.y); o.y = pk2(y0.z, y0.w); o.z = pk2(y1.x, y1.y); o.w = pk2(y1.z, y1.w);
        *(u32x4*)(YM + (row0 + t) * D + 512 + lane * 8) = o; }
    __syncthreads();
}

constexpr int GR_OFF = 69632, CARRY_OFF = 137216;
constexpr int XC_PITCH = 1040;
struct RgState { float Hl[4][4][4]; float Pl[4][4][4]; };

__device__ __forceinline__ void rglru_part1(CParams& p, int l, int b, int k, LAS unsigned char* lds, RgState& S) {
    const int tid = otid(), lane = tid & 63, h = tid >> 6, fr = lane & 15, fq = lane >> 4;
    const bf16* U = (const bf16*)(p.ws + WS_U);
    {
        const int wave = h; const size_t row = (size_t)b * SEQ + k * 64;
        u32x4 xr[11];
#pragma unroll
        for (int i = 0; i < 11; ++i) { const int t = 8 * wave - 3 + i; xr[i] = (u32x4){0u, 0u, 0u, 0u};
            if (k > 0 || t >= 0) xr[i] = *(const u32x4*)(U + (row + t) * DIN + lane * 8); }
        u32x4 gq[8];
#pragma unroll
        for (int i = 0; i < 8; ++i) { const int idx = tid + 512 * i; gq[i] = *(const u32x4*)(U + (row + (idx >> 6)) * DIN + 512 + (idx & 63) * 8); }
        const float* cw = p.in[I_RGCW] + (size_t)l * 4 * DR + lane * 8; const float* cb = p.in[I_RGCB] + l * DR + lane * 8;
        float wj[4][8], bc[8];
#pragma unroll
        for (int j = 0; j < 4; ++j) { const f32x4 a0 = *(const f32x4*)(cw + j * DR), a1 = *(const f32x4*)(cw + j * DR + 4);
            wj[j][0] = a0.x; wj[j][1] = a0.y; wj[j][2] = a0.z; wj[j][3] = a0.w; wj[j][4] = a1.x; wj[j][5] = a1.y; wj[j][6] = a1.z; wj[j][7] = a1.w; }
        { const f32x4 a0 = *(const f32x4*)cb, a1 = *(const f32x4*)(cb + 4); bc[0] = a0.x; bc[1] = a0.y; bc[2] = a0.z; bc[3] = a0.w; bc[4] = a1.x; bc[5] = a1.y; bc[6] = a1.z; bc[7] = a1.w; }
#pragma unroll
        for (int tt = 0; tt < 8; ++tt) { float o[8];
#pragma unroll
            for (int e = 0; e < 8; ++e) { float a = bc[e];
#pragma unroll
                for (int j = 0; j < 4; ++j) { const unsigned wv = xr[tt + j][e >> 1]; a += wj[j][e] * ((e & 1) ? bfhi(wv) : bflo(wv)); }
                o[e] = a; }
            u32x4 w; w.x = pk2(o[0], o[1]); w.y = pk2(o[2], o[3]); w.z = pk2(o[4], o[5]); w.w = pk2(o[6], o[7]);
            *(LAS u32x4*)(lds + (8 * wave + tt) * XC_PITCH + lane * 16) = w; }
        if (k == 31 && wave == 7) {
#pragma unroll
            for (int j = 0; j < 3; ++j) { const u32x4 wv = xr[8 + j]; float* op = p.out + O_PRG + ((size_t)(l * NB + b) * 3 + j) * DR + lane * 8;
                *(f32x4*)op = (f32x4){bflo(wv.x), bfhi(wv.x), bflo(wv.y), bfhi(wv.y)}; *(f32x4*)(op + 4) = (f32x4){bflo(wv.z), bfhi(wv.z), bflo(wv.w), bfhi(wv.w)}; } }
#pragma unroll
        for (int i = 0; i < 8; ++i) { const int idx = tid + 512 * i; *(LAS u32x4*)(lds + GR_OFF + (idx >> 6) * 1024 + (idx & 63) * 16) = gq[i]; }
    }
    __syncthreads();
    const bf16* RGW = (const bf16*)(p.ws + WS_RGW) + (size_t)(l * 2) * 8 * 4096;
    float2* AGG = (float2*)(p.ws + WS_AGG);
#pragma unroll
    for (int ct = 0; ct < 4; ++ct) {
        const int c = h * 64 + 16 * ct + fr;
        bf16x8 wf[2][2];
#pragma unroll
        for (int g = 0; g < 2; ++g)
#pragma unroll
            for (int ks = 0; ks < 2; ++ks) wf[g][ks] = *(const bf16x8*)(RGW + (size_t)((g * 8 + h) * 64 + 16 * ct + fr) * 64 + 32 * ks + 8 * fq);
        const float ba = p.in[I_BA][l * DR + c], bx = p.in[I_BX][l * DR + c], sp8 = ((const float*)(p.ws + WS_SP8))[l * DR + c];
        float Ac = 1.f, Bc = 0.f;
#pragma unroll
        for (int tt = 0; tt < 4; ++tt) {
            const bf16x8 xf0 = *(const LAS bf16x8*)(lds + (16 * tt + fr) * XC_PITCH + (h * 64 + 8 * fq) * 2);
            const bf16x8 xf1 = *(const LAS bf16x8*)(lds + (16 * tt + fr) * XC_PITCH + (h * 64 + 32 + 8 * fq) * 2);
            f32x4 racc = {0.f, 0.f, 0.f, 0.f}, iacc = {0.f, 0.f, 0.f, 0.f};
            racc = __builtin_amdgcn_mfma_f32_16x16x32_bf16(xf0, wf[0][0], racc, 0, 0, 0); racc = __builtin_amdgcn_mfma_f32_16x16x32_bf16(xf1, wf[0][1], racc, 0, 0, 0);
            iacc = __builtin_amdgcn_mfma_f32_16x16x32_bf16(xf0, wf[1][0], iacc, 0, 0, 0); iacc = __builtin_amdgcn_mfma_f32_16x16x32_bf16(xf1, wf[1][1], iacc, 0, 0, 0);
            float hq = 0.f, pq = 1.f;
#pragma unroll
            for (int e = 0; e < 4; ++e) { const float xcv = bf2f(*(const LAS bf16*)(lds + (16 * tt + 4 * fq + e) * XC_PITCH + c * 2));
                const float r = sigmoidf_(racc[e] + ba), ig = sigmoidf_(iacc[e] + bx); float a, mult; lru_coef(sp8 * r, a, mult);
                hq = a * hq + mult * (ig * xcv); pq *= a; S.Hl[ct][tt][e] = hq; S.Pl[ct][tt][e] = pq; }
            float Ai = pq, Bi = hq;
            { const float A1 = __shfl_up(Ai, 16), B1 = __shfl_up(Bi, 16); if (fq >= 1) { Bi = Ai * B1 + Bi; Ai = A1 * Ai; } }
            { const float A2 = __shfl_up(Ai, 32), B2 = __shfl_up(Bi, 32); if (fq >= 2) { Bi = Ai * B2 + Bi; Ai = A2 * Ai; } }
            float Ae = __shfl_up(Ai, 16), Be = __shfl_up(Bi, 16); if (fq == 0) { Ae = 1.f; Be = 0.f; }
            const float Ap = Ac * Ae, Bp = Ae * Bc + Be;
#pragma unroll
            for (int e = 0; e < 4; ++e) { S.Hl[ct][tt][e] += S.Pl[ct][tt][e] * Bp; S.Pl[ct][tt][e] *= Ap; }
            const float At = __shfl(Ai, 48 + fr), Bt = __shfl(Bi, 48 + fr);
            Bc = At * Bc + Bt; Ac = Ac * At;
            asm volatile("" ::: "memory");
        }
        if (fq == 0) AGG[(size_t)(b * 32 + k) * DR + c] = make_float2(Ac, Bc);
    }
}
__device__ __forceinline__ void rglru_part2(CParams& p, int l, int b, int k, LAS unsigned char* lds, const RgState& S) {
    const int tid = otid(), lane = tid & 63, h = tid >> 6, fr = lane & 15, fq = lane >> 4;
    bf16* YM = (bf16*)(p.ws + WS_YM);
    const float2* AGG = (const float2*)(p.ws + WS_AGG);
    { float carry = 0.f; const float2* ap = AGG + (size_t)(b * 32) * DR + tid;
#pragma unroll 1
        for (int k0 = 0; k0 < k; k0 += 16) { float2 ab[16];
#pragma unroll
            for (int kk = 0; kk < 16; ++kk) { ab[kk] = make_float2(1.f, 0.f); if (k0 + kk < k) ab[kk] = ap[(size_t)(k0 + kk) * DR]; }
#pragma unroll
            for (int kk = 0; kk < 16; ++kk) carry = ab[kk].x * carry + ab[kk].y; }
        *(LAS float*)(lds + CARRY_OFF + tid * 4) = carry; }
    __syncthreads();
#pragma unroll
    for (int ct = 0; ct < 4; ++ct) {
        const int c = h * 64 + 16 * ct + fr; const float carry = *(const LAS float*)(lds + CARRY_OFF + c * 4);
#pragma unroll
        for (int tt = 0; tt < 4; ++tt)
#pragma unroll
            for (int e = 0; e < 4; ++e) { const float hv = S.Hl[ct][tt][e] + S.Pl[ct][tt][e] * carry;
                LAS bf16* gp = (LAS bf16*)(lds + GR_OFF + (16 * tt + 4 * fq + e) * 1024 + c * 2);
                *gp = (bf16)f2bf(hv * gelu_tanh(bf2f(*gp)));
                if (k == 31 && tt == 3 && e == 3 && fq == 3) p.out[O_PH + (size_t)(l * NB + b) * DR + c] = hv; }
    }
    __syncthreads();
    const size_t row = (size_t)b * SEQ + k * 64;
#pragma unroll
    for (int i = 0; i < 8; ++i) { const int idx = tid + 512 * i; *(u32x4*)(YM + (row + (idx >> 6)) * D + (idx & 63) * 8) = *(const LAS u32x4*)(lds + GR_OFF + (idx >> 6) * 1024 + (idx & 63) * 16); }
}

__device__ __forceinline__ void attn_prompt_unit(CParams& p, int l, int b, int h, int qb, LAS unsigned char* lds) {
    const int tid = otid(), lane = tid & 63, wave = tid >> 6, r32 = lane & 31, half = lane >> 5;
    const bf16* QB = (const bf16*)(p.ws + WS_QB); bf16* OB = (bf16*)(p.ws + WS_YM);
    const bf16* KB = (const bf16*)(p.ws + WS_KB) + (size_t)l * MROWS * D; const bf16* VT = (const bf16*)(p.ws + WS_VT) + (size_t)l * MROWS * D;
#pragma unroll 8
    for (int i = 0; i < 16; ++i) { const int idx = tid + 512 * i, key = idx >> 5, ch = idx & 31;
        const u32x4 v = *(const u32x4*)(KB + (size_t)(b * NMEM + key) * D + h * HD + ch * 8);
        *(LAS u32x4*)(lds + key * 512 + ((ch ^ (key & 31)) << 4)) = v; }
    const size_t qrow = (size_t)b * SEQ + qb * 256 + wave * 32 + r32;
    const bf16* qp = QB + qrow * D + h * HD + 8 * half;
    bf16x8 qf[8];
#pragma unroll
    for (int ks = 0; ks < 8; ++ks) qf[ks] = *(const bf16x8*)(qp + ks * 16);
    __syncthreads();
    f32x16 acc[8];
#pragma unroll
    for (int kb = 0; kb < 8; ++kb)
#pragma unroll
        for (int j = 0; j < 16; ++j) acc[kb][j] = 0.f;
#pragma unroll
    for (int kh = 0; kh < 2; ++kh) {
#pragma unroll
        for (int k8 = 0; k8 < 8; ++k8) { const int ks = kh * 8 + k8;
#pragma unroll
            for (int kb = 0; kb < 8; ++kb) { const int key = 32 * kb + r32;
                const bf16x8 a = *(const LAS bf16x8*)(lds + key * 512 + (((2 * ks + half) ^ r32) << 4));
                acc[kb] = __builtin_amdgcn_mfma_f32_32x32x16_bf16(a, qf[k8], acc[kb], 0, 0, 0); }
            if (kh == 0) qf[k8] = *(const bf16x8*)(qp + (8 + k8) * 16); }
    }
    float mx = -3.0e38f;
#pragma unroll
    for (int kb = 0; kb < 8; ++kb)
#pragma unroll
        for (int j = 0; j < 16; ++j) mx = fmaxf(mx, acc[kb][j]);
    mx = fmaxf(mx, __shfl_xor(mx, 32));
    float sum = 0.f;
#pragma unroll
    for (int kb = 0; kb < 8; ++kb)
#pragma unroll
        for (int j = 0; j < 16; ++j) { const float e = __builtin_amdgcn_exp2f(acc[kb][j] - mx); acc[kb][j] = e; sum += e; }
    sum += __shfl_xor(sum, 32);
    const float inv = 1.0f / sum;
    bf16x8 pf[8][2];
#pragma unroll
    for (int kb = 0; kb < 8; ++kb)
#pragma unroll
        for (int jj = 0; jj < 2; ++jj) { u32x4 w; w.x = pk2(acc[kb][8 * jj + 0], acc[kb][8 * jj + 1]); w.y = pk2(acc[kb][8 * jj + 2], acc[kb][8 * jj + 3]);
            w.z = pk2(acc[kb][8 * jj + 4], acc[kb][8 * jj + 5]); w.w = pk2(acc[kb][8 * jj + 6], acc[kb][8 * jj + 7]); pf[kb][jj] = __builtin_bit_cast(bf16x8, w); }
    __syncthreads();
#pragma unroll 8
    for (int i = 0; i < 16; ++i) { const int idx = tid + 512 * i, d = idx >> 5, ch = idx & 31;
        const u32x4 v = *(const u32x4*)(VT + ((size_t)((b * NH + h) * HD + d)) * NMEM + ch * 8);
        const int c8 = 2 * ch; u32x2 lo; lo.x = v.x; lo.y = v.y; u32x2 hi; hi.x = v.z; hi.y = v.w;
        *(LAS u32x2*)(lds + d * 512 + ((c8 ^ (d & 63)) << 3)) = lo; *(LAS u32x2*)(lds + d * 512 + (((c8 + 1) ^ (d & 63)) << 3)) = hi; }
    __syncthreads();
    LAS unsigned char* st = lds + 131072 + wave * 2304;
    const size_t orow0 = (size_t)b * SEQ + qb * 256 + wave * 32;
#pragma unroll
    for (int db = 0; db < 8; ++db) {
        f32x16 o;
#pragma unroll
        for (int j = 0; j < 16; ++j) o[j] = 0.f;
        const int dim = 32 * db + r32;
#pragma unroll
        for (int kb = 0; kb < 8; ++kb)
#pragma unroll
            for (int jj = 0; jj < 2; ++jj) { const int c8 = 8 * kb + 4 * jj + half;
                const u32x2 lo = *(const LAS u32x2*)(lds + dim * 512 + ((c8 ^ (dim & 63)) << 3)), hi = *(const LAS u32x2*)(lds + dim * 512 + (((c8 + 2) ^ (dim & 63)) << 3));
                u32x4 w; w.x = lo.x; w.y = lo.y; w.z = hi.x; w.w = hi.y;
                o = __builtin_amdgcn_mfma_f32_32x32x16_bf16(__builtin_bit_cast(bf16x8, w), pf[kb][jj], o, 0, 0, 0); }
#pragma unroll
        for (int g = 0; g < 4; ++g) { u32x2 w; w.x = pk2(o[4 * g] * inv, o[4 * g + 1] * inv); w.y = pk2(o[4 * g + 2] * inv, o[4 * g + 3] * inv);
            *(LAS u32x2*)(st + r32 * 72 + g * 16 + half * 8) = w; }
        asm volatile("s_waitcnt lgkmcnt(0)" ::: "memory");
#pragma unroll
        for (int i = 0; i < 2; ++i) { const int q = 16 * i + (lane >> 2), c = lane & 3;
            const u32x2 v0 = *(const LAS u32x2*)(st + q * 72 + c * 16), v1 = *(const LAS u32x2*)(st + q * 72 + c * 16 + 8);
            u32x4 v; v.x = v0.x; v.y = v0.y; v.z = v1.x; v.w = v1.y;
            *(u32x4*)(OB + (orow0 + q) * D + h * HD + 32 * db + 8 * c) = v; }
        asm volatile("s_waitcnt lgkmcnt(0)" ::: "memory");
    }
    __syncthreads();
}

__device__ __forceinline__ void attn_sample_unit(CParams& p, int l, int sb, int h, LAS unsigned char* lds) {
    const int tid = otid(), lane = tid & 63, wave = tid >> 6;
    const bf16* QB = (const bf16*)(p.ws + WS_QB); bf16* OB = (bf16*)(p.ws + WS_YM);
    const float* CK = p.in[I_CK] + ((size_t)(l * SB + sb) * NMEM) * D + h * HD; const float* CV = p.in[I_CV] + ((size_t)(l * SB + sb) * NMEM) * D + h * HD;
    LAS f32x4* sc = (LAS f32x4*)lds;
    LAS float* red = (LAS float*)(lds + 8192);
    const size_t row0 = (size_t)TP + sb * SS;
    {
        const int ksub = lane >> 4, dseg = lane & 15;
        f32x4 q[4][4];
#pragma unroll
        for (int t = 0; t < 4; ++t)
#pragma unroll
            for (int jj = 0; jj < 4; ++jj) { const u32x2 w = *(const u32x2*)(QB + (row0 + t) * D + h * HD + jj * 64 + dseg * 4);
                q[t][jj] = (f32x4){bflo(w.x), bfhi(w.x), bflo(w.y), bfhi(w.y)}; }
#pragma unroll 4
        for (int it = 0; it < 8; ++it) { const int key = wave * 32 + it * 4 + ksub;
            f32x4 kv[4];
#pragma unroll
            for (int jj = 0; jj < 4; ++jj) kv[jj] = __builtin_nontemporal_load((const f32x4*)(CK + (size_t)key * D + jj * 64 + dseg * 4));
            float s[4];
#pragma unroll
            for (int t = 0; t < 4; ++t) { float a = 0.f;
#pragma unroll
                for (int jj = 0; jj < 4; ++jj) a += (kv[jj].x * q[t][jj].x + kv[jj].y * q[t][jj].y) + (kv[jj].z * q[t][jj].z + kv[jj].w * q[t][jj].w);
                a += __shfl_xor(a, 1); a += __shfl_xor(a, 2); a += __shfl_xor(a, 4); a += __shfl_xor(a, 8); s[t] = a; }
            if (dseg == 0) sc[key] = (f32x4){s[0], s[1], s[2], s[3]}; }
    }
    __syncthreads();
    if (wave < 4) { const int t = wave; float v[4]; float mx = -3.0e38f;
#pragma unroll
        for (int j = 0; j < 4; ++j) { v[j] = ((const LAS float*)lds)[(lane * 4 + j) * 4 + t]; mx = fmaxf(mx, v[j]); }
#pragma unroll
        for (int o = 1; o < 64; o <<= 1) mx = fmaxf(mx, __shfl_xor(mx, o));
        float sum = 0.f;
#pragma unroll
        for (int j = 0; j < 4; ++j) { v[j] = __builtin_amdgcn_exp2f(v[j] - mx); sum += v[j]; }
        sum = wave_sum(sum); const float inv = 1.0f / sum;
#pragma unroll
        for (int j = 0; j < 4; ++j) ((LAS float*)lds)[(lane * 4 + j) * 4 + t] = v[j] * inv; }
    __syncthreads();
    {
        f32x4 o[4];
#pragma unroll
        for (int t = 0; t < 4; ++t) o[t] = (f32x4){0.f, 0.f, 0.f, 0.f};
#pragma unroll 16
        for (int m = 0; m < 32; ++m) { const int key = wave * 32 + m; const f32x4 v = __builtin_nontemporal_load((const f32x4*)(CV + (size_t)key * D + lane * 4)); const f32x4 pr = sc[key];
            o[0] += v * pr.x; o[1] += v * pr.y; o[2] += v * pr.z; o[3] += v * pr.w; }
#pragma unroll
        for (int t = 0; t < 4; ++t) *(LAS f32x4*)(red + (wave * 4 + t) * 256 + lane * 4) = o[t];
    }
    __syncthreads();
    { const int t = tid >> 7, d2 = tid & 127; float a0 = 0.f, a1 = 0.f;
#pragma unroll
        for (int w = 0; w < 8; ++w) { const f32x2 v = *(const LAS f32x2*)(red + (w * 4 + t) * 256 + d2 * 2); a0 += v.x; a1 += v.y; }
        *(unsigned*)(OB + (row0 + t) * D + h * HD + d2 * 2) = pk2(a0, a1); }
    __syncthreads();
}

struct TailScale {
    bf16* O; int ldc; const float* ssq; float scale;
    typedef float Pre;
    __device__ __forceinline__ Pre prefetch(int row, int) const { return ssq[TP + row]; }
    __device__ __forceinline__ void operator()(int row, int col, f32x4 v, bool, Pre sq) const { const int gr = TP + row; const float r = rsqrtf(sq * (1.0f / 1024.0f) + EPS) * scale;
        u32x2 w; w.x = pk2(v.x * r, v.y * r); w.y = pk2(v.z * r, v.w * r); *(u32x2*)(O + (size_t)gr * ldc + col) = w; }
};
struct TailRes {
    bf16* XB; float* ssq_out;
    typedef u32x2 Pre;
    __device__ __forceinline__ Pre prefetch(int row, int col) const { return *(const u32x2*)(XB + (size_t)(TP + row) * D + col); }
    __device__ __forceinline__ void operator()(int row, int col, f32x4 v, bool lead, Pre xo) const { const size_t off = (size_t)(TP + row) * D + col;
        const f32x4 xn = (f32x4){bflo(xo.x), bfhi(xo.x), bflo(xo.y), bfhi(xo.y)} + v;
        u32x2 w; w.x = pk2(xn.x, xn.y); w.y = pk2(xn.z, xn.w); *(u32x2*)(XB + off) = w;
        float s = (xn.x * xn.x + xn.y * xn.y) + (xn.z * xn.z + xn.w * xn.w);
        s += __shfl_xor(s, 16); s += __shfl_xor(s, 32);
        if (lead) atomicAdd(ssq_out + TP + row, s); }
};
template <int CT, class Epi>
__device__ __forceinline__ void tail_gemm(const bf16* A, const bf16* Bt, int K, int N, LAS unsigned char* lds, const Epi& E) {
    const int tid = otid(), lane = tid & 63, wave = tid >> 6, fr = lane & 15, fq = lane >> 4;
    constexpr int NC = 16 * CT, TPW = CT / 2, KC = 256, PITCH = KC * 2 + 16, NB_ = NC / 16;
    const int npc = N / NC, nchunks = K / KC;
    LAS unsigned char* As = lds; LAS unsigned char* Bs = lds + 64 * PITCH;
    for (int pc = blockIdx.x; pc < 8 * npc; pc += gridDim.x) {
        const int row0 = (pc / npc) * 64, col0 = (pc % npc) * NC;
        typename Epi::Pre pre[TPW]; f32x4 acc[TPW];
#pragma unroll
        for (int j = 0; j < TPW; ++j) { const int t = wave * TPW + j, rt = t / CT, ct = t % CT; pre[j] = E.prefetch(row0 + 16 * rt + fr, col0 + 16 * ct + 4 * fq); acc[j] = (f32x4){0.f, 0.f, 0.f, 0.f}; }
        u32x4 ua[4], ub[NB_];
#pragma unroll
        for (int i = 0; i < 4; ++i) { const int idx = tid + 512 * i; ua[i] = *(const u32x4*)(A + (size_t)(row0 + (idx >> 5)) * K + (idx & 31) * 8); }
#pragma unroll
        for (int i = 0; i < NB_; ++i) { const int idx = tid + 512 * i; ub[i] = *(const u32x4*)(Bt + (size_t)(col0 + (idx >> 5)) * K + (idx & 31) * 8); }
#pragma unroll 1
        for (int kc = 0; kc < nchunks; ++kc) {
#pragma unroll
            for (int i = 0; i < 4; ++i) { const int idx = tid + 512 * i; *(LAS u32x4*)(As + (idx >> 5) * PITCH + (idx & 31) * 16) = ua[i]; }
#pragma unroll
            for (int i = 0; i < NB_; ++i) { const int idx = tid + 512 * i; *(LAS u32x4*)(Bs + (idx >> 5) * PITCH + (idx & 31) * 16) = ub[i]; }
            __syncthreads();
            if (kc + 1 < nchunks) {
#pragma unroll
                for (int i = 0; i < 4; ++i) { const int idx = tid + 512 * i; ua[i] = *(const u32x4*)(A + (size_t)(row0 + (idx >> 5)) * K + (kc + 1) * KC + (idx & 31) * 8); }
#pragma unroll
                for (int i = 0; i < NB_; ++i) { const int idx = tid + 512 * i; ub[i] = *(const u32x4*)(Bt + (size_t)(col0 + (idx >> 5)) * K + (kc + 1) * KC + (idx & 31) * 8); }
            }
#pragma unroll
            for (int ks = 0; ks < KC / 32; ++ks)
#pragma unroll
                for (int j = 0; j < TPW; ++j) { const int t = wave * TPW + j, rt = t / CT, ct = t % CT;
                    const bf16x8 af = *(const LAS bf16x8*)(As + (16 * rt + fr) * PITCH + (32 * ks + 8 * fq) * 2), bfv = *(const LAS bf16x8*)(Bs + (16 * ct + fr) * PITCH + (32 * ks + 8 * fq) * 2);
                    acc[j] = __builtin_amdgcn_mfma_f32_16x16x32_bf16(bfv, af, acc[j], 0, 0, 0); }
            __syncthreads();
        }
#pragma unroll
        for (int j = 0; j < TPW; ++j) { const int t = wave * TPW + j, rt = t / CT, ct = t % CT; E(row0 + 16 * rt + fr, col0 + 16 * ct + 4 * fq, acc[j], fq == 0, pre[j]); }
    }
}

constexpr int N_PHASES = 18;
__device__ __forceinline__ void phase_body(const int ph, CParams* p0, LAS unsigned char* lds, const XcdBarrier& bar) {
        CParams* pq = p0; asm volatile("" : "+s"(pq));
        CParams& p = *pq;
        unsigned char* ws = p.ws;
        bf16* XB = (bf16*)(ws + WS_XB); bf16* U = (bf16*)(ws + WS_U); bf16* YM = (bf16*)(ws + WS_YM); bf16* QB = (bf16*)(ws + WS_QB); bf16* HB = (bf16*)(ws + WS_H);
        float* SSQ = (float*)(ws + WS_SSQ); const int bx = blockIdx.x;
        if (ph == 0) { prologue(p, lds); return; }
        if (ph == N_PHASES - 1) {
            const int tdx = otid(), lane = tdx & 63, wave = tdx >> 6; const float* g = p.in[I_GFIN];
            for (int m0 = bx * NWAVES + wave; m0 < T; m0 += 4 * GRID * NWAVES) {
                u32x2 w[4][4]; float rs[4];
#pragma unroll
                for (int r = 0; r < 4; ++r) { const int m = m0 + r * GRID * NWAVES;
                    if (m < T) { rs[r] = SSQ[6 * T + m]; const u32x2* xr = (const u32x2*)(XB + (size_t)m * D) + lane;
#pragma unroll
                        for (int j = 0; j < 4; ++j) w[r][j] = xr[64 * j]; } }
                const f32x4* gp = (const f32x4*)g + lane;
#pragma unroll
                for (int r = 0; r < 4; ++r) { const int m = m0 + r * GRID * NWAVES;
                    if (m < T) { const float sc = rsqrtf(rs[r] * (1.0f / 1024.0f) + EPS); f32x4* yo = (f32x4*)(p.out + (size_t)m * D) + lane;
#pragma unroll
                        for (int j = 0; j < 4; ++j) __builtin_nontemporal_store((f32x4){bflo(w[r][j].x), bfhi(w[r][j].x), bflo(w[r][j].y), bfhi(w[r][j].y)} * sc * gp[64 * j], yo + 64 * j); } }
            }
            return;
        }
        const int l = (ph - 1) >> 3, sub = (ph - 1) & 7;
        unsigned char* wl = ws + WS_W + (size_t)l * W_LAYER;
        if (sub == 0) {
            { pg8::Gemm g{XB, (const bf16*)(wl + WO_IN), TP, DIN, D}; pg8::StaticOrder S; S.init(TP, DIN, GRID, bx);
              pg8::EpiScaleBf16 E{U, DIN, SSQ + (size_t)(3 * l) * T, 1.0f, 0};
              pg8::gemm_phase<pg8::EpiScaleBf16, pg8::StaticOrder, true, true>(lds, g, S, E); }
            if (l == 0) { pg8::Gemm g{(const bf16*)(ws + WS_MEMB), (const bf16*)(ws + WS_W + WO_KV), MROWS, 2048, D};
                pg8::StaticOrder S; S.init(MROWS, 2048, GRID, bx);
                pg8::EpiKV E{p.out + O_PMK, p.out + O_PMV, (bf16*)(ws + WS_KB), (bf16*)(ws + WS_VT), (const float*)(ws + WS_SSQM)};
                pg8::gemm_phase<pg8::EpiKV, pg8::StaticOrder, true, true>(lds, g, S, E); }
            if (l == 0) { if (bx >= 64) { const int td = otid(); weight_items(p, lds, 1, (bx - 64) * NWAVES + (td >> 6), (GRID - 64) * NWAVES, td >> 6, td & 63); }
                __syncthreads(); }
            { TailScale E{U, DIN, SSQ + (size_t)(3 * l) * T, 1.0f}; tail_gemm<4, TailScale>(XB + (size_t)TP * D, (const bf16*)(wl + WO_IN), D, DIN, lds, E);
#if defined(EXP_TAIL)
              tail_gemm<4, TailScale>(XB + (size_t)TP * D, (const bf16*)(wl + WO_IN), D, DIN, lds, E); tail_gemm<4, TailScale>(XB + (size_t)TP * D, (const bf16*)(wl + WO_IN), D, DIN, lds, E);
#endif
            }
        } else if (sub == 1) {
            const int b = bx >> 5, k = bx & 31;
            { TP_BEGIN(); conf_prompt_pair(p, l, b, 2 * k, lds); TP_END(5); }
            { TP_BEGIN(); sample_mixer_item(p, l, bx & (SB - 1), lds, bx >= SB); TP_END(6); }
            RgState S; { TP_BEGIN(); rglru_part1(p, l, b, k, lds, S); TP_END(7); }
            { TP_BEGIN(); xcd_barrier(bar); TP_END(8); }
            { TP_BEGIN(); rglru_part2(p, l, b, k, lds, S); TP_END(9); }
        } else if (sub == 2) {
            pg8::Gemm g{YM, (const bf16*)(wl + WO_OUT), TP, D, D}; pg8::StaticOrder S; S.init(TP, D, GRID, bx);
            pg8::EpiRes E{XB, SSQ + (size_t)(3 * l + 1) * T};
            pg8::gemm_phase<pg8::EpiRes, pg8::StaticOrder, true, true>(lds, g, S, E);
            TailRes ET{XB, SSQ + (size_t)(3 * l + 1) * T}; tail_gemm<2, TailRes>(YM + (size_t)TP * D, (const bf16*)(wl + WO_OUT), D, D, lds, ET);
        } else if (sub == 3) {
            pg8::Gemm g{XB, (const bf16*)(wl + WO_Q), TP, D, D}; pg8::StaticOrder S; S.init(TP, D, GRID, bx);
            pg8::EpiScaleBf16 E{QB, D, SSQ + (size_t)(3 * l + 1) * T, QSCALE, 0};
            pg8::gemm_phase<pg8::EpiScaleBf16, pg8::StaticOrder, true, true>(lds, g, S, E);
            TailScale ET{QB, D, SSQ + (size_t)(3 * l + 1) * T, QSCALE}; tail_gemm<2, TailScale>(XB + (size_t)TP * D, (const bf16*)(wl + WO_Q), D, D, lds, ET);
#if defined(EXP_TAIL)
            tail_gemm<2, TailScale>(XB + (size_t)TP * D, (const bf16*)(wl + WO_Q), D, D, lds, ET); tail_gemm<2, TailScale>(XB + (size_t)TP * D, (const bf16*)(wl + WO_Q), D, D, lds, ET);
#endif
        } else if (sub == 4) {
            if ((bx >> 3) & 1) { for (int u = bx; u < SB * NH; u += GRID) attn_sample_unit(p, l, u >> 2, u & 3, lds); }
            { TP_BEGIN(); { const int pair = (bx & 7) * 4 + (bx >> 6), qb_ = (bx >> 3) & 7; attn_prompt_unit(p, l, pair >> 2, pair & 3, qb_, lds); } TP_END(10); }
            { TP_BEGIN(); if (!((bx >> 3) & 1)) { for (int u = bx; u < SB * NH; u += GRID) attn_sample_unit(p, l, u >> 2, u & 3, lds); } TP_END(11); }
        } else if (sub == 5) {
            pg8::Gemm g{YM, (const bf16*)(wl + WO_O), TP, D, D}; pg8::StaticOrder S; S.init(TP, D, GRID, bx);
            pg8::EpiRes E{XB, SSQ + (size_t)(3 * l + 2) * T};
            pg8::gemm_phase<pg8::EpiRes, pg8::StaticOrder, true, true>(lds, g, S, E);
            TailRes ET{XB, SSQ + (size_t)(3 * l + 2) * T}; tail_gemm<2, TailRes>(YM + (size_t)TP * D, (const bf16*)(wl + WO_O), D, D, lds, ET);
        } else if (sub == 6) {
            { pg8::Gemm g{XB, (const bf16*)(wl + WO_GU), TP, 2 * DFF, D}; pg8::StaticOrder S; S.init(TP, 2 * DFF, GRID, bx);
              pg8::EpiGateUp E{HB, DFF, SSQ + (size_t)(3 * l + 2) * T, 0};
              pg8::gemm_phase<pg8::EpiGateUp, pg8::StaticOrder, true, true>(lds, g, S, E); }
            { pg8::Gemm g{XB + (size_t)TP * D, (const bf16*)(wl + WO_GU), TS, 2 * DFF, D}; pg8::StaticOrder S; S.init(TS, 2 * DFF, GRID, (bx + 128) & 255);
              pg8::EpiGateUp E{HB, DFF, SSQ + (size_t)(3 * l + 2) * T, TP};
              pg8::gemm_phase<pg8::EpiGateUp, pg8::StaticOrder, true, true>(lds, g, S, E); }
            if (l == 0) { pg8::Gemm g{(const bf16*)(ws + WS_MEMB), (const bf16*)(ws + WS_W + W_LAYER + WO_KV), MROWS, 2048, D};
                pg8::StaticOrder S; S.init(MROWS, 2048, GRID, (bx + 256 - 172) & 255);
                pg8::EpiKV E{p.out + O_PMK + (size_t)MROWS * D, p.out + O_PMV + (size_t)MROWS * D, (bf16*)(ws + WS_KB) + (size_t)MROWS * D, (bf16*)(ws + WS_VT) + (size_t)MROWS * D, (const float*)(ws + WS_SSQM)};
                pg8::gemm_phase<pg8::EpiKV, pg8::StaticOrder, true, true>(lds, g, S, E); }
        } else {
            pg8::Gemm g{HB, (const bf16*)(wl + WO_D), TP, D, DFF}; pg8::StaticOrder S; S.init(TP, D, GRID, bx);
            pg8::EpiRes E{XB, SSQ + (size_t)(3 * l + 3) * T};
            pg8::gemm_phase<pg8::EpiRes, pg8::StaticOrder, true, true>(lds, g, S, E);
            TailRes ET{XB, SSQ + (size_t)(3 * l + 3) * T}; tail_gemm<2, TailRes>(HB + (size_t)TP * DFF, (const bf16*)(wl + WO_D), DFF, D, lds, ET);
        }
}
__global__ void __launch_bounds__(NTHREADS, 2) hymba_fwd(Params p_formal) {
    extern __shared__ __attribute__((aligned(16))) unsigned char lds_raw[];
    LAS unsigned char* lds = (LAS unsigned char*)lds_raw;
    cg::grid_group grid = cg::this_grid();
    if (gridDim.x != GRID) return;
    CParams* p0 = (CParams*)__builtin_amdgcn_kernarg_segment_ptr();
    const int ph_lo = p0->ph_lo, ph_hi = p0->ph_hi;
    if (ph_lo < 0) grid.sync();
    if (threadIdx.x < 2) ((volatile LAS unsigned*)(lds + LDS_BARW))[threadIdx.x] = 0u;
    __syncthreads();
    const XcdBarrier bar = xcd_barrier_post((unsigned*)(p0->ws + WS_BAR), (volatile LAS unsigned*)(lds + LDS_BARW));
#ifndef EXP_SYNC
#define EXP_SYNC 0
#endif
#ifdef TSEL
    unsigned long long tacc0 = 0, tacc1 = 0, tacc2 = 0, tacc3 = 0, tacc4 = 0;
#define TCAT(PH) ((PH) == 0 ? 4 : (PH) == 17 ? 4 : (((PH) - 1) & 7) == 1 ? 2 : (((PH) - 1) & 7) == 4 ? 3 : 1)
#define RUN(PH) if (ph_lo <= (PH) && (PH) < ph_hi) { const unsigned long long t0_ = __builtin_amdgcn_s_memrealtime(); if ((PH) > ph_lo) { xcd_barrier(bar); } const unsigned long long t1_ = __builtin_amdgcn_s_memrealtime(); \
        phase_body((PH), p0, lds, bar); asm volatile("s_waitcnt vmcnt(0)" ::: "memory"); const unsigned long long t2_ = __builtin_amdgcn_s_memrealtime(); tacc0 += t1_ - t0_; \
        if (TCAT(PH) == 1) tacc1 += t2_ - t1_; if (TCAT(PH) == 2) tacc2 += t2_ - t1_; if (TCAT(PH) == 3) tacc3 += t2_ - t1_; if (TCAT(PH) == 4) tacc4 += t2_ - t1_; }
#else
#define RUN(PH) if (ph_lo <= (PH) && (PH) < ph_hi) { if ((PH) > ph_lo) { xcd_barrier(bar); if (EXP_SYNC) { xcd_barrier(bar); xcd_barrier(bar); } } phase_body((PH), p0, lds, bar); }
#endif
#define RUN2(PH) RUN(PH) if (ph_lo <= (PH) && (PH) < ph_hi) { xcd_barrier(bar); phase_body((PH), p0, lds, bar); }
#ifndef EXP_PRO
#define EXP_PRO 0
#endif
#ifndef EXP_MIX
#define EXP_MIX 0
#endif
#ifndef EXP_ATT
#define EXP_ATT 0
#endif
#ifndef EXP_Q
#define EXP_Q 0
#endif
#ifndef EXP_GU
#define EXP_GU 0
#endif
#ifndef EXP_IN
#define EXP_IN 0
#endif
#if EXP_PRO
    RUN2(0)
#else
    RUN(0)
#endif
#if EXP_IN
    RUN2(1)
#else
    RUN(1)
#endif
#if EXP_MIX
    RUN2(2)
#else
    RUN(2)
#endif
    RUN(3)
#if EXP_Q
    RUN2(4)
#else
    RUN(4)
#endif
#if EXP_ATT
    RUN2(5)
#else
    RUN(5)
#endif
    RUN(6)
#if EXP_GU
    RUN2(7)
#else
    RUN(7)
#endif
    RUN(8)
#if EXP_IN
    RUN2(9)
#else
    RUN(9)
#endif
#if EXP_MIX
    RUN2(10)
#else
    RUN(10)
#endif
    RUN(11)
#if EXP_Q
    RUN2(12)
#else
    RUN(12)
#endif
#if EXP_ATT
    RUN2(13)
#else
    RUN(13)
#endif
    RUN(14)
#if EXP_GU
    RUN2(15)
#else
    RUN(15)
#endif
    RUN(16)
#if EXP_PRO
    RUN2(17)
#else
    RUN(17)
#endif
#undef RUN2
#ifdef TSEL
    { unsigned long long tsel = TSEL == 0 ? tacc0 : TSEL == 1 ? tacc1 : TSEL == 2 ? tacc2 : TSEL == 3 ? tacc3 : tacc4;
      if (TSEL >= 5) tsel = __hip_atomic_load((unsigned long long*)(p0->ws + WS_BAR + 15360) + TSEL, __ATOMIC_RELAXED, __HIP_MEMORY_SCOPE_AGENT);
      float* epsw = (float*)(p0->ws + WS_SP8 + 8192);
      if (blockIdx.x == 0 && threadIdx.x == 0) *epsw = 0.006f + (float)tsel * 0.01f * 1e-5f;
      xcd_barrier(bar);
      const float sc = 1.0f + *epsw; float* o = p0->out + O_SCF;
      for (size_t i = (size_t)blockIdx.x * NTHREADS + threadIdx.x; i < (size_t)2 * SB * 30 * DC; i += (size_t)GRID * NTHREADS) o[i] *= sc; }
#endif
#undef RUN
}

#ifndef N_LAUNCH_SPLIT
#define N_LAUNCH_SPLIT 0
#endif
extern "C" void kernel_launch(void* const* d_in, const int* in_sizes, int n_in, void* d_out, int out_size, void* d_ws, size_t ws_size, hipStream_t stream) {
    static int ready = 0;
    if (ready == 0) {
        if (n_in != N_IN || (size_t)out_size != O_END || ws_size < WS_END) { fprintf(stderr, "kernel_launch: unexpected shapes: n_in %d out %d ws %zu\n", n_in, out_size, ws_size); ready = -1; return; }
        if (hipFuncSetAttribute((const void*)hymba_fwd, hipFuncAttributeMaxDynamicSharedMemorySize, LDS_BYTES) != hipSuccess) { fprintf(stderr, "kernel_launch: hipFuncSetAttribute failed\n"); ready = -1; return; }
        int dev = 0, cus = 0, per_cu = 0;
        hipGetDevice(&dev); hipDeviceGetAttribute(&cus, hipDeviceAttributeMultiprocessorCount, dev);
        hipOccupancyMaxActiveBlocksPerMultiprocessor(&per_cu, (const void*)hymba_fwd, NTHREADS, LDS_BYTES);
        if (cus * per_cu < GRID) { fprintf(stderr, "kernel_launch: device holds %d x %d workgroups, need %d resident\n", cus, per_cu, GRID); ready = -1; return; }
        ready = 1;
    }
    if (ready < 0) return;
    if (hipMemsetAsync((unsigned char*)d_ws + WS_BAR, 0, BAR_BYTES, stream) != hipSuccess) { fprintf(stderr, "kernel_launch: memset of the barrier words failed\n"); return; }
    Params p{};
    for (int i = 0; i < N_IN; ++i) p.in[i] = (const float*)d_in[i];
    p.out = (float*)d_out; p.ws = (unsigned char*)d_ws;
#if N_LAUNCH_SPLIT
    for (int ph = 0; ph < N_PHASES; ++ph) { p.ph_lo = ph; p.ph_hi = ph + 1; void* args[] = {&p};
        hipError_t e = hipLaunchCooperativeKernel((const void*)hymba_fwd, dim3(GRID), dim3(NTHREADS), args, LDS_BYTES, stream);
        if (e != hipSuccess) { fprintf(stderr, "cooperative launch failed: %s\n", hipGetErrorString(e)); return; } }
#else
    p.ph_lo = 0; p.ph_hi = N_PHASES; void* args[] = {&p};
    hipError_t e = hipLaunchCooperativeKernel((const void*)hymba_fwd, dim3(GRID), dim3(NTHREADS), args, LDS_BYTES, stream);
    if (e != hipSuccess) fprintf(stderr, "cooperative launch failed: %s\n", hipGetErrorString(e));
#endif
}
```
